# Optimizing an MI355X kernel written in HIP

```python
import math
import jax, jax.numpy as jnp
from jax import lax
import numpy as np

D_MODEL = 1024
BATCH = 2
SEQ = 8192
DEPTH = 1

D_MIX = D_MODEL
ATT_HEADS = 8
HEAD_DIM = 64
D_ATT = ATT_HEADS * HEAD_DIM
CONV_GROUPS = 8
D_CONV = D_MIX - D_ATT
CONV_WIDTH = 31
Q_BLOCK = 128
N_EXPERTS = 32
TOP_K = 4
D_FF = 1024
SWIGLU_LIMIT = 7.0
SWIGLU_ALPHA = 1.702
RMS_EPS = 1e-6
LN_EPS = 1e-5
MASK_VALUE = -1e30
D_IN = 3 * D_ATT + ATT_HEADS + 2 * D_CONV

kernel_name = "hybrid_fox_conformer_moe_layer"


def rmsnorm(x, g):
    xf = x.astype(jnp.float32)
    y = xf * lax.rsqrt(jnp.mean(xf * xf, axis=-1, keepdims=True) + RMS_EPS)
    return (y * g.astype(jnp.float32)).astype(x.dtype)


def layernorm(x, g, b):
    xf = x.astype(jnp.float32)
    mu = jnp.mean(xf, axis=-1, keepdims=True)
    var = jnp.mean(jnp.square(xf - mu), axis=-1, keepdims=True)
    y = (xf - mu) * lax.rsqrt(var + LN_EPS)
    return (y * g.astype(jnp.float32) + b.astype(jnp.float32)).astype(x.dtype)


def forgetting_attention(q, k, v, log_f):
    B, H, T, Dh = q.shape
    scale = 1.0 / math.sqrt(Dh)
    c = lax.cumsum(log_f, axis=2)
    k_pos = jnp.arange(T)
    n_blocks = T // Q_BLOCK

    def one_block(i):
        start = i * Q_BLOCK
        q_blk = lax.dynamic_slice_in_dim(q, start, Q_BLOCK, axis=2)
        c_blk = lax.dynamic_slice_in_dim(c, start, Q_BLOCK, axis=2)
        s = jnp.einsum('bhqd,bhkd->bhqk', q_blk, k).astype(jnp.float32) * scale
        s = s + c_blk[..., :, None] - c[..., None, :]
        q_pos = start + jnp.arange(Q_BLOCK)
        causal = k_pos[None, :] <= q_pos[:, None]
        s = jnp.where(causal, s, MASK_VALUE)
        p = jax.nn.softmax(s, axis=-1).astype(v.dtype)
        return jnp.einsum('bhqk,bhkd->bhqd', p, v)

    o = lax.map(one_block, jnp.arange(n_blocks))
    o = jnp.transpose(o, (1, 0, 3, 2, 4))
    return o.reshape(B, T, H * Dh)


def conformer_conv(glu_in, w_dw, b_dw, ln_g, ln_b):
    a, g = jnp.split(glu_in, 2, axis=-1)
    u = a * jax.nn.sigmoid(g)
    y = lax.conv_general_dilated(
        u, w_dw[:, None, :], window_strides=(1,),
        padding=[(CONV_WIDTH - 1, 0)],
        dimension_numbers=('NWC', 'WIO', 'NWC'),
        feature_group_count=D_CONV) + b_dw
    y = layernorm(y, ln_g, ln_b)
    return jax.nn.silu(y)


def moe_ffn(x, w_router, b_router, w_gu, b_gu, w_down, b_down):
    logits = (x @ w_router + b_router).astype(jnp.float32)
    top_vals, top_idx = lax.top_k(logits, TOP_K)
    top_w = jax.nn.softmax(top_vals, axis=-1)
    gates = jnp.sum(jax.nn.one_hot(top_idx, N_EXPERTS, dtype=jnp.float32)
                    * top_w[..., None], axis=1).astype(x.dtype)

    def expert(acc, params):
        wgu_e, bgu_e, wd_e, bd_e, gate_e = params
        h = x @ wgu_e + bgu_e
        hg, hu = h[:, :D_FF], h[:, D_FF:]
        hg = jnp.minimum(hg, SWIGLU_LIMIT)
        hu = jnp.clip(hu, -SWIGLU_LIMIT, SWIGLU_LIMIT)
        act = (hu + 1.0) * (hg * jax.nn.sigmoid(SWIGLU_ALPHA * hg))
        y = act @ wd_e + bd_e
        return acc + gate_e[:, None] * y, None

    acc0 = jnp.zeros_like(x)
    out, _ = lax.scan(expert, acc0, (w_gu, b_gu, w_down, b_down, gates.T))
    return out


def setup_inputs(seed: int = 0) -> dict:
    key = jax.random.key(seed)
    ks = jax.random.split(key, 20)
    f32 = jnp.float32
    nrm = lambda k, shape, s: jax.random.normal(k, shape, f32) * s
    return {
        "x": nrm(ks[0], (BATCH, SEQ, D_MODEL), 1.0),
        "norm_mix_g": 1.0 + nrm(ks[1], (D_MODEL,), 0.02),
        "w_in": nrm(ks[2], (D_MODEL, D_IN), D_MODEL ** -0.5),
        "b_f": jax.random.uniform(ks[3], (ATT_HEADS,), f32, 1.0, 5.0),
        "b_glu": nrm(ks[4], (2 * D_CONV,), 0.02),
        "w_dw": nrm(ks[5], (CONV_WIDTH, D_CONV), CONV_WIDTH ** -0.5),
        "b_dw": nrm(ks[6], (D_CONV,), 0.02),
        "ln_g": 1.0 + nrm(ks[7], (D_CONV,), 0.02),
        "ln_b": nrm(ks[8], (D_CONV,), 0.02),
        "w_out": nrm(ks[9], (D_MIX, D_MODEL), D_MIX ** -0.5),
        "norm_ffn_g": 1.0 + nrm(ks[10], (D_MODEL,), 0.02),
        "w_router": nrm(ks[11], (D_MODEL, N_EXPERTS), D_MODEL ** -0.5),
        "b_router": nrm(ks[12], (N_EXPERTS,), 0.01),
        "w_gu": nrm(ks[13], (N_EXPERTS, D_MODEL, 2 * D_FF), D_MODEL ** -0.5),
        "b_gu": nrm(ks[14], (N_EXPERTS, 2 * D_FF), 0.02),
        "w_down": nrm(ks[15], (N_EXPERTS, D_FF, D_MODEL), D_FF ** -0.5),
        "b_down": nrm(ks[16], (N_EXPERTS, D_MODEL), 0.02),
        "norm_final_g": 1.0 + nrm(ks[17], (D_MODEL,), 0.02),
    }


def reference(x, norm_mix_g, w_in, b_f, b_glu, w_dw, b_dw, ln_g, ln_b, w_out,
              norm_ffn_g, w_router, b_router, w_gu, b_gu, w_down, b_down,
              norm_final_g):
    B, T, D = x.shape
    h = x
    for _ in range(DEPTH):
        xn = rmsnorm(h, norm_mix_g)
        proj = xn @ w_in
        o0 = 0
        q = proj[..., o0:o0 + D_ATT]; o0 += D_ATT
        k = proj[..., o0:o0 + D_ATT]; o0 += D_ATT
        v = proj[..., o0:o0 + D_ATT]; o0 += D_ATT
        f_logit = proj[..., o0:o0 + ATT_HEADS]; o0 += ATT_HEADS
        glu_in = proj[..., o0:o0 + 2 * D_CONV] + b_glu

        heads = lambda t: jnp.transpose(t.reshape(B, T, ATT_HEADS, HEAD_DIM), (0, 2, 1, 3))
        log_f = jax.nn.log_sigmoid((f_logit + b_f).astype(jnp.float32))
        log_f = jnp.transpose(log_f, (0, 2, 1))
        att_o = forgetting_attention(heads(q), heads(k), heads(v), log_f)

        conv_o = conformer_conv(glu_in, w_dw, b_dw, ln_g, ln_b)

        mixed = jnp.concatenate([att_o, conv_o], axis=-1)
        h = h + mixed @ w_out

        hn = rmsnorm(h, norm_ffn_g).reshape(B * T, D)
        h = h + moe_ffn(hn, w_router, b_router, w_gu, b_gu, w_down, b_down).reshape(B, T, D)
    return rmsnorm(h, norm_final_g)
```

```cpp
#include <hip/hip_runtime.h>
#include <hip/hip_bf16.h>
#include <cstdio>
#include <cstdint>
#include <cmath>
#define MK_VARIANT 0
#define MK_DBGSTAT 0
#define MK_ROWA 32
#define MK_ROWB 64
#define PG8_BAUX 0
#define MK_CONVSPLIT 0
#define MK_ALIGN5 true
#define MK_ALIGN6 true
namespace pg8 {
#define PG8_LAS __attribute__((address_space(3)))
typedef unsigned short bf16_t;
typedef short bf16x8 __attribute__((ext_vector_type(8)));
typedef float f32x4 __attribute__((ext_vector_type(4)));
typedef unsigned u32x4 __attribute__((ext_vector_type(4)));
constexpr int BM = 256, BK = 64, HALF = 128, HTB = HALF * BK * 2  , STAGE_BYTES = 8 * HTB, NXCD = 8, WGM = 8;

__host__ __device__ __forceinline__ int lds_byte(int r, int c) { const int st = (r >> 4) * 2 + (c >> 5), rr = r & 15, cc = c & 31, ob = rr * 64 + cc * 2; return st * 1024 + (ob ^ (((ob >> 9) & 1) << 5)); }
__host__ __device__ __forceinline__ void stage_rc(int b, int& R, int& C) { const int st = b / 1024, sb = b % 1024, swz = sb ^ (((sb >> 9) & 1) << 5); R = (st >> 1) * 16 + swz / 64; C = (st & 1) * 32 + (swz % 64) / 2; }
__host__ __device__ __forceinline__ int perm32(int rho) { const int n = rho >> 4, i = rho & 15; return 8 * (i >> 2) + 4 * n + (i & 3); }

struct Unit { int pm, pn, e, rt, seq; };
struct Gemm { const void* A; const void* Bt; int M, N, K, KB; };

struct StaticOrder {
    int nM, nN, nwg, G, c;
    __host__ __device__ void init(int M, int N, int G_, int c_) { nM = M / BM; nN = N / BM; nwg = nM * nN; G = G_; c = c_; }
    __host__ __device__ bool next(int i, Unit& u) const {
        const long L = (long)i * G + c; if (L >= nwg) return false;
        int wgid = (int)L; { const int q = nwg / NXCD, r = nwg % NXCD, xcd = wgid % NXCD, off = wgid / NXCD; wgid = (xcd < r ? xcd * (q + 1) : r * (q + 1) + (xcd - r) * q) + off; }
        const int nig = WGM * nN, gid = wgid / nig, fm = gid * WGM, gsz = (nM - fm) < WGM ? (nM - fm) : WGM;
        u.pm = fm + ((wgid % nig) % gsz); u.pn = (wgid % nig) / gsz; u.e = 0; u.rt = 0; return true;
    }
    __device__ __forceinline__ void a_ready(const Unit&) const {}
    __device__ __forceinline__ void done(const Unit&) const {}
};

__device__ __forceinline__ unsigned cvt_pk_bf16(float lo, float hi) { unsigned r; asm volatile("v_cvt_pk_bf16_f32 %0, %1, %2" : "=v"(r) : "v"(lo), "v"(hi)); return r; }
__device__ __forceinline__ float sigmoid_f(float x) { return __builtin_amdgcn_rcpf(1.0f + __builtin_amdgcn_exp2f(-1.4426950408889634f * x)); }
typedef int i32x4 __attribute__((ext_vector_type(4))); typedef int i32x8 __attribute__((ext_vector_type(8))); typedef unsigned u32x2 __attribute__((ext_vector_type(2)));
__device__ __forceinline__ float clamp448(float x) { return fminf(fmaxf(x, -448.0f), 448.0f); }
__device__ __forceinline__ unsigned pk4_fp8(float a, float b, float c, float d) { int w = __builtin_amdgcn_cvt_pk_fp8_f32(clamp448(a), clamp448(b), 0, false); w = __builtin_amdgcn_cvt_pk_fp8_f32(clamp448(c), clamp448(d), w, true); return (unsigned)w; }
__device__ __forceinline__ unsigned pk4_fp8_nc(float a, float b, float c, float d) { int w = __builtin_amdgcn_cvt_pk_fp8_f32(a, b, 0, false); w = __builtin_amdgcn_cvt_pk_fp8_f32(c, d, w, true); return (unsigned)w; }
__device__ __forceinline__ u32x4 pack8(f32x4 v0, f32x4 v1) { u32x4 w; w.x = cvt_pk_bf16(v0[0], v0[1]); w.y = cvt_pk_bf16(v0[2], v0[3]); w.z = cvt_pk_bf16(v1[0], v1[1]); w.w = cvt_pk_bf16(v1[2], v1[3]); return w; }

struct EpiProj {
    static constexpr bool PERM = true, AFTER_DRAIN = false;
    bf16_t *Q, *U; size_t qkv_stride  ; const PG8_LAS float* bglu  ; float qscale; unsigned* nrm;
    __device__ __forceinline__ void operator()(const f32x4 (&acc)[2][2][4][2], const Unit& u, int wr, int wc, int fr, int fq) const {
        const int row0 = u.pm * BM + wr * 64 + fr;
        if (u.pn < 6) {
            const int t = u.pn >> 1; bf16_t* base = Q + (size_t)t * qkv_stride; const float sc = (t == 0) ? qscale : 1.0f;
            const int col0 = (u.pn & 1) * 256 + wc * 32 + 8 * fq;
#pragma unroll
            for (int ai = 0; ai < 2; ++ai)
#pragma unroll
                for (int m = 0; m < 4; ++m) { bf16_t* rowp = base + (size_t)(row0 + ai * HALF + m * 16) * 512 + col0;
#pragma unroll
                    for (int bj = 0; bj < 2; ++bj) *(u32x4*)(rowp + bj * HALF) = pack8(acc[ai][bj][m][0] * sc, acc[ai][bj][m][1] * sc); }
            if (t < 2) {
#pragma unroll
                for (int bj = 0; bj < 2; ++bj) { float mx = 0.f;
#pragma unroll
                    for (int ai = 0; ai < 2; ++ai)
#pragma unroll
                        for (int m = 0; m < 4; ++m) { const f32x4 a0 = acc[ai][bj][m][0] * sc, a1 = acc[ai][bj][m][1] * sc;
                            float s = (a0[0] * a0[0] + a0[1] * a0[1]) + (a0[2] * a0[2] + a0[3] * a0[3]) + (a1[0] * a1[0] + a1[1] * a1[1]) + (a1[2] * a1[2] + a1[3] * a1[3]);
                            s += __shfl_xor(s, 16); s += __shfl_xor(s, 32); mx = fmaxf(mx, s); }
#pragma unroll
                    for (int o = 1; o < 16; o <<= 1) mx = fmaxf(mx, __shfl_xor(mx, o));
                    if (fr == 0 && fq == 0) { const int head = (u.pn & 1) * 4 + bj * 2 + (wc >> 1), bh = (u.pm >> 5) * 8 + head;
                        __hip_atomic_fetch_max(nrm + (size_t)(((t * 16 + bh) * 2 + (wc & 1)) * 64), __builtin_bit_cast(unsigned, mx), __ATOMIC_RELAXED, __HIP_MEMORY_SCOPE_AGENT); } } }
        } else {
            const int ch0 = (u.pn - 6) * 128 + wc * 32 + 8 * fq;
            f32x4 ba[2], bg[2];
#pragma unroll
            for (int n = 0; n < 2; ++n) { ba[n] = *(const PG8_LAS f32x4*)(bglu + ch0 + 4 * n); bg[n] = *(const PG8_LAS f32x4*)(bglu + 512 + ch0 + 4 * n); }
#pragma unroll
            for (int ai = 0; ai < 2; ++ai)
#pragma unroll
                for (int m = 0; m < 4; ++m) { f32x4 o[2];
#pragma unroll
                    for (int n = 0; n < 2; ++n) { const f32x4 a = acc[ai][0][m][n] + ba[n], g = acc[ai][1][m][n] + bg[n];
#pragma unroll
                        for (int j = 0; j < 4; ++j) o[n][j] = a[j] * sigmoid_f(g[j]); }
                    *(u32x4*)(U + (size_t)(row0 + ai * HALF + m * 16) * 512 + ch0) = pack8(o[0], o[1]); }
        }
    }
};
struct EpiH1 {
    static constexpr bool PERM = true, AFTER_DRAIN = false;
    const bf16_t* xn; const float* rms; const float* g; bf16_t* h1;
    __device__ __forceinline__ void operator()(const f32x4 (&acc)[2][2][4][2], const Unit& u, int wr, int wc, int fr, int fq) const {
        const int row0 = u.pm * BM + wr * 64 + fr, col0 = u.pn * BM + wc * 32 + 8 * fq;
        f32x4 gi[2][2];
#pragma unroll
        for (int bj = 0; bj < 2; ++bj)
#pragma unroll
            for (int n = 0; n < 2; ++n) { const f32x4 gv = *(const f32x4*)(g + col0 + bj * HALF + 4 * n);
                gi[bj][n] = (f32x4){__builtin_amdgcn_rcpf(gv[0]), __builtin_amdgcn_rcpf(gv[1]), __builtin_amdgcn_rcpf(gv[2]), __builtin_amdgcn_rcpf(gv[3])}; }
#pragma unroll
        for (int ai = 0; ai < 2; ++ai) {
            u32x4 xb[4][2]; float rr[4];
#pragma unroll
            for (int m = 0; m < 4; ++m) { const int row = row0 + ai * HALF + m * 16; rr[m] = rms[row];
#pragma unroll
                for (int bj = 0; bj < 2; ++bj) xb[m][bj] = *(const u32x4*)(xn + (size_t)row * 1024 + col0 + bj * HALF); }
            __builtin_amdgcn_sched_barrier(0);
#pragma unroll
            for (int m = 0; m < 4; ++m)
#pragma unroll
                for (int bj = 0; bj < 2; ++bj) { const int row = row0 + ai * HALF + m * 16; const size_t p = (size_t)row * 1024 + col0 + bj * HALF;
                    const u32x4 b = xb[m][bj]; const float r = rr[m];
                    const f32x4 x0 = (f32x4){__builtin_bit_cast(float, b.x << 16), __builtin_bit_cast(float, b.x & 0xffff0000u), __builtin_bit_cast(float, b.y << 16), __builtin_bit_cast(float, b.y & 0xffff0000u)} * r * gi[bj][0];
                    const f32x4 x1 = (f32x4){__builtin_bit_cast(float, b.z << 16), __builtin_bit_cast(float, b.z & 0xffff0000u), __builtin_bit_cast(float, b.w << 16), __builtin_bit_cast(float, b.w & 0xffff0000u)} * r * gi[bj][1];
                    *(u32x4*)(h1 + p) = pack8(acc[ai][bj][m][0] + x0, acc[ai][bj][m][1] + x1); }
            __builtin_amdgcn_sched_barrier(0);
        }
    }
};
struct EpiGU {
    static constexpr bool PERM = true, AFTER_DRAIN = false;
    unsigned char* act; const PG8_LAS float* tab  ; float acc_scale, out_scale;
    __device__ __forceinline__ void operator()(const f32x4 (&acc)[2][2][4][2], const Unit& u, int wr, int wc, int fr, int fq) const {
        const int row0 = u.pm * BM + wr * 64 + fr, pl = u.pn & 7, ch0 = pl * 128 + wc * 32 + 8 * fq;
        const PG8_LAS float* bp = tab + u.seq * 256 + wc * 32 + 8 * fq;
        f32x4 bgt[2], bup[2];
#pragma unroll
        for (int n = 0; n < 2; ++n) { bgt[n] = *(const PG8_LAS f32x4*)(bp + 4 * n); bup[n] = *(const PG8_LAS f32x4*)(bp + 128 + 4 * n); }
#pragma unroll
        for (int ai = 0; ai < 2; ++ai)
#pragma unroll
            for (int m = 0; m < 4; ++m) { f32x4 o[2];
#pragma unroll
                for (int n = 0; n < 2; ++n) { const f32x4 g = acc[ai][0][m][n] * acc_scale + bgt[n], up = acc[ai][1][m][n] * acc_scale + bup[n];
#pragma unroll
                    for (int j = 0; j < 4; ++j) { const float hg = fminf(g[j], 7.0f), hu = fminf(fmaxf(up[j], -7.0f), 7.0f);
                        o[n][j] = fmaf(hu, out_scale, out_scale) * (hg * __builtin_amdgcn_rcpf(1.0f + __builtin_amdgcn_exp2f(hg * (-1.702f * 1.4426950408889634f)))); } }
                u32x2 w; w.x = pk4_fp8_nc(o[0][0], o[0][1], o[0][2], o[0][3]); w.y = pk4_fp8_nc(o[1][0], o[1][1], o[1][2], o[1][3]);
                *(u32x2*)(act + (size_t)(row0 + ai * HALF + m * 16) * 1024 + ch0) = w; }
    }
};
struct EpiDown {
    static constexpr bool PERM = true, AFTER_DRAIN = false;
    unsigned char* y; const PG8_LAS float* tab  ; float acc_scale;
    __device__ __forceinline__ void operator()(const f32x4 (&acc)[2][2][4][2], const Unit& u, int wr, int wc, int fr, int fq) const {
        const int r0 = wr * 64 + fr, pl = u.pn & 3, col0 = pl * 256 + wc * 32 + 8 * fq;
        const PG8_LAS float* tp = tab + u.seq * 512; const PG8_LAS float* bp = tp + wc * 32 + 8 * fq;
        f32x4 bv[2][2];
#pragma unroll
        for (int bj = 0; bj < 2; ++bj)
#pragma unroll
            for (int n = 0; n < 2; ++n) bv[bj][n] = *(const PG8_LAS f32x4*)(bp + bj * HALF + 4 * n);
#pragma unroll
        for (int ai = 0; ai < 2; ++ai)
#pragma unroll
            for (int m = 0; m < 4; ++m) { const int r = r0 + ai * HALF + m * 16; const float gt = tp[256 + r];
                unsigned char* rowp = y + (size_t)(u.pm * BM + r) * 1024 + col0;
#pragma unroll
                for (int bj = 0; bj < 2; ++bj) { const f32x4 v0 = (acc[ai][bj][m][0] * acc_scale + bv[bj][0]) * gt, v1 = (acc[ai][bj][m][1] * acc_scale + bv[bj][1]) * gt;
                    u32x2 w; w.x = pk4_fp8(v0[0], v0[1], v0[2], v0[3]); w.y = pk4_fp8(v1[0], v1[1], v1[2], v1[3]); *(u32x2*)(rowp + bj * HALF) = w; } }
    }
};

struct MoeOrder {
    int nwg, G, c, NPN; const PG8_LAS int* ustart; const PG8_LAS int* ntile; const PG8_LAS int* tileoff;
    __device__ __forceinline__ bool next(int i, Unit& u) const {
        const int L = i * G + c; if (L >= nwg) return false;
        int wgid = L; { const int q = nwg / NXCD, r = nwg % NXCD, xcd = wgid % NXCD, off = wgid / NXCD; wgid = (xcd < r ? xcd * (q + 1) : r * (q + 1) + (xcd - r) * q) + off; }
        int e = 0;
        for (int k = 1; k < 32; ++k) e += (ustart[k] <= wgid) ? 1 : 0;
        e = __builtin_amdgcn_readfirstlane(e);
        const int l = wgid - ustart[e], rt = l / NPN, pl = l - rt * NPN;
        u.pm = __builtin_amdgcn_readfirstlane(tileoff[e] + rt); u.pn = __builtin_amdgcn_readfirstlane(e * NPN + pl); u.e = e; u.rt = __builtin_amdgcn_readfirstlane(rt); return true;
    }
    __device__ __forceinline__ void a_ready(const Unit&) const {}
    __device__ __forceinline__ void done(const Unit&) const {}
};

#ifndef PG8_BAUX
#define PG8_BAUX 0
#endif
template <class Epi, class Sched, bool ALIGN_EPI, bool GATHER, bool F8>
__device__ __forceinline__ void gemm_phase(PG8_LAS unsigned char* lds, const Gemm g, const Sched& S, const Epi& E, const PG8_LAS int* tokl) {
    const int tid = threadIdx.x, wid = __builtin_amdgcn_readfirstlane(tid >> 6), lane = tid & 63, wr = wid >> 2, wc = wid & 3, fr = lane & 15, fq = lane >> 4;
    const int KB = g.KB, nt = KB / 128;
    unsigned voffB[2];
#pragma unroll
    for (int i = 0; i < 2; ++i) { int R, C; stage_rc(tid * 16 + i * 8192, R, C); const int Rb = Epi::PERM ? ((R & ~31) + perm32(R & 31)) : R;
        voffB[i] = (unsigned)(Rb * KB + C * 2); }
    const size_t kstep = (size_t)(BK * 2);
    const size_t hstep = (size_t)HALF * KB;
    const size_t tstep = 2 * hstep;
    const unsigned ldsw = (unsigned)wid * 1024u;
    const int aoff = lds_byte(wr * 64 + fr, fq * 8), boff = lds_byte(wc * 32 + fr, fq * 8);
#define PG8_SA(b, h) (((b) * 2 + (h)) * HTB)
#define PG8_SB(b, h) ((4 + (b) * 2 + (h)) * HTB)
#define PG8_STAGE(bufoff, gbase, voff) do { _Pragma("unroll") for (int _i = 0; _i < 2; ++_i) \
        __builtin_amdgcn_global_load_lds((const unsigned*)((const char*)(gbase) + (voff)[_i]), (PG8_LAS unsigned*)(lds + (bufoff) + ldsw + _i * 8192), 16, 0, 0); } while (0)
#define PG8_STAGEB(bufoff, gbase, voff) do { _Pragma("unroll") for (int _i = 0; _i < 2; ++_i) \
        __builtin_amdgcn_global_load_lds((const unsigned*)((const char*)(gbase) + (voff)[_i]), (PG8_LAS unsigned*)(lds + (bufoff) + ldsw + _i * 8192), 16, 0, PG8_BAUX); } while (0)
#define PG8_LDA(dst, b, h) do { _Pragma("unroll") for (int m = 0; m < 4; ++m) _Pragma("unroll") for (int k = 0; k < 2; ++k) dst[m][k] = *(const PG8_LAS bf16x8*)(lds + PG8_SA(b, h) + aoff + m * 2048 + k * 1024); } while (0)
#define PG8_LDB(dst, b, h) do { _Pragma("unroll") for (int n = 0; n < 2; ++n) _Pragma("unroll") for (int k = 0; k < 2; ++k) dst[n][k] = *(const PG8_LAS bf16x8*)(lds + PG8_SB(b, h) + boff + n * 2048 + k * 1024); } while (0)
#define PG8_CAT(X) __builtin_shufflevector(__builtin_bit_cast(i32x4, (X)[0]), __builtin_bit_cast(i32x4, (X)[1]), 0, 1, 2, 3, 4, 5, 6, 7)
#define PG8_MMA(ai, bj, At, Bt) do { __builtin_amdgcn_s_setprio(1); if constexpr (F8) { _Pragma("unroll") for (int m = 0; m < 4; ++m) _Pragma("unroll") for (int n = 0; n < 2; ++n) \
        acc[ai][bj][m][n] = __builtin_amdgcn_mfma_scale_f32_16x16x128_f8f6f4(PG8_CAT(Bt[n]), PG8_CAT(At[m]), acc[ai][bj][m][n], 0, 0, 0, 0x7f7f7f7f, 0, 0x7f7f7f7f); } else { \
        _Pragma("unroll") for (int m = 0; m < 4; ++m) _Pragma("unroll") for (int n = 0; n < 2; ++n) _Pragma("unroll") for (int k = 0; k < 2; ++k) \
        acc[ai][bj][m][n] = __builtin_amdgcn_mfma_f32_16x16x32_bf16(Bt[n][k], At[m][k], acc[ai][bj][m][n], 0, 0, 0); } __builtin_amdgcn_s_setprio(0); } while (0)
#define PG8_WAIT_V(n) asm volatile("s_waitcnt vmcnt(" #n ")" ::: "memory")
#define PG8_WAIT_L(n) asm volatile("s_waitcnt lgkmcnt(" #n ")" ::: "memory")
#define PG8_BAR __builtin_amdgcn_s_barrier()
#define PG8_SCHED __builtin_amdgcn_sched_barrier(0)
#define PG8_SETOFF(V, UIDX) do { _Pragma("unroll") for (int _i = 0; _i < 2; ++_i) { int _R, _C; { int _t = threadIdx.x; asm volatile("" : "+v"(_t)); stage_rc(_t * 16 + _i * 8192, _R, _C); } \
        _Pragma("unroll") for (int _h = 0; _h < 2; ++_h) { const unsigned _r = GATHER ? (unsigned)tokl[(UIDX) * 256 + _h * HALF + _R] : (unsigned)(_h * HALF + _R); V[_h][_i] = _r * (unsigned)KB + (unsigned)(_C * 2); } } } while (0)
    Unit cur, nxt; int ui = 0;
    if (!S.next(0, cur)) return;
    cur.seq = 0;
    f32x4 acc[2][2][4][2];
#pragma unroll
    for (int a = 0; a < 2; ++a)
#pragma unroll
        for (int b = 0; b < 2; ++b)
#pragma unroll
            for (int m = 0; m < 4; ++m)
#pragma unroll
                for (int n = 0; n < 2; ++n) acc[a][b][m][n] = (f32x4){0.f, 0.f, 0.f, 0.f};
    bf16x8 At[4][2], B0[2][2], B1[2][2];
    unsigned voA[2][2];
    const char* cA = GATHER ? (const char*)g.A : (const char*)g.A + (size_t)cur.pm * tstep; const char* cB = (const char*)g.Bt + (size_t)cur.pn * tstep;
    PG8_SETOFF(voA, 0);
    S.a_ready(cur);
    PG8_STAGEB(PG8_SB(0, 0), cB, voffB); PG8_STAGEB(PG8_SB(0, 1), cB + hstep, voffB); PG8_STAGE(PG8_SA(0, 0), cA, voA[0]); PG8_STAGE(PG8_SA(0, 1), cA, voA[1]);
    if (wr == 1) PG8_BAR;
    PG8_WAIT_V(2); PG8_BAR;
    PG8_STAGEB(PG8_SB(1, 0), cB + kstep, voffB); PG8_STAGE(PG8_SA(1, 0), cA + kstep, voA[0]); PG8_STAGEB(PG8_SB(1, 1), cB + hstep + kstep, voffB);
    PG8_WAIT_V(6); PG8_BAR;
    for (;;) {
        const bool has_next = S.next(ui + 1, nxt);
        const char* nA = has_next ? (GATHER ? (const char*)g.A : (const char*)g.A + (size_t)nxt.pm * tstep) : cA; const char* nB = has_next ? (const char*)g.Bt + (size_t)nxt.pn * tstep : cB;
#pragma clang loop unroll(disable)
        for (int t = 0; t < nt; t += 2) {
            const bool last = (t == nt - 2);
            const char* a1 = cA + (size_t)(t + 1) * kstep;
            const char* a2 = last ? nA : cA + (size_t)(t + 2) * kstep; const char* b2 = last ? nB : cB + (size_t)(t + 2) * kstep;
            const char* a3 = a2 + kstep; const char* b3 = b2 + kstep;
            if (last && has_next) S.a_ready(nxt);
            PG8_LDB(B0, 0, 0); PG8_LDB(B1, 0, 1); PG8_SCHED; PG8_LDA(At, 0, 0); PG8_STAGE(PG8_SA(1, 1), a1, voA[1]);
            if (GATHER && last && has_next) { PG8_SETOFF(voA, ui + 1); }
            PG8_WAIT_V(8); PG8_WAIT_L(0); PG8_BAR; PG8_MMA(0, 0, At, B0); PG8_MMA(0, 1, At, B1); PG8_BAR; PG8_SCHED;
            PG8_LDA(At, 0, 1); PG8_STAGEB(PG8_SB(0, 0), b2, voffB); PG8_STAGEB(PG8_SB(0, 1), b2 + hstep, voffB); PG8_STAGE(PG8_SA(0, 0), a2, voA[0]);
            PG8_WAIT_V(8); PG8_WAIT_L(0); PG8_BAR; PG8_MMA(1, 0, At, B0); PG8_MMA(1, 1, At, B1); PG8_BAR; PG8_SCHED;
            PG8_LDB(B0, 1, 0); PG8_LDB(B1, 1, 1); PG8_SCHED; PG8_LDA(At, 1, 0); PG8_STAGE(PG8_SA(0, 1), a2, voA[1]);
            PG8_WAIT_V(8); PG8_WAIT_L(0); PG8_BAR; PG8_MMA(0, 0, At, B0); PG8_MMA(0, 1, At, B1); PG8_BAR; PG8_SCHED;
            PG8_LDA(At, 1, 1); PG8_STAGEB(PG8_SB(1, 0), b3, voffB); PG8_STAGEB(PG8_SB(1, 1), b3 + hstep, voffB); PG8_STAGE(PG8_SA(1, 0), a3, voA[0]);
            PG8_WAIT_V(8); PG8_WAIT_L(0); PG8_BAR; PG8_MMA(1, 0, At, B0); PG8_MMA(1, 1, At, B1); PG8_BAR; PG8_SCHED;
        }
        if constexpr (ALIGN_EPI) { if (wr == 0) PG8_BAR; }
        E(acc, cur, wr, wc, fr, fq); S.done(cur);
        if (!has_next) break;
#pragma unroll
        for (int a = 0; a < 2; ++a)
#pragma unroll
            for (int b = 0; b < 2; ++b)
#pragma unroll
                for (int m = 0; m < 4; ++m)
#pragma unroll
                    for (int n = 0; n < 2; ++n) acc[a][b][m][n] = (f32x4){0.f, 0.f, 0.f, 0.f};
        cur = nxt; cA = nA; cB = nB; ++ui; cur.seq = ui;
        if constexpr (ALIGN_EPI) { if (wr == 1) PG8_BAR; }
    }
    PG8_WAIT_V(0);
    if constexpr (!ALIGN_EPI) { if (wr == 0) PG8_BAR; }
    PG8_BAR;
#undef PG8_SA
#undef PG8_SB
#undef PG8_STAGE
#undef PG8_STAGEB
#undef PG8_LDA
#undef PG8_LDB
#undef PG8_MMA
#undef PG8_CAT
#undef PG8_WAIT_V
#undef PG8_WAIT_L
#undef PG8_BAR
#undef PG8_SCHED
#undef PG8_SETOFF
}
}
namespace attn_body {
using bf16=__hip_bfloat16;
using bf16x8=__attribute__((ext_vector_type(8)))short;
using s16x4=__attribute__((ext_vector_type(4)))short;
using f32x16=__attribute__((ext_vector_type(16)))float;
using u32x4=__attribute__((ext_vector_type(4)))unsigned;
using f32x4_t=__attribute__((ext_vector_type(4)))float;
constexpr int BATCH=2,NHEAD=8,SEQ=8192,D=64,DM=NHEAD*D,OPITCH=1024;
constexpr int NW=8,QBLK=32,QB=QBLK*NW,KVBLK=64,NQB=SEQ/QB;
constexpr int ATTN_PITCH=DM, ATTN_UNIT_ROWS=QB;
__device__ __forceinline__ int crow(int r,int hi){return (r&3)+8*(r>>2)+4*hi;}
#define SBAR() __builtin_amdgcn_sched_barrier(0)
__device__ __forceinline__ void cmask(f32x16&p0,f32x16&p1,int jb,int qrel,int hi){
  const float NEG=-INFINITY; int kb=64*jb+4*hi;
  #pragma unroll
  for(int r=0;r<16;++r){int kv=kb+(r&3)+8*(r>>2); if(kv>qrel)p0[r]=NEG; if(kv+32>qrel)p1[r]=NEG;}
}

constexpr int NSLOT=3, SLOTB=8192;
constexpr int LDS_K=0, LDS_V=NSLOT*SLOTB, LDS_WS=2*NSLOT*SLOTB, LDS_OST=LDS_WS+NW*64*4, LDS_C=LDS_OST+NW*4096, LDS_BYTES=LDS_C+SEQ*4;
constexpr float C2=0.125f*1.4426950408889634f;
__device__ __forceinline__ void glds16(const void*gsrc,unsigned lds_dst){unsigned keep;
  asm volatile("s_mov_b32 %0, m0\n\ts_mov_b32 m0, %2\n\ts_nop 0\n\tglobal_load_lds_dwordx4 %1, off\n\ts_mov_b32 m0, %0":"=&s"(keep):"v"(gsrc),"s"(lds_dst):"memory");}
__device__ __forceinline__ float max3f(float a,float b,float c){float r;asm("v_max3_f32 %0, %1, %2, %3":"=v"(r):"v"(a),"v"(b),"v"(c));return r;}
__device__ __forceinline__ float max2f(float a,float b){float r;asm("v_max_f32_e32 %0, %1, %2":"=v"(r):"v"(a),"v"(b));return r;}
__device__ __forceinline__ float fadd_s(float a,float b){float r;asm("v_add_f32_e32 %0, %1, %2":"=v"(r):"v"(a),"v"(b));return r;}
__device__ __forceinline__ float fsub_s(float a,float b){float r;asm("v_sub_f32_e32 %0, %1, %2":"=v"(r):"v"(a),"v"(b));return r;}
typedef float f32x2_t __attribute__((ext_vector_type(2))); typedef __bf16 bf16x2_t __attribute__((ext_vector_type(2)));
__device__ __forceinline__ unsigned cvtpk_s(float lo,float hi){f32x2_t v={lo,hi};bf16x2_t b=__builtin_convertvector(v,bf16x2_t);return __builtin_bit_cast(unsigned,b);}
#define WAIT_BAR(N) asm volatile("s_waitcnt vmcnt(" #N ") lgkmcnt(0)\n\ts_barrier":::"memory")

__device__ __forceinline__ void qkt(f32x16&p0,f32x16&p1,const char*Kslot,const bf16x8*qr,const f32x16&c0,const f32x16&c1,int r32,int hi){
  const char*kb=Kslot+hi*1024+r32*16;
  #pragma unroll
  for(int d0=0;d0<4;++d0){
    const bf16x8 b0=*reinterpret_cast<const bf16x8*>(kb+d0*2048);
    const bf16x8 b1=*reinterpret_cast<const bf16x8*>(kb+d0*2048+512);
    if(d0==0){p0=__builtin_amdgcn_mfma_f32_32x32x16_bf16(b0,qr[0],c0,0,0,0);p1=__builtin_amdgcn_mfma_f32_32x32x16_bf16(b1,qr[0],c1,0,0,0);}
    else{p0=__builtin_amdgcn_mfma_f32_32x32x16_bf16(b0,qr[d0],p0,0,0,0);p1=__builtin_amdgcn_mfma_f32_32x32x16_bf16(b1,qr[d0],p1,0,0,0);}}
}
typedef __attribute__((address_space(3))) const char* lds_cptr;
typedef short v4i16_t __attribute__((ext_vector_type(4)));
__device__ __forceinline__ void kload8(bf16x8*kf,lds_cptr kp){
  kf[0]=*(const __attribute__((address_space(3))) bf16x8*)(kp);      kf[1]=*(const __attribute__((address_space(3))) bf16x8*)(kp+512);
  kf[2]=*(const __attribute__((address_space(3))) bf16x8*)(kp+2048); kf[3]=*(const __attribute__((address_space(3))) bf16x8*)(kp+2560);
  kf[4]=*(const __attribute__((address_space(3))) bf16x8*)(kp+4096); kf[5]=*(const __attribute__((address_space(3))) bf16x8*)(kp+4608);
  kf[6]=*(const __attribute__((address_space(3))) bf16x8*)(kp+6144); kf[7]=*(const __attribute__((address_space(3))) bf16x8*)(kp+6656);
}
__device__ __forceinline__ void kload2(bf16x8*kf,lds_cptr kp,int j){ kf[2*j]=*(const __attribute__((address_space(3))) bf16x8*)(kp+j*2048); kf[2*j+1]=*(const __attribute__((address_space(3))) bf16x8*)(kp+j*2048+512); }
__device__ __forceinline__ s16x4 vtr(lds_cptr p){ return __builtin_bit_cast(s16x4,__builtin_amdgcn_ds_read_tr16_b64_v4i16((__attribute__((address_space(3))) v4i16_t*)p)); }
__device__ __forceinline__ float rowmax(const f32x16&p0,const f32x16&p1){
  float a=max3f(p0[0],p0[1],p1[0]),b=max3f(p0[2],p0[3],p1[1]);a=max3f(a,p1[2],p1[3]);
  #pragma unroll
  for(int r=4;r<16;r+=4){a=max3f(a,p0[r],p0[r+1]);b=max3f(b,p0[r+2],p0[r+3]);a=max3f(a,p1[r],p1[r+1]);b=max3f(b,p1[r+2],p1[r+3]);}
  const float m=max2f(a,b);
  auto rr=__builtin_amdgcn_permlane32_swap(__float_as_uint(m),__float_as_uint(m),false,false);
  return max2f(__uint_as_float(rr[0]),__uint_as_float(rr[1]));
}
__device__ __forceinline__ void pv(f32x16*o,int vb,bf16x8 pa0,bf16x8 pa1,bf16x8 pa2,bf16x8 pa3){
  #pragma unroll
  for(int d0=0;d0<2;++d0){s16x4 lo[4],hi[4];
    #pragma unroll
    for(int ks=0;ks<4;++ks){
      asm volatile("ds_read_b64_tr_b16 %0,%1 offset:%c2":"=&v"(lo[ks]):"v"(vb),"i"(d0*4096+ks*1024):"memory");
      asm volatile("ds_read_b64_tr_b16 %0,%1 offset:%c2":"=&v"(hi[ks]):"v"(vb),"i"(d0*4096+ks*1024+512):"memory");}
    asm volatile("s_waitcnt lgkmcnt(0)":::"memory");SBAR();
    #define PK(k) (bf16x8){lo[k][0],lo[k][1],lo[k][2],lo[k][3],hi[k][0],hi[k][1],hi[k][2],hi[k][3]}
    o[d0]=__builtin_amdgcn_mfma_f32_32x32x16_bf16(pa0,PK(0),o[d0],0,0,0);
    o[d0]=__builtin_amdgcn_mfma_f32_32x32x16_bf16(pa1,PK(1),o[d0],0,0,0);
    o[d0]=__builtin_amdgcn_mfma_f32_32x32x16_bf16(pa2,PK(2),o[d0],0,0,0);
    o[d0]=__builtin_amdgcn_mfma_f32_32x32x16_bf16(pa3,PK(3),o[d0],0,0,0);
    #undef PK
  }
}

#ifndef ATTN_STORE16
#define ATTN_STORE16(p,v) (*(u32x4*)(p)=(v))
#endif
template<int THRL> __device__ __forceinline__ void attn_unit(int b,int h,int qb,const bf16*Q,const bf16*__restrict__ K,const bf16*__restrict__ V,bf16*O,const float*__restrict__ CP,const unsigned*__restrict__ NRM,char*shm){
  const int tid=threadIdx.x,lane=tid&63,r32=lane&31,hi=lane>>5; const int wid=__builtin_amdgcn_readfirstlane(tid>>6);
  const long rowbase=(long)b*SEQ; const int q0=qb*QB;
  const bf16*Qw=Q+(rowbase+q0+wid*QBLK)*DM+h*D;
  const bf16*Kh=K+rowbase*DM+h*D,*Vh=V+rowbase*DM+h*D;
  const unsigned lds0=(unsigned)(uintptr_t)shm;
  const lds_cptr shm3=(lds_cptr)shm;
  float*wsf=(float*)(shm+LDS_WS)+wid*64;
  const bf16*ksrc=Kh+(long)lane*DM+wid*8;
  const bf16*vsrc=Vh+(long)(16*(wid&3)+(lane>>2))*DM+(wid>>2)*32+(lane&3)*8;
  const unsigned kdst=lds0+LDS_K+wid*1024, vdst=lds0+LDS_V+wid*1024;
  #define DMA_K(t,slot) glds16(ksrc+(long)TIDX(t)*KVBLK*DM,(unsigned)__builtin_amdgcn_readfirstlane(kdst+(slot)))
  #define DMA_V(t,slot) glds16(vsrc+(long)TIDX(t)*KVBLK*DM,(unsigned)__builtin_amdgcn_readfirstlane(vdst+(slot)))
  const int vb0=(int)(lds0+LDS_V)+((lane>>4)&1)*32+(lane&3)*8+(4*hi+((lane&15)>>2))*64;
  const char*Kbase=shm+LDS_K; bf16x8 kf[8];
  const lds_cptr kp0=shm3+LDS_K+hi*1024+r32*16; const lds_cptr vp0=shm3+LDS_V+((lane>>4)&1)*32+(lane&3)*8+(4*hi+((lane&15)>>2))*64;
  const int NT=(q0+QB)/KVBLK;
#if defined(ATT_ORIGORDER)
  #define TIDX(p) (p)
  #define JBOF(t) ((t)-(NT-4))
#else
  #define TIDX(p) (((p)<4)?(NT-4+(p)):(NT-1-(p)))
  #define JBOF(t) (((t)<4)?(t):-1)
#endif
  const float*cg=CP+(long)(b*NHEAD+h)*SEQ;
  typedef __attribute__((address_space(3))) const f32x4_t* lds_c4;
#if !defined(ATT_NOSTAGE)
  { float*cl=(float*)(shm+LDS_C); const int nk=q0+QB; for(int i=tid*4;i<nk;i+=NW*64*4)*(f32x4_t*)(cl+i)=*(const f32x4_t*)(cg+i); }
#endif
  const lds_c4 cl4=(lds_c4)(shm3+LDS_C)+hi;
#if defined(ATT_NOBIAS)
  #define CBIAS(C0,C1,a) do{ _Pragma("unroll") for(int g_=0;g_<16;++g_){ C0[g_]=nm; C1[g_]=nm; } }while(0)
#else
  #define CBIAS(C0,C1,a) do{ const lds_c4 cp_=cl4+16*(a); _Pragma("unroll") for(int g_=0;g_<4;++g_){ const f32x4_t v_=cp_[2*g_], w_=cp_[8+2*g_]; \
      C0[4*g_]=nm-v_[0];C0[4*g_+1]=nm-v_[1];C0[4*g_+2]=nm-v_[2];C0[4*g_+3]=nm-v_[3]; C1[4*g_]=nm-w_[0];C1[4*g_+1]=nm-w_[1];C1[4*g_+2]=nm-w_[2];C1[4*g_+3]=nm-w_[3]; } }while(0)
#endif
  DMA_K(0,0);DMA_V(0,0);DMA_K(1,SLOTB);
  bf16x8 qr[4];
  #pragma unroll
  for(int d0=0;d0<4;++d0)qr[d0]=*reinterpret_cast<const bf16x8*>(&Qw[(long)r32*DM+d0*16+hi*8]);
  #if defined(ATT_NOBIAS)
  float l_reg=0.f,nm=0.f;
#else
  float l_reg=0.f,nm=cg[q0+wid*QBLK+r32];
#endif
  f32x16 o[2];o[0]=f32x16{};o[1]=f32x16{};
  const int qrel=wid*QBLK+r32;
  #define CMASK(P0,P1,t) do{int jb_=JBOF(t); if(jb_>=0)cmask(P0,P1,jb_,qrel,hi);}while(0)
  bool resc=false;
  #define START(P0,P1) do{ const float rm=rowmax(P0,P1); resc=false; \
    { const float dl=rm; \
      _Pragma("unroll") for(int r=0;r<16;++r){P0[r]=fsub_s(P0[r],dl);P1[r]=fsub_s(P1[r],dl);} \
      nm=fsub_s(nm,dl); } \
    _Pragma("unroll") for(int r=0;r<16;++r)P0[r]=__builtin_amdgcn_exp2f(P0[r]); }while(0)
  #define RESC() do{ if(resc){ asm volatile("s_waitcnt lgkmcnt(0)":::"memory"); \
      _Pragma("unroll") for(int d_=0;d_<2;++d_) _Pragma("unroll") for(int r=0;r<16;++r)o[d_][r]*=wsf[crow(r,hi)]; } }while(0)
  f32x16 pA0,pA1,pB0,pB1;
  int sl_prev=0,sl_cur=0,sl_next=SLOTB;
  #define ROT() do{sl_prev=sl_cur;sl_cur=sl_next;sl_next=(sl_next==(NSLOT-1)*SLOTB)?0:sl_next+SLOTB;}while(0)
  DMA_K(2,2*SLOTB);
  WAIT_BAR(3);
  int NTe=NT;
#if !defined(ATT_NOSKIP)
  { const unsigned*np=NRM+(size_t)((b*NHEAD+h)*2)*64; const float qn=__builtin_bit_cast(float,np[0])+__builtin_bit_cast(float,np[64]), kn=__builtin_bit_cast(float,np[16*2*64])+__builtin_bit_cast(float,np[16*2*64+64]);
    const float thr=40.0f+2.0f*1.02f*sqrtf(qn*kn); const __attribute__((address_space(3))) float*cls=(const __attribute__((address_space(3))) float*)(shm3+LDS_C);
    const float cq0=cls[q0]; int lo_=0,hi_=NT-4;
    while(lo_<hi_){ const int mid=(lo_+hi_)>>1; if(cq0-cls[64*mid+63]>=-thr)hi_=mid; else lo_=mid+1; }
    NTe=4+(NT-4-lo_); NTe+=NTe&1; NTe=__builtin_amdgcn_readfirstlane(NTe); }
#endif
  { f32x16 cb0,cb1; CBIAS(cb0,cb1,TIDX(0)); qkt(pA0,pA1,Kbase,qr,cb0,cb1,r32,hi); } asm volatile("s_nop 15\n\ts_nop 7":"+v"(pA0),"+v"(pA1));CMASK(pA0,pA1,0);
  START(pA0,pA1);
  _Pragma("unroll") for(int r=0;r<16;++r)pA1[r]=__builtin_amdgcn_exp2f(pA1[r]);
  WAIT_BAR(0);
  DMA_K(3,0);DMA_V(1,SLOTB);
  ROT();
  kload8(kf,kp0+sl_cur);
  WAIT_BAR(2);
  s16x4 vlo[8],vhi[8]; u32x4 pw0,pw1,pw2,pw3;
  #define PKW(P,B) cvtpk_s(P[B],P[B+1])
  #define PAF(k) __builtin_bit_cast(bf16x8,pw##k)
  #define VFR(i) (bf16x8){vlo[i][0],vlo[i][1],vlo[i][2],vlo[i][3],vhi[i][0],vhi[i][1],vhi[i][2],vhi[i][3]}
  #define PIN(x) asm volatile("":"+v"(x))
  #define MX3(a,b,c) __builtin_fmaxf(__builtin_fmaxf((a),(b)),(c))
  #define GAPA(MF,A0,A1,A2,A3,W0,W1,PW) do{ MF; sacc+=A0; sacc+=A1; sacc+=A2; sacc+=A3; PIN(sacc); W0; W1; PIN(PW); SBAR(); }while(0)
  #define EX(v) __builtin_amdgcn_exp2f(v)
  #define GAPB(MF,X,B) do{ MF; X[B]=EX(X[B]); X[B+1]=EX(X[B+1]); X[B+2]=EX(X[B+2]); X[B+3]=EX(X[B+3]); PIN(X); SBAR(); }while(0)
  #define VRD(i) do{ vlo[i]=vtr(vp_+(((i)>>2)*4096+((i)&3)*1024)); vhi[i]=vtr(vp_+(((i)>>2)*4096+((i)&3)*1024+512)); }while(0)
  #define KRD(G,j) do{ if(G){ kload2(kf,kp0+sl_next,j); SBAR(); } }while(0)
  #define STEP(C0,C1,P0,P1,t,GK,GV,GL) do{ SBAR(); \
    CBIAS(C0,C1,TIDX(t)); SBAR(); \
    const lds_cptr vp_=vp0+sl_prev; \
    VRD(0); SBAR(); float sacc=(P0[0]+P0[1]); \
    GAPA(C0=__builtin_amdgcn_mfma_f32_32x32x16_bf16(kf[0],qr[0],C0,0,0,0), P0[2],P0[3],P0[4],P0[5],     pw0[0]=PKW(P0,0), pw0[1]=PKW(P0,2), pw0); \
    VRD(4); SBAR(); GAPA(C1=__builtin_amdgcn_mfma_f32_32x32x16_bf16(kf[1],qr[0],C1,0,0,0), P0[6],P0[7],P0[8],P0[9],     pw0[2]=PKW(P0,4), pw0[3]=PKW(P0,6), pw0); \
    VRD(1); SBAR(); GAPA(C0=__builtin_amdgcn_mfma_f32_32x32x16_bf16(kf[2],qr[1],C0,0,0,0),   P0[10],P0[11],P0[12],P0[13], pw1[0]=PKW(P0,8), pw1[1]=PKW(P0,10), pw1); \
    VRD(5); SBAR(); GAPA(C1=__builtin_amdgcn_mfma_f32_32x32x16_bf16(kf[3],qr[1],C1,0,0,0),   P0[14],P0[15],P1[0],P1[1],   pw1[2]=PKW(P0,12),pw1[3]=PKW(P0,14), pw1); \
    VRD(2); SBAR(); GAPA(C0=__builtin_amdgcn_mfma_f32_32x32x16_bf16(kf[4],qr[2],C0,0,0,0),   P1[2],P1[3],P1[4],P1[5],     pw2[0]=PKW(P1,0), pw2[1]=PKW(P1,2), pw2); \
    VRD(6); SBAR(); GAPA(C1=__builtin_amdgcn_mfma_f32_32x32x16_bf16(kf[5],qr[2],C1,0,0,0),   P1[6],P1[7],P1[8],P1[9],     pw2[2]=PKW(P1,4), pw2[3]=PKW(P1,6), pw2); \
    VRD(3); SBAR(); GAPA(C0=__builtin_amdgcn_mfma_f32_32x32x16_bf16(kf[6],qr[3],C0,0,0,0),   P1[10],P1[11],P1[12],P1[13], pw3[0]=PKW(P1,8), pw3[1]=PKW(P1,10), pw3); \
    VRD(7); SBAR(); GAPA(C1=__builtin_amdgcn_mfma_f32_32x32x16_bf16(kf[7],qr[3],C1,0,0,0),   P1[14],P1[15],0.f,0.f,       pw3[2]=PKW(P1,12),pw3[3]=PKW(P1,14), pw3); \
    l_reg+=sacc; \
    if(GK){DMA_K((t)+3,sl_cur);} if(GV){DMA_V((t)+1,sl_next);} \
    CMASK(C0,C1,t); \
    { float a=MX3(C0[0],C0[1],C1[0]),b=MX3(C0[2],C0[3],C1[1]); a=MX3(a,C1[2],C1[3]); \
      _Pragma("unroll") for(int r=4;r<16;r+=4){a=MX3(a,C0[r],C0[r+1]);b=MX3(b,C0[r+2],C0[r+3]);a=MX3(a,C1[r],C1[r+1]);b=MX3(b,C1[r+2],C1[r+3]);} \
      float rm=__builtin_fmaxf(a,b); { auto rr=__builtin_amdgcn_permlane32_swap(__float_as_uint(rm),__float_as_uint(rm),false,false); rm=__builtin_fmaxf(__uint_as_float(rr[0]),__uint_as_float(rr[1])); } \
      resc=false; \
      if(__builtin_expect(__any(rm>(float)THRL),0)){ const float dl=__builtin_fmaxf(rm,0.f); \
        _Pragma("unroll") for(int r=0;r<16;++r){C0[r]-=dl;C1[r]-=dl;} \
        nm-=dl; \
        const float f=__builtin_amdgcn_exp2f(-dl); l_reg*=f; if(hi==0)wsf[r32]=f; resc=true; } } \
    SBAR(); \
    GAPB(o[0]=__builtin_amdgcn_mfma_f32_32x32x16_bf16(PAF(0),VFR(0),o[0],0,0,0), C0,0); \
    GAPB(o[1]=__builtin_amdgcn_mfma_f32_32x32x16_bf16(PAF(0),VFR(4),o[1],0,0,0), C0,4); \
    KRD(GL,0); GAPB(o[0]=__builtin_amdgcn_mfma_f32_32x32x16_bf16(PAF(1),VFR(1),o[0],0,0,0), C0,8); \
    KRD(GL,1); GAPB(o[1]=__builtin_amdgcn_mfma_f32_32x32x16_bf16(PAF(1),VFR(5),o[1],0,0,0), C0,12); \
    KRD(GL,2); GAPB(o[0]=__builtin_amdgcn_mfma_f32_32x32x16_bf16(PAF(2),VFR(2),o[0],0,0,0), C1,0); \
    KRD(GL,3); GAPB(o[1]=__builtin_amdgcn_mfma_f32_32x32x16_bf16(PAF(2),VFR(6),o[1],0,0,0), C1,4); \
    GAPB(o[0]=__builtin_amdgcn_mfma_f32_32x32x16_bf16(PAF(3),VFR(3),o[0],0,0,0), C1,8); \
    GAPB(o[1]=__builtin_amdgcn_mfma_f32_32x32x16_bf16(PAF(3),VFR(7),o[1],0,0,0), C1,12); \
    }while(0)
  int t=1;
  #define ENDW(tt) do{ if((tt)+3<NTe){WAIT_BAR(2);} else if((tt)+2<NTe){WAIT_BAR(1);} else {WAIT_BAR(0);} }while(0)
  for(;t<5&&t+1<NTe;t+=2){
    STEP(pB0,pB1,pA0,pA1,t,(t+3<NTe),(t+1<NTe),(t+1<NTe));       ENDW(t);   RESC(); ROT();
    STEP(pA0,pA1,pB0,pB1,t+1,(t+4<NTe),(t+2<NTe),(t+2<NTe));     ENDW(t+1); RESC(); ROT();
  }
  #undef CMASK
  #define CMASK(P0,P1,t) do{}while(0)
  for(;t+5<NTe;t+=2){
    STEP(pB0,pB1,pA0,pA1,t,true,true,true);     WAIT_BAR(2); RESC(); ROT();
    STEP(pA0,pA1,pB0,pB1,t+1,true,true,true);   WAIT_BAR(2); RESC(); ROT();
  }
  #undef CMASK
  #define CMASK(P0,P1,t) do{int jb_=JBOF(t); if(jb_>=0)cmask(P0,P1,jb_,qrel,hi);}while(0)
  for(;t+1<NTe;t+=2){
    STEP(pB0,pB1,pA0,pA1,t,(t+3<NTe),(t+1<NTe),(t+1<NTe));       ENDW(t);   RESC(); ROT();
    STEP(pA0,pA1,pB0,pB1,t+1,(t+4<NTe),(t+2<NTe),(t+2<NTe));     ENDW(t+1); RESC(); ROT();
  }
  STEP(pB0,pB1,pA0,pA1,NTe-1,false,false,false); RESC();
  { float sacc=pB0[0]+pB0[1]; _Pragma("unroll") for(int r=2;r<16;++r)sacc+=pB0[r]; _Pragma("unroll") for(int r=0;r<16;++r)sacc+=pB1[r]; l_reg+=sacc;
    pw0=(u32x4){PKW(pB0,0),PKW(pB0,2),PKW(pB0,4),PKW(pB0,6)};pw1=(u32x4){PKW(pB0,8),PKW(pB0,10),PKW(pB0,12),PKW(pB0,14)};pw2=(u32x4){PKW(pB1,0),PKW(pB1,2),PKW(pB1,4),PKW(pB1,6)};pw3=(u32x4){PKW(pB1,8),PKW(pB1,10),PKW(pB1,12),PKW(pB1,14)};
    SBAR(); pv(o,vb0+sl_cur,PAF(0),PAF(1),PAF(2),PAF(3)); }
  #undef PKW
  #undef PAF
  #undef VFR
  #undef PIN
  #undef MX3
  #undef GAPA
  #undef GAPB
  #undef EX
  #undef VRD
  #undef KRD
  #undef STEP
  #undef ENDW
  {auto rr=__builtin_amdgcn_permlane32_swap(__float_as_uint(l_reg),__float_as_uint(l_reg),false,false);l_reg=__uint_as_float(rr[0])+__uint_as_float(rr[1]);}
  if(hi==0)wsf[32+r32]=l_reg;asm volatile("s_waitcnt lgkmcnt(0)":::"memory");
  float rli[16];
  #pragma unroll
  for(int r=0;r<16;++r)rli[r]=__builtin_amdgcn_rcpf(wsf[32+crow(r,hi)]);
  bf16*Ow=O+(rowbase+q0+wid*QBLK)*OPITCH+h*D;
  { bf16*stg=(bf16*)(shm+LDS_OST)+wid*2048;
    #pragma unroll
    for(int r=0;r<16;++r){const int orow=crow(r,hi);
      #pragma unroll
      for(int d0=0;d0<2;++d0)stg[orow*64+d0*32+r32]=__float2bfloat16(o[d0][r]*rli[r]);}
    asm volatile("s_waitcnt lgkmcnt(0)":::"memory");
    #pragma unroll
    for(int i=0;i<4;++i){const int row=i*8+(lane>>3),ch=lane&7; const u32x4 v=*(const u32x4*)(stg+row*64+ch*8); ATTN_STORE16(Ow+(long)row*OPITCH+ch*8,v);} }
  asm volatile("s_waitcnt lgkmcnt(0)\n\ts_barrier":::"memory");
  #undef DMA_K
  #undef DMA_V
  #undef TIDX
  #undef JBOF
  #undef CBIAS
  #undef CMASK
  #undef START
  #undef RESC
  #undef ROT
}
constexpr int ATTN_LDS_BYTES=LDS_BYTES;
struct AttnTensors { const bf16* Q; const bf16* K; const bf16* V; bf16* O; const float* CP; const unsigned* NRM; };
struct AttnUnit { int bh; int qb; };
struct StaticOrder {
  int vcu;
  __device__ __forceinline__ explicit StaticOrder(int grid,int block):vcu((grid%8==0)?((block%8)*(grid/8)+block/8):block){}
  __device__ __forceinline__ bool next(int i,AttnUnit&u)const{ const int j=vcu+256*(i>>1); if(j>=256)return false; const int s=j&15; u.bh=j>>4; u.qb=(i&1)?s:31-s; return true; }
  __device__ __forceinline__ void a_ready(const AttnUnit&)const{}
  __device__ __forceinline__ void done(const AttnUnit&)const{}
};
struct QueueOrder {
  unsigned* head; volatile unsigned* slot;
  __device__ __forceinline__ bool next(int,AttnUnit&u)const{
    if(threadIdx.x==0)*slot=__hip_atomic_fetch_add(head,1u,__ATOMIC_RELAXED,__HIP_MEMORY_SCOPE_AGENT);
    __syncthreads(); const unsigned j=*slot; __syncthreads();
    if(j>=512u)return false; u.bh=(int)(j&15u); u.qb=31-(int)(j>>4); return true; }
  __device__ __forceinline__ void a_ready(const AttnUnit&)const{}
  __device__ __forceinline__ void done(const AttnUnit&)const{}
};
template<class Sched,int THRL=8> __device__ __forceinline__ void attn_phase(char*lds,const AttnTensors&T,const Sched&S){
  AttnUnit u;
  for(int i=0;S.next(i,u);++i){ S.a_ready(u); attn_unit<THRL>(u.bh/NHEAD,u.bh%NHEAD,u.qb,T.Q,T.K,T.V,T.O,T.CP,T.NRM,lds); S.done(u); }
}
#undef SBAR
#undef WAIT_BAR
}

constexpr int NWAVES = 8;
constexpr int BATCH = 2, T = 8192, D = 1024, M = BATCH * T;
constexpr int NH = 8, DATT = 512, DCONV = 512, CWID = 31, NE = 32, TOPK = 4, DFF = 1024, DIN = 2568, NP1 = 2560;
constexpr int COL_F = 1536, COL_A = 1544, COL_G = 2056;
constexpr int CAP = 16384;
constexpr int MAXTILES = (M * TOPK) / 256 + NE;
constexpr float LOG2E = 1.4426950408889634f;
constexpr float W8_SCALE = 64.0f, HN8_SCALE = 8.0f, ACT8_SCALE = 4.0f, Y8_SCALE = 32.0f;
constexpr int MAXU = 12;

constexpr size_t MiB = 1u << 20;
constexpr size_t WS_CTL = 0, CTL_ZERO_BYTES = 1 * MiB;
constexpr size_t WS_WIN = 2 * MiB, WS_WO = 8 * MiB, WS_LF = 10 * MiB, WS_CP = 10 * MiB + 512 * 1024, WS_RMS = 11 * MiB + 512 * 1024  , WS_TOKINFO = 11 * MiB, WS_TOKIDX = 12 * MiB, WS_GATEW = 14 * MiB;
constexpr size_t WS_XN = 16 * MiB, WS_Q = 48 * MiB, WS_K = 64 * MiB, WS_V = 80 * MiB, WS_U = 96 * MiB, WS_MIX = 112 * MiB, WS_H1 = 144 * MiB, WS_HN = 208 * MiB;
constexpr size_t WS_WGU = 240 * MiB, WS_WD = 368 * MiB, WS_ACT = 432 * MiB, WS_Y = 576 * MiB, WS_END = 720 * MiB;
static_assert(WS_V - WS_K == WS_K - WS_Q && WS_ACT + (size_t)MAXTILES * 256 * 1024 * 2 <= WS_Y && WS_Y + (size_t)MAXTILES * 256 * 1024 * 2 <= WS_END, "d_ws map");
constexpr int CW_TMO = 0, CW_CODE = 1, CW_CNT = 64  , CW_BAR = 4096;
static_assert(CW_CNT + 64 * NE <= CW_BAR, "CTL words");
constexpr int CW_NRM = 16384  , CW_QHEAD = 24576  ;
static_assert((CW_QHEAD + 64) * 4 <= (int)CTL_ZERO_BYTES, "CTL words inside the memset region");

constexpr int RING_OFF = 0, RING_BYTES = 131072;
constexpr int LDSCTL_OFF = RING_BYTES, MISC_OFF = LDSCTL_OFF;
constexpr int META_OFF = LDSCTL_OFF + 512;
constexpr int TOKL_OFF = LDSCTL_OFF + 2048;
constexpr int EPIL_OFF = TOKL_OFF + MAXU * 1024, EPIL_BYTES = 12288;
constexpr int LDS_BYTES = 163840;
static_assert(EPIL_OFF + EPIL_BYTES <= LDS_BYTES && 9 * 256 * 4 <= EPIL_BYTES && 6 * 512 * 4 <= EPIL_BYTES, "LDS map");

#define GAS __attribute__((address_space(1)))
#define LAS __attribute__((address_space(3)))
typedef unsigned short bf16;
typedef unsigned v4u __attribute__((ext_vector_type(4)));
typedef unsigned v2u __attribute__((ext_vector_type(2)));
typedef float f32x4 __attribute__((ext_vector_type(4)));
typedef GAS unsigned gu32;
#define RLX_AGENT __ATOMIC_RELAXED, __HIP_MEMORY_SCOPE_AGENT
#define LDS_WAIT() asm volatile("s_waitcnt lgkmcnt(0)" ::: "memory")
#define VM_WAIT() asm volatile("s_waitcnt vmcnt(0)" ::: "memory")
__device__ __forceinline__ unsigned f2bf(float f) { unsigned u = __builtin_bit_cast(unsigned, f); return (u + 0x7fffu + ((u >> 16) & 1u)) >> 16; }
__device__ __forceinline__ unsigned pk2(float lo, float hi) { return f2bf(lo) | (f2bf(hi) << 16); }
__device__ __forceinline__ float bf2f(unsigned short h) { return __builtin_bit_cast(float, (unsigned)h << 16); }
#define XB_TMO      128
#define XB_XCNT(j)  (256  + 64 * (j))
#define XB_XSUB(j)  (1280 + 64 * (j))
#define XB_XGEN(j)  (2304 + 64 * (j))
#define XB_TOP      3328
#define XB_TOPGEN   3392
#define XCD_BAR_WORDS 3456
#define XB_SPIN_CAP (1u << 18)

__device__ __forceinline__ unsigned xb_ld(unsigned* p)              { return __hip_atomic_load(p, __ATOMIC_RELAXED, __HIP_MEMORY_SCOPE_AGENT); }
__device__ __forceinline__ unsigned xb_add(unsigned* p, unsigned v) { return __hip_atomic_fetch_add(p, v, __ATOMIC_RELAXED, __HIP_MEMORY_SCOPE_AGENT); }
__device__ __forceinline__ unsigned xb_xcc_id() { return (unsigned)__builtin_amdgcn_s_getreg((3 << 11) | 20) & 0xFu; }
#define XB_SPIN(cond, bar) do { unsigned _sp = 0; while (cond) { __builtin_amdgcn_s_sleep(1); \
    if ((++_sp & 255u) == 0u) { if (xb_ld(&(bar)[XB_TMO])) break; if (_sp > XB_SPIN_CAP) { atomicAdd(&(bar)[XB_TMO], 1u); break; } } } } while (0)

struct XcdBarrier {
    unsigned* bar; unsigned x;
    volatile LAS unsigned* st;
};

__device__ __forceinline__ XcdBarrier xcd_barrier_post(unsigned* bar, volatile LAS unsigned* st) {
    XcdBarrier b; b.bar = bar; b.x = xb_xcc_id(); b.st = st;
    if (threadIdx.x == 0) (void)xb_add(&bar[XB_XCNT(b.x)], 1u);
    return b;
}
__device__ __forceinline__ void xcd_barrier_complete(unsigned* bar, unsigned x, unsigned& nloc, unsigned& nx) {
    const unsigned G = gridDim.x * gridDim.y * gridDim.z;
    unsigned sum, cnt, mine, sp = 0u;
    for (;;) {
        sum = 0u; cnt = 0u; mine = 0u;
#pragma unroll
        for (unsigned j = 0; j < 16; ++j) { const unsigned c = xb_ld(&bar[XB_XCNT(j)]); sum += c; cnt += (c > 0u) ? 1u : 0u; mine = (j == x) ? c : mine; }
        if (sum == G) break;
        __builtin_amdgcn_s_sleep(1);
        if ((++sp & 255u) == 0u) { if (xb_ld(&bar[XB_TMO])) break; if (sp > XB_SPIN_CAP) { atomicAdd(&bar[XB_TMO], 1u); break; } }
    }
    nloc = mine > 0u ? mine : 1u; nx = cnt > 0u ? cnt : 1u;
}

__device__ __forceinline__ void xcd_barrier(const XcdBarrier& b) {
    asm volatile("s_waitcnt vmcnt(0)" ::: "memory");
    __syncthreads();
    if (threadIdx.x == 0) {
        unsigned* bar = b.bar;
        __builtin_amdgcn_s_waitcnt(0);
        unsigned nloc = b.st[0], nx = b.st[1];
        if (nloc == 0u) { xcd_barrier_complete(bar, b.x, nloc, nx); b.st[0] = nloc; b.st[1] = nx; }
        const unsigned old = xb_add(&bar[XB_XSUB(b.x)], 1u);
        const unsigned gen = old / nloc;
        if (old + 1u == (gen + 1u) * nloc) {
            __builtin_amdgcn_fence(__ATOMIC_RELEASE, "agent");
            asm volatile("s_waitcnt vmcnt(0)" ::: "memory");
            const unsigned og = xb_add(&bar[XB_TOP], 1u);
            const unsigned tg = og / nx;
            if (og + 1u == (tg + 1u) * nx) xb_add(&bar[XB_TOPGEN], 1u);
            else XB_SPIN(xb_ld(&bar[XB_TOPGEN]) == tg, bar);
            __builtin_amdgcn_fence(__ATOMIC_ACQUIRE, "agent");
            xb_add(&bar[XB_XGEN(b.x)], 1u);
            asm volatile("s_waitcnt vmcnt(0)" ::: "memory");
        } else {
            XB_SPIN(xb_ld(&bar[XB_XGEN(b.x)]) == gen, bar);
            __builtin_amdgcn_fence(__ATOMIC_ACQUIRE, "agent");
            asm volatile("s_waitcnt vmcnt(0)" ::: "memory");
        }
    }
    __syncthreads();
}

struct Args {
    const float *x, *norm_mix_g, *w_in, *b_f, *b_glu, *w_dw, *b_dw, *ln_g, *ln_b, *w_out, *norm_ffn_g, *w_router, *b_router, *w_gu, *b_gu, *w_down, *b_down, *norm_final_g;
    float* out; unsigned char* ws; int ph_lo, ph_hi, li, pad;
};
struct Frame {
    LAS unsigned char* lds;
    volatile LAS unsigned* MISC;
    gu32* ctl;
    int tid, lane, wave, vcu, G;
};
__device__ __forceinline__ float wave_sum(float v) {
#pragma unroll
    for (int o = 1; o < 64; o <<= 1) v += __shfl_xor(v, o);
    return v;
}

__device__ __forceinline__ void p0_transpose_item(const float* W, int K, int N, int k0, int sc0, bf16* WTrow0, LAS float* scr, int lane) {
#pragma unroll 8
    for (int i = 0; i < 32; ++i) { const int kk = 2 * i + (lane >> 5); scr[kk * 33 + (lane & 31)] = __builtin_nontemporal_load(W + (size_t)(k0 + kk) * N + sc0 + (lane & 31)); }
    LDS_WAIT(); asm volatile("" ::: "memory");
    const int c = lane & 7;
#pragma unroll
    for (int j = 0; j < 4; ++j) { const int n = (lane >> 3) + 8 * j; const LAS float* s = scr + (8 * c) * 33 + n;
        v4u o; o.x = pk2(s[0 * 33], s[1 * 33]); o.y = pk2(s[2 * 33], s[3 * 33]); o.z = pk2(s[4 * 33], s[5 * 33]); o.w = pk2(s[6 * 33], s[7 * 33]);
        *(GAS v4u*)(WTrow0 + (size_t)n * K + k0 + 8 * c) = o; }
    LDS_WAIT(); asm volatile("" ::: "memory");
}
__device__ __forceinline__ void p0_transpose_item_f8(const float* W, int K, int N, int k0, int sc0, unsigned char* WTrow0, LAS float* scr, int lane, float sc) {
#pragma unroll 8
    for (int i = 0; i < 32; ++i) { const int kk = 2 * i + (lane >> 5); scr[kk * 33 + (lane & 31)] = __builtin_nontemporal_load(W + (size_t)(k0 + kk) * N + sc0 + (lane & 31)) * sc; }
    LDS_WAIT(); asm volatile("" ::: "memory");
    const int c = lane & 3;
#pragma unroll
    for (int j = 0; j < 2; ++j) { const int n = (lane >> 2) + 16 * j; const LAS float* s = scr + (16 * c) * 33 + n;
        v4u o; o.x = pg8::pk4_fp8(s[0 * 33], s[1 * 33], s[2 * 33], s[3 * 33]); o.y = pg8::pk4_fp8(s[4 * 33], s[5 * 33], s[6 * 33], s[7 * 33]);
        o.z = pg8::pk4_fp8(s[8 * 33], s[9 * 33], s[10 * 33], s[11 * 33]); o.w = pg8::pk4_fp8(s[12 * 33], s[13 * 33], s[14 * 33], s[15 * 33]);
        *(GAS v4u*)(WTrow0 + (size_t)n * K + k0 + 16 * c) = o; }
    LDS_WAIT(); asm volatile("" ::: "memory");
}
constexpr int P0_KB = D / 64;
constexpr int P0_I_IN = P0_KB * (NP1 / 32), P0_I_O = P0_KB * (D / 32), P0_I_GU = NE * P0_KB * (2 * DFF / 32), P0_I_DN = NE * P0_KB * (D / 32);
constexpr int P0_NITEMS = P0_I_IN + P0_I_O + P0_I_GU + P0_I_DN;
__device__ __forceinline__ void p0_items(Frame& F, const Args& a, int first, int last) {
    unsigned char* ws = a.ws;
    LAS float* scr = (LAS float*)(F.lds + RING_OFF + F.wave * 16384);
    const int gw = F.vcu * NWAVES + F.wave, NGW = F.G * NWAVES;
    bf16* Win_t = (bf16*)(ws + WS_WIN); bf16* Wo_t = (bf16*)(ws + WS_WO); unsigned char* Wgu_t = ws + WS_WGU; unsigned char* Wd_t = ws + WS_WD;
    constexpr int KB = P0_KB, I_IN = P0_I_IN, I_O = P0_I_O, I_GU = P0_I_GU;
    for (int it = first + gw; it < last; it += NGW) {
        int r = it;
        if (r < I_IN) { const int nb = r % (NP1 / 32), kb = r / (NP1 / 32), n0 = nb * 32; int sc;
            if (n0 < 1536) sc = n0; else { const int j = (n0 - 1536) >> 8, i = (n0 - 1536) & 255; sc = (i < 128) ? (COL_A + 128 * j + i) : (COL_G + 128 * j + (i - 128)); }
            p0_transpose_item(a.w_in, D, DIN, kb * 64, sc, Win_t + (size_t)n0 * D, scr, F.lane); continue; }
        r -= I_IN;
        if (r < I_O) { const int nb = r % (D / 32), kb = r / (D / 32); p0_transpose_item(a.w_out, D, D, kb * 64, nb * 32, Wo_t + (size_t)nb * 32 * D, scr, F.lane); continue; }
        r -= I_O;
        if (r < I_GU) { const int per = KB * (2 * DFF / 32), e = r / per, q = r % per, nb = q % (2 * DFF / 32), kb = q / (2 * DFF / 32), n0 = nb * 32;
            const int pl = n0 >> 8, i = n0 & 255, sc = (i < 128) ? (128 * pl + i) : (DFF + 128 * pl + (i - 128));
            p0_transpose_item_f8(a.w_gu + (size_t)e * D * 2 * DFF, D, 2 * DFF, kb * 64, sc, Wgu_t + ((size_t)e * 2 * DFF + n0) * D, scr, F.lane, W8_SCALE); continue; }
        r -= I_GU;
        { const int per = KB * (D / 32), e = r / per, q = r % per, nb = q % (D / 32), kb = q / (D / 32);
            p0_transpose_item_f8(a.w_down + (size_t)e * DFF * D, DFF, D, kb * 64, nb * 32, Wd_t + ((size_t)e * D + nb * 32) * DFF, scr, F.lane, W8_SCALE); }
    }
}
__device__ __forceinline__ void p0_prologue(Frame& F, const Args& a) {
    unsigned char* ws = a.ws;
    const int gw = F.vcu * NWAVES + F.wave, NGW = F.G * NWAVES;
    p0_items(F, a, 0, P0_I_IN + P0_I_O); p0_items(F, a, P0_I_IN + P0_I_O + P0_I_GU, P0_NITEMS);
    __syncthreads();
    LAS float* wf = (LAS float*)(F.lds + RING_OFF);
    for (int i = F.tid; i < D * NH; i += NWAVES * 64) { const int k = i >> 3, h = i & 7; wf[h * D + k] = a.w_in[(size_t)k * DIN + COL_F + h]; }
    __syncthreads();
    bf16* XN = (bf16*)(ws + WS_XN); float* LF = (float*)(ws + WS_LF);
    f32x4 gv[4];
#pragma unroll
    for (int j = 0; j < 4; ++j) gv[j] = ((const GAS f32x4*)a.norm_mix_g)[F.lane + 64 * j];
    for (int m = gw; m < M; m += NGW) {
        const GAS f32x4* xr = (const GAS f32x4*)(a.x + (size_t)m * D) + F.lane;
        f32x4 v[4]; float s = 0.f;
#pragma unroll
        for (int j = 0; j < 4; ++j) { v[j] = xr[64 * j]; s += (v[j].x * v[j].x + v[j].y * v[j].y) + (v[j].z * v[j].z + v[j].w * v[j].w); }
        const float ms = wave_sum(s) * (1.f / D) + 1e-6f, rs = 1.0f / sqrtf(ms);
        if (F.lane == 0) ((float*)(ws + WS_RMS))[m] = sqrtf(ms);
#pragma unroll
        for (int j = 0; j < 4; ++j) v[j] = v[j] * rs * gv[j];
        GAS unsigned long long* o8 = (GAS unsigned long long*)(XN + (size_t)m * D) + F.lane;
#pragma unroll
        for (int j = 0; j < 4; ++j) o8[64 * j] = (unsigned long long)pk2(v[j].x, v[j].y) | ((unsigned long long)pk2(v[j].z, v[j].w) << 32);
        float fl[NH];
#pragma unroll
        for (int h = 0; h < NH; ++h) { float acc = 0.f;
#pragma unroll
            for (int j = 0; j < 4; ++j) { const f32x4 w = *(const LAS f32x4*)(wf + h * D + 4 * F.lane + 256 * j); acc += (v[j].x * w.x + v[j].y * w.y) + (v[j].z * w.z + v[j].w * w.w); }
            fl[h] = wave_sum(acc); }
        if (F.lane < NH) { float z = fl[0];
#pragma unroll
            for (int h = 1; h < NH; ++h) z = (F.lane == h) ? fl[h] : z;
            z += a.b_f[F.lane];
            const float ls = fminf(z, 0.f) - log1pf(expf(-fabsf(z)));
            const int b = m / T, t = m % T;
            LF[(size_t)(b * NH + F.lane) * T + t] = ls; }
    }
}
__device__ __forceinline__ void scan_bh(Frame& F, const float* LF, float* CP, int bh) {
    LAS double* wtot = (LAS double*)(F.lds + RING_OFF);
    const GAS f32x4* src = (const GAS f32x4*)(LF + (size_t)bh * T) + F.tid * 4;
    f32x4 v[4];
#pragma unroll
    for (int j = 0; j < 4; ++j) v[j] = src[j];
    double pre[16]; double run = 0.0;
#pragma unroll
    for (int j = 0; j < 4; ++j)
#pragma unroll
        for (int c = 0; c < 4; ++c) { run += (double)v[j][c]; pre[j * 4 + c] = run; }
    double inc = run;
#pragma unroll
    for (int o = 1; o < 64; o <<= 1) { const double up = __shfl_up(inc, o); if (F.lane >= o) inc += up; }
    if (F.lane == 63) wtot[F.wave] = inc;
    __syncthreads();
    double base = inc - run;
    for (int w = 0; w < F.wave; ++w) base += wtot[w];
    GAS f32x4* dst = (GAS f32x4*)(CP + (size_t)bh * T) + F.tid * 4;
#pragma unroll
    for (int j = 0; j < 4; ++j) { f32x4 o;
#pragma unroll
        for (int c = 0; c < 4; ++c) o[c] = (float)((base + pre[j * 4 + c]) * (double)LOG2E);
        dst[j] = o; }
    __syncthreads();
}

__device__ __forceinline__ void conv_phase(Frame& F, const Args& a, int blk, int grp0, int grp1) {
    const bf16* U = (const bf16*)(a.ws + WS_U); bf16* MIX = (bf16*)(a.ws + WS_MIX);
    LAS float* yl = (LAS float*)(F.lds + RING_OFF);
    LAS float* st = (LAS float*)(F.lds + RING_OFF + 65536);
    int ch = threadIdx.x; asm volatile("" : "+v"(ch));
    const int clane = ch & 63, cwave = __builtin_amdgcn_readfirstlane(ch >> 6);
    float w[CWID];
#pragma unroll
    for (int j = 0; j < CWID; ++j) w[j] = a.w_dw[j * DCONV + ch];
    const float bdw = a.b_dw[ch], lg = a.ln_g[ch], lb = a.ln_b[ch];
    for (int grp = grp0; grp < grp1; ++grp) {
        const int n0 = blk * 64 + grp * 32, t0 = n0 % T;
        unsigned short raw[CWID - 1 + 32];
#pragma unroll
        for (int i = 0; i < CWID - 1 + 32; ++i) { const int ts = t0 - (CWID - 1) + i; const int rowc = (ts >= 0) ? (n0 - (CWID - 1) + i) : n0;
            raw[i] = U[(size_t)rowc * DCONV + ch]; }
        __builtin_amdgcn_sched_barrier(0);
        float uin[CWID - 1 + 32];
#pragma unroll
        for (int i = 0; i < CWID - 1 + 32; ++i) { const int ts = t0 - (CWID - 1) + i; uin[i] = (ts >= 0) ? bf2f(raw[i]) : 0.f; }
        float y[32];
#pragma unroll
        for (int o = 0; o < 32; ++o) { float acc = bdw;
#pragma unroll
            for (int j = 0; j < CWID; ++j) acc = fmaf(w[j], uin[o + j], acc);
            y[o] = acc; yl[o * DCONV + ch] = acc; }
        __syncthreads();
#pragma unroll
        for (int q = 0; q < 4; ++q) { const int o = cwave * 4 + q;
            const f32x4 p0 = *(const LAS f32x4*)(yl + o * DCONV + 4 * clane), p1 = *(const LAS f32x4*)(yl + o * DCONV + 256 + 4 * clane);
            const float mu = wave_sum((p0.x + p0.y) + (p0.z + p0.w) + (p1.x + p1.y) + (p1.z + p1.w)) * (1.f / DCONV);
            const f32x4 d0 = p0 - mu, d1 = p1 - mu;
            const float var = wave_sum((d0.x * d0.x + d0.y * d0.y) + (d0.z * d0.z + d0.w * d0.w) + (d1.x * d1.x + d1.y * d1.y) + (d1.z * d1.z + d1.w * d1.w)) * (1.f / DCONV);
            if (clane == 0) { st[2 * o] = mu; st[2 * o + 1] = 1.0f / sqrtf(var + 1e-5f); } }
        __syncthreads();
#pragma unroll
        for (int o = 0; o < 32; ++o) { const float z = (y[o] - st[2 * o]) * st[2 * o + 1] * lg + lb; const float sw = z * pg8::sigmoid_f(z);
            MIX[(size_t)(n0 + o) * D + DATT + ch] = (bf16)f2bf(sw); }
        __syncthreads();
    }
}

#define RT_SWZ(col) ((((col) & 7) ^ ((((col) >> 3) & 1) << 2)))
__device__ __forceinline__ void router_table(Frame& F, const Args& a) {
    LAS unsigned char* tbl = F.lds + RING_OFF;
    { f32x4 wv[16]; float gg[16];
#pragma unroll
      for (int i = 0; i < 16; ++i) { const int f = F.tid + 512 * i; wv[i] = ((const GAS f32x4*)a.w_router)[f]; gg[i] = a.norm_ffn_g[f >> 3]; }
      __builtin_amdgcn_sched_barrier(0);
#pragma unroll
      for (int i = 0; i < 16; ++i) { const int f = F.tid + 512 * i, col = f >> 3, e4 = f & 7; *(LAS f32x4*)(tbl + col * 128 + ((e4 ^ RT_SWZ(col)) << 4)) = wv[i] * gg[i]; } }
}
__device__ __forceinline__ void router_phase(Frame& F, const Args& a, int blk, size_t dry  ) {
    const bf16* H1 = (const bf16*)(a.ws + WS_H1); unsigned char* HN = a.ws + WS_HN + dry;
    int* tokinfo = (int*)(a.ws + WS_TOKINFO + dry); int* tokidx = (int*)(a.ws + WS_TOKIDX + dry); float* gatew = (float*)(a.ws + WS_GATEW + dry);
    int* gcnt = (int*)(F.ctl + CW_CNT) + (dry ? 32 : 0);
    LAS unsigned char* tbl = F.lds + RING_OFF;
    LAS int* lcnt = (LAS int*)(F.lds + META_OFF) + 32 + 32 + 33 + 33 + 33;
    LAS int* lbase = lcnt + 32;
    LAS float* part = (LAS float*)(F.lds + TOKL_OFF);
    LAS float* ssp = part + 4 * 8 * 64;
    LAS float* rsl = ssp + 64;
    if (F.tid < 32) lcnt[F.tid] = 0;
    __syncthreads();
    const int rg = F.wave & 3, kh = F.wave >> 2, r16 = F.lane & 15, kq = F.lane >> 4;
    f32x4 c0 = {0.f, 0.f, 0.f, 0.f}, c1 = {0.f, 0.f, 0.f, 0.f}; float ss = 0.f;
    {
        const bf16* hp = H1 + (size_t)(blk * 64 + rg * 16 + r16) * D + kh * 512 + kq * 8;
        const int e4a = r16 >> 2, e4b = 4 + (r16 >> 2), wi = (r16 & 3) * 4;
        v4u avv[16];
#pragma unroll
        for (int j = 0; j < 16; ++j) avv[j] = *(const v4u*)(hp + 32 * j);
        __builtin_amdgcn_sched_barrier(0);
#pragma unroll
        for (int j = 0; j < 16; ++j) {
#pragma unroll
            for (int c = 0; c < 8; ++c) { const unsigned wv = avv[j][c >> 1]; const float av = __builtin_bit_cast(float, (c & 1) ? (wv & 0xffff0000u) : (wv << 16));
                ss += av * av;
                const int k = kh * 512 + 32 * j + 8 * kq + c; const LAS unsigned char* rp = tbl + k * 128 + wi; const int sw = RT_SWZ(k);
                const float b0 = *(const LAS float*)(rp + ((e4a ^ sw) << 4)), b1 = *(const LAS float*)(rp + ((e4b ^ sw) << 4));
                c0 = __builtin_amdgcn_mfma_f32_16x16x4f32(av, b0, c0, 0, 0, 0); c1 = __builtin_amdgcn_mfma_f32_16x16x4f32(av, b1, c1, 0, 0, 0); } }
    }
    ss += __shfl_xor(ss, 16); ss += __shfl_xor(ss, 32);
    if (kh == 1) {
#pragma unroll
        for (int i = 0; i < 4; ++i) { part[(rg * 8 + i) * 64 + F.lane] = c0[i]; part[(rg * 8 + 4 + i) * 64 + F.lane] = c1[i]; }
        if (F.lane < 16) ssp[rg * 16 + F.lane] = ss;
    }
    __syncthreads();
    int pe = 0, plr = 0; float pw = 0.f;
    if (kh == 0) {
#pragma unroll
        for (int i = 0; i < 4; ++i) { c0[i] += part[(rg * 8 + i) * 64 + F.lane]; c1[i] += part[(rg * 8 + 4 + i) * 64 + F.lane]; }
        if (F.lane < 16) rsl[rg * 16 + F.lane] = 1.0f / sqrtf((ss + ssp[rg * 16 + F.lane]) * (1.f / D) + 1e-6f);
        LDS_WAIT(); asm volatile("" ::: "memory");
        const float ba = a.b_router[r16], bb = a.b_router[16 + r16];
#pragma unroll
        for (int i = 0; i < 4; ++i) {
            const float rs = rsl[rg * 16 + 4 * kq + i];
            float za = c0[i] * rs + ba, zb = c1[i] * rs + bb;
            int idx[TOPK]; float val[TOPK];
#pragma unroll
            for (int k = 0; k < TOPK; ++k) { float bv = za; int bi = r16; if (zb > za) { bv = zb; bi = 16 + r16; }
#pragma unroll
                for (int o = 8; o > 0; o >>= 1) { const float ov = __shfl_xor(bv, o); const int oi = __shfl_xor(bi, o); if (ov > bv || (ov == bv && oi < bi)) { bv = ov; bi = oi; } }
                idx[k] = bi; val[k] = bv; if (bi == r16) za = -INFINITY; if (bi == 16 + r16) zb = -INFINITY; }
            float ex[TOPK], den = 0.f;
#pragma unroll
            for (int k = 0; k < TOPK; ++k) { ex[k] = __expf(val[k] - val[0]); den += ex[k]; }
            const float inv = 1.0f / den;
#pragma unroll
            for (int k = 0; k < TOPK; ++k) if (r16 == 4 * i + k) { pe = idx[k]; pw = ex[k] * inv; }
        }
        plr = __hip_atomic_fetch_add(&lcnt[pe], 1, __ATOMIC_RELAXED, __HIP_MEMORY_SCOPE_WORKGROUP);
    }
    __syncthreads();
    if (F.tid < 32) lbase[F.tid] = (int)__hip_atomic_fetch_add(gcnt + 64 * F.tid, lcnt[F.tid], RLX_AGENT);
    __syncthreads();
    if (kh == 0) { const int rank = lbase[pe] + plr, row = blk * 64 + rg * 16 + (F.lane >> 2), k = F.lane & 3;
        tokinfo[row * TOPK + k] = pe * CAP + rank; tokidx[pe * CAP + rank] = row; gatew[pe * CAP + rank] = pw; }
    f32x4 gv[4];
#pragma unroll
    for (int j = 0; j < 4; ++j) gv[j] = ((const GAS f32x4*)a.norm_ffn_g)[F.lane + 64 * j];
    for (int rb = 0; rb < 2; ++rb) { f32x4 hv[4][4];
#pragma unroll
        for (int rr = 0; rr < 4; ++rr) { const GAS v2u* hr = (const GAS v2u*)(H1 + (size_t)(blk * 64 + F.wave * 8 + rb * 4 + rr) * D) + F.lane;
#pragma unroll
            for (int j = 0; j < 4; ++j) { const v2u p = hr[64 * j]; hv[rr][j] = (f32x4){__builtin_bit_cast(float, p.x << 16), __builtin_bit_cast(float, p.x & 0xffff0000u), __builtin_bit_cast(float, p.y << 16), __builtin_bit_cast(float, p.y & 0xffff0000u)}; } }
        __builtin_amdgcn_sched_barrier(0);
#pragma unroll
        for (int rr = 0; rr < 4; ++rr) { const int lr = F.wave * 8 + rb * 4 + rr, row = blk * 64 + lr; const float rs = rsl[lr];
            GAS unsigned* o4 = (GAS unsigned*)(HN + (size_t)row * D) + F.lane;
#pragma unroll
            for (int j = 0; j < 4; ++j) { const f32x4 v = hv[rr][j] * (rs * HN8_SCALE) * gv[j]; o4[64 * j] = pg8::pk4_fp8(v.x, v.y, v.z, v.w); } } }
    __syncthreads();
}
__device__ __forceinline__ void moe_meta(Frame& F) {
    LAS int* meta = (LAS int*)(F.lds + META_OFF);
    if (F.tid < 32) { const int c = (int)__hip_atomic_load((int*)(F.ctl + CW_CNT) + 64 * F.tid, RLX_AGENT); meta[F.tid] = c; meta[32 + F.tid] = (c + 255) >> 8; }
    __syncthreads();
    if (F.tid == 0) { int o = 0; for (int e = 0; e < 32; ++e) { meta[64 + e] = o; meta[97 + e] = o * 8; meta[130 + e] = o * 4; o += meta[32 + e]; } meta[64 + 32] = o; meta[97 + 32] = o * 8; meta[130 + 32] = o * 4; }
    __syncthreads();
}

__device__ __forceinline__ void final_phase(Frame& F, const Args& a, int blk) {
    const bf16* H1 = (const bf16*)(a.ws + WS_H1); const unsigned char* Y = a.ws + WS_Y; const int* tokinfo = (const int*)(a.ws + WS_TOKINFO);
    const LAS int* tileoff = (const LAS int*)(F.lds + META_OFF) + 64;
    f32x4 gv[4];
#pragma unroll
    for (int j = 0; j < 4; ++j) gv[j] = ((const GAS f32x4*)a.norm_final_g)[F.lane + 64 * j];
    for (int rr = 0; rr < 8; ++rr) {
        const int row = blk * 64 + F.wave * 8 + rr;
        const GAS v2u* hr = (const GAS v2u*)(H1 + (size_t)row * D) + F.lane;
        f32x4 v[4];
#pragma unroll
        for (int j = 0; j < 4; ++j) { const v2u p = __builtin_nontemporal_load(hr + 64 * j); v[j] = (f32x4){__builtin_bit_cast(float, p.x << 16), __builtin_bit_cast(float, p.x & 0xffff0000u), __builtin_bit_cast(float, p.y << 16), __builtin_bit_cast(float, p.y & 0xffff0000u)}; }
#pragma unroll
        for (int k = 0; k < TOPK; ++k) { const int info = tokinfo[row * TOPK + k], e = info >> 14, rank = info & (CAP - 1);
            const GAS unsigned* yr = (const GAS unsigned*)(Y + ((size_t)tileoff[e] * 256 + rank) * D) + F.lane;
#pragma unroll
            for (int j = 0; j < 4; ++j) { const unsigned p = __builtin_nontemporal_load(yr + 64 * j);
                const auto lo2 = __builtin_amdgcn_cvt_pk_f32_fp8((int)p, false), hi2 = __builtin_amdgcn_cvt_pk_f32_fp8((int)p, true);
                v[j].x += lo2[0] * (1.0f / Y8_SCALE); v[j].y += lo2[1] * (1.0f / Y8_SCALE); v[j].z += hi2[0] * (1.0f / Y8_SCALE); v[j].w += hi2[1] * (1.0f / Y8_SCALE); } }
        float s = 0.f;
#pragma unroll
        for (int j = 0; j < 4; ++j) s += (v[j].x * v[j].x + v[j].y * v[j].y) + (v[j].z * v[j].z + v[j].w * v[j].w);
        const float rs = 1.0f / sqrtf(wave_sum(s) * (1.f / D) + 1e-6f);
        GAS f32x4* orow = (GAS f32x4*)(a.out + (size_t)row * D) + F.lane;
#pragma unroll
        for (int j = 0; j < 4; ++j) __builtin_nontemporal_store(v[j] * rs * gv[j], orow + 64 * j);
    }
}

constexpr int NPHASE = 8;
__global__ void __launch_bounds__(NWAVES * 64, 2) mega_fwd(Args args) {
    extern __shared__ __attribute__((aligned(16))) unsigned char lds[];
    Frame F;
    F.lds = (LAS unsigned char*)lds;
    F.MISC = (volatile LAS unsigned*)(F.lds + MISC_OFF);
    F.tid = threadIdx.x; F.lane = F.tid & 63; F.wave = __builtin_amdgcn_readfirstlane(F.tid >> 6);
    F.G = gridDim.x; { const int bx = blockIdx.x; F.vcu = (F.G % 8 == 0) ? (bx % 8) * (F.G / 8) + bx / 8 : bx; }
    unsigned char* ws = args.ws;
    F.ctl = (gu32*)(ws + WS_CTL);
    for (int u = F.tid; u < 512 / 4; u += NWAVES * 64) ((LAS unsigned*)(F.lds + LDSCTL_OFF))[u] = 0u;
    __syncthreads();
    const int lo = args.ph_lo, hi = args.ph_hi;
    XcdBarrier bar; bar.bar = (unsigned*)(F.ctl + CW_BAR); bar.x = 0; bar.st = nullptr;
    if (hi - lo > 1) bar = xcd_barrier_post((unsigned*)(F.ctl + CW_BAR) + args.li * XCD_BAR_WORDS, F.MISC + 8);
#ifdef MK_ONLY
#define IN(k) ((k) == MK_ONLY && lo <= (k) && (k) < hi)
#else
#define IN(k) (lo <= (k) && (k) < hi)
#endif
#define BOTH(k) (IN(k) && IN((k) + 1))
#define GRID_BAR() xcd_barrier(bar)
#define REFRESH() do { int t_ = threadIdx.x; asm volatile("" : "+v"(t_)); F.tid = t_; F.lane = t_ & 63; F.wave = __builtin_amdgcn_readfirstlane(t_ >> 6); } while (0)
    const int blk = blockIdx.x;

    if (IN(0)) {
        REFRESH();
        p0_prologue(F, args);
        if (BOTH(0)) GRID_BAR();
    }

    if (IN(1)) {
        REFRESH();
#ifndef NO_SCAN
        if (blk >= F.G - 16) scan_bh(F, (const float*)(ws + WS_LF), (float*)(ws + WS_CP), blk - (F.G - 16));
#endif
        pg8::Gemm g{ws + WS_XN, ws + WS_WIN, M, NP1, D, 2 * D}; pg8::StaticOrder S; S.init(M, NP1, F.G, blk);
        LAS float* epil = (LAS float*)(F.lds + EPIL_OFF);
        for (int i = F.tid; i < 2 * DCONV; i += NWAVES * 64) epil[i] = args.b_glu[i];
        __syncthreads();
        pg8::EpiProj E{(bf16*)(ws + WS_Q), (bf16*)(ws + WS_U), (size_t)(WS_K - WS_Q) / 2, epil, 0.125f * LOG2E, (unsigned*)(F.ctl + CW_NRM)};
        pg8::gemm_phase<pg8::EpiProj, pg8::StaticOrder, true, false, false>(F.lds + RING_OFF, g, S, E, nullptr);
        if (BOTH(1)) GRID_BAR();
#ifdef MK_XBAR
        if (BOTH(1)) { GRID_BAR(); GRID_BAR(); GRID_BAR(); GRID_BAR(); }
#endif
    }

    if (IN(2)) {
        REFRESH();
        const attn_body::AttnTensors AT{(const attn_body::bf16*)(ws + WS_Q), (const attn_body::bf16*)(ws + WS_K), (const attn_body::bf16*)(ws + WS_V), (attn_body::bf16*)(ws + WS_MIX), (const float*)(ws + WS_CP), (const unsigned*)(F.ctl + CW_NRM)};
        volatile unsigned* slot = (volatile unsigned*)(lds + MISC_OFF + 64);
        for (;;) {
            if (threadIdx.x == 0) *slot = __hip_atomic_fetch_add((unsigned*)(F.ctl + CW_QHEAD), 1u, __ATOMIC_RELAXED, __HIP_MEMORY_SCOPE_AGENT);
            __syncthreads(); const unsigned j = __builtin_amdgcn_readfirstlane(*slot); __syncthreads();
            if (j >= 512u + (unsigned)(M / 32)) break;
            if (j < 512u) { const int bh = (int)(j & 15u), qb = 31 - (int)(j >> 4); attn_body::attn_unit<8>(bh / NH, bh % NH, qb, AT.Q, AT.K, AT.V, AT.O, AT.CP, AT.NRM, (char*)lds + RING_OFF); }
            else { const int cj = (int)(j - 512u); conv_phase(F, args, cj >> 1, cj & 1, (cj & 1) + 1); }
        }
        if (BOTH(2)) GRID_BAR();
    }

    if (IN(3)) {
        REFRESH();
        pg8::Gemm g{ws + WS_MIX, ws + WS_WO, M, D, D, 2 * D}; pg8::StaticOrder S; S.init(M, D, F.G, blk);
        pg8::EpiH1 E{(const bf16*)(ws + WS_XN), (const float*)(ws + WS_RMS), args.norm_mix_g, (bf16*)(ws + WS_H1)};
        pg8::gemm_phase<pg8::EpiH1, pg8::StaticOrder, true, false, false>(F.lds + RING_OFF, g, S, E, nullptr);
        if (IN(4)) router_table(F, args);
        if (BOTH(3)) GRID_BAR();
    }

    if (IN(4)) {
        REFRESH();
        if (!IN(3)) router_table(F, args);
        router_phase(F, args, blk, 0);
        p0_items(F, args, P0_I_IN + P0_I_O, P0_I_IN + P0_I_O + P0_I_GU);
        if (BOTH(4)) GRID_BAR();
    }

    if (IN(5)) {
        REFRESH();
        moe_meta(F);
        const LAS int* meta = (const LAS int*)(F.lds + META_OFF);
        LAS int* tokl = (LAS int*)(F.lds + TOKL_OFF);
        pg8::MoeOrder S{meta[97 + 32], F.G, blk, 8, meta + 97, meta + 32, meta + 64};
        { pg8::Unit u; const int* tokidx = (const int*)(ws + WS_TOKIDX);
          LAS float* epil = (LAS float*)(F.lds + EPIL_OFF);
          for (int ui = 0; ui < MAXU && S.next(ui, u); ++ui) { if (F.tid < 256) { const int r = u.rt * 256 + F.tid; tokl[ui * 256 + F.tid] = (r < meta[u.e]) ? tokidx[u.e * CAP + r] : 0; }
              else { const int t = F.tid - 256, pl = u.pn & 7; epil[ui * 256 + t] = args.b_gu[(size_t)u.e * 2048 + ((t < 128) ? (128 * pl + t) : (DFF + 128 * pl + (t - 128)))]; } } }
        __syncthreads();
        pg8::Gemm g{ws + WS_HN, ws + WS_WGU, M, 2 * DFF, D, D};
        pg8::EpiGU E{ws + WS_ACT, (const LAS float*)(F.lds + EPIL_OFF), 1.0f / (HN8_SCALE * W8_SCALE), ACT8_SCALE};
        pg8::gemm_phase<pg8::EpiGU, pg8::MoeOrder, MK_ALIGN5, true, true>(F.lds + RING_OFF, g, S, E, tokl);
        if (BOTH(5)) GRID_BAR();
    }

    if (IN(6)) {
        REFRESH();
        if (!IN(5)) moe_meta(F);
        const LAS int* meta = (const LAS int*)(F.lds + META_OFF);
        pg8::MoeOrder S{meta[130 + 32], F.G, blk, 4, meta + 130, meta + 32, meta + 64};
        LAS int* tokl = (LAS int*)(F.lds + TOKL_OFF);
        { pg8::Unit u; LAS float* epil = (LAS float*)(F.lds + EPIL_OFF); const float* gatew = (const float*)(ws + WS_GATEW);
          for (int ui = 0; ui < 6 && S.next(ui, u); ++ui) { if (F.tid < 256) { tokl[ui * 256 + F.tid] = u.pm * 256 + F.tid; epil[ui * 512 + F.tid] = args.b_down[(size_t)u.e * 1024 + (u.pn & 3) * 256 + F.tid]; }
              else { const int r = u.rt * 256 + (F.tid - 256); epil[ui * 512 + F.tid] = (r < meta[u.e]) ? gatew[(size_t)u.e * CAP + r] * Y8_SCALE : 0.0f; } } }
        __syncthreads();
        pg8::Gemm g{ws + WS_ACT, ws + WS_WD, M, D, DFF, DFF};
        pg8::EpiDown E{ws + WS_Y, (const LAS float*)(F.lds + EPIL_OFF), 1.0f / (ACT8_SCALE * W8_SCALE)};
        pg8::gemm_phase<pg8::EpiDown, pg8::MoeOrder, MK_ALIGN6, true, true>(F.lds + RING_OFF, g, S, E, tokl);
        if (BOTH(6)) GRID_BAR();
    }

    if (IN(7)) {
        REFRESH();
        if (!IN(6)) moe_meta(F);
        final_phase(F, args, blk);
    }
#undef IN
#undef BOTH
#undef GRID_BAR
}

#ifndef MK_STAGE
#define MK_STAGE 0
#endif
#ifndef MK_SPLIT
#define MK_SPLIT 0
#endif

#if MK_STAGE != 0
#endif

extern "C" void kernel_launch(void* const* d_in, const int* in_sizes, int n_in, void* d_out, int out_size, void* d_ws, size_t ws_size, hipStream_t stream) {
    static int grid = 0;
    if (grid == 0) {
        if (n_in != 18 || in_sizes[0] != M * D || out_size != M * D || ws_size < (size_t)1024 * MiB) { fprintf(stderr, "kernel_launch: unexpected shapes / workspace (n_in %d, ws %zu); nothing launched\n", n_in, ws_size); grid = -1; return; }
        int dev = 0, cus = 0, per_cu = 0;
        if (hipGetDevice(&dev) != hipSuccess || hipDeviceGetAttribute(&cus, hipDeviceAttributeMultiprocessorCount, dev) != hipSuccess) { grid = -1; return; }
        if (hipFuncSetAttribute((const void*)mega_fwd, hipFuncAttributeMaxDynamicSharedMemorySize, LDS_BYTES) != hipSuccess) { fprintf(stderr, "kernel_launch: hipFuncSetAttribute failed\n"); grid = -1; return; }
        if (hipOccupancyMaxActiveBlocksPerMultiprocessor(&per_cu, (const void*)mega_fwd, NWAVES * 64, LDS_BYTES) != hipSuccess || per_cu < 1) { fprintf(stderr, "kernel_launch: occupancy query says %d workgroups per CU\n", per_cu); }
        (void)hipGetLastError();
        grid = cus;
        if (grid != 256) { fprintf(stderr, "kernel_launch: built for a 256-CU device, found %d CUs; nothing launched\n", cus); grid = -1; return; }
    }
    if (grid < 0) return;
    if (hipMemsetAsync((char*)d_ws + WS_CTL, 0, CTL_ZERO_BYTES, stream) != hipSuccess) return;
    Args a{};
    a.x = (const float*)d_in[0]; a.norm_mix_g = (const float*)d_in[1]; a.w_in = (const float*)d_in[2]; a.b_f = (const float*)d_in[3]; a.b_glu = (const float*)d_in[4];
    a.w_dw = (const float*)d_in[5]; a.b_dw = (const float*)d_in[6]; a.ln_g = (const float*)d_in[7]; a.ln_b = (const float*)d_in[8]; a.w_out = (const float*)d_in[9];
    a.norm_ffn_g = (const float*)d_in[10]; a.w_router = (const float*)d_in[11]; a.b_router = (const float*)d_in[12]; a.w_gu = (const float*)d_in[13]; a.b_gu = (const float*)d_in[14];
    a.w_down = (const float*)d_in[15]; a.b_down = (const float*)d_in[16]; a.norm_final_g = (const float*)d_in[17];
    a.out = (float*)d_out; a.ws = (unsigned char*)d_ws; a.pad = 0;
    const int ph_end = (MK_STAGE == 0) ? NPHASE : (MK_STAGE + 1);
#if defined(MK_PREFILL)
    (void)hipMemsetAsync((char*)d_ws + WS_MIX, 0xFF, (size_t)M * D * 2, stream);
#endif
#if MK_SPLIT
    for (int p = 0; p < ph_end; ++p) { a.ph_lo = p; a.ph_hi = p + 1; a.li = p; hipLaunchKernelGGL(mega_fwd, dim3(grid), dim3(NWAVES * 64), LDS_BYTES, stream, a); }
#else
    a.ph_lo = 0; a.ph_hi = ph_end; a.li = 0;
    hipLaunchKernelGGL(mega_fwd, dim3(grid), dim3(NWAVES * 64), LDS_BYTES, stream, a);
#endif
#if MK_STAGE != 0
    orc::finish(MK_STAGE, a, stream);
#endif
}
```

```cpp
#include <hip/hip_runtime.h>
#include <hip/hip_bf16.h>
#include <cstdio>
#include <cstdint>
#include <cmath>
#define MK_VARIANT 0
#define MK_DBGSTAT 0
#define MK_ROWA 32
#define MK_ROWB 64
#define PG8_BAUX 0
#define MK_CONVSPLIT 0
#define MK_ALIGN5 true
#define MK_ALIGN6 true
namespace pg8 {
#define PG8_LAS __attribute__((address_space(3)))
typedef unsigned short bf16_t;
typedef short bf16x8 __attribute__((ext_vector_type(8)));
typedef float f32x4 __attribute__((ext_vector_type(4)));
typedef unsigned u32x4 __attribute__((ext_vector_type(4)));
constexpr int BM = 256, BK = 64, HALF = 128, HTB = HALF * BK * 2  , STAGE_BYTES = 8 * HTB, NXCD = 8, WGM = 8;

__host__ __device__ __forceinline__ int lds_byte(int r, int c) { const int st = (r >> 4) * 2 + (c >> 5), rr = r & 15, cc = c & 31, ob = rr * 64 + cc * 2; return st * 1024 + (ob ^ (((ob >> 9) & 1) << 5)); }
__host__ __device__ __forceinline__ void stage_rc(int b, int& R, int& C) { const int st = b / 1024, sb = b % 1024, swz = sb ^ (((sb >> 9) & 1) << 5); R = (st >> 1) * 16 + swz / 64; C = (st & 1) * 32 + (swz % 64) / 2; }
__host__ __device__ __forceinline__ int perm32(int rho) { const int n = rho >> 4, i = rho & 15; return 8 * (i >> 2) + 4 * n + (i & 3); }

struct Unit { int pm, pn, e, rt, seq; };
struct Gemm { const void* A; const void* Bt; int M, N, K, KB; };

struct StaticOrder {
    int nM, nN, nwg, G, c;
    __host__ __device__ void init(int M, int N, int G_, int c_) { nM = M / BM; nN = N / BM; nwg = nM * nN; G = G_; c = c_; }
    __host__ __device__ bool next(int i, Unit& u) const {
        const long L = (long)i * G + c; if (L >= nwg) return false;
        int wgid = (int)L; { const int q = nwg / NXCD, r = nwg % NXCD, xcd = wgid % NXCD, off = wgid / NXCD; wgid = (xcd < r ? xcd * (q + 1) : r * (q + 1) + (xcd - r) * q) + off; }
        const int nig = WGM * nN, gid = wgid / nig, fm = gid * WGM, gsz = (nM - fm) < WGM ? (nM - fm) : WGM;
        u.pm = fm + ((wgid % nig) % gsz); u.pn = (wgid % nig) / gsz; u.e = 0; u.rt = 0; return true;
    }
    __device__ __forceinline__ void a_ready(const Unit&) const {}
    __device__ __forceinline__ void done(const Unit&) const {}
};

__device__ __forceinline__ unsigned cvt_pk_bf16(float lo, float hi) { unsigned r; asm volatile("v_cvt_pk_bf16_f32 %0, %1, %2" : "=v"(r) : "v"(lo), "v"(hi)); return r; }
__device__ __forceinline__ float sigmoid_f(float x) { return __builtin_amdgcn_rcpf(1.0f + __builtin_amdgcn_exp2f(-1.4426950408889634f * x)); }
typedef int i32x4 __attribute__((ext_vector_type(4))); typedef int i32x8 __attribute__((ext_vector_type(8))); typedef unsigned u32x2 __attribute__((ext_vector_type(2)));
__device__ __forceinline__ float clamp448(float x) { return fminf(fmaxf(x, -448.0f), 448.0f); }
__device__ __forceinline__ unsigned pk4_fp8(float a, float b, float c, float d) { int w = __builtin_amdgcn_cvt_pk_fp8_f32(clamp448(a), clamp448(b), 0, false); w = __builtin_amdgcn_cvt_pk_fp8_f32(clamp448(c), clamp448(d), w, true); return (unsigned)w; }
__device__ __forceinline__ unsigned pk4_fp8_nc(float a, float b, float c, float d) { int w = __builtin_amdgcn_cvt_pk_fp8_f32(a, b, 0, false); w = __builtin_amdgcn_cvt_pk_fp8_f32(c, d, w, true); return (unsigned)w; }
__device__ __forceinline__ u32x4 pack8(f32x4 v0, f32x4 v1) { u32x4 w; w.x = cvt_pk_bf16(v0[0], v0[1]); w.y = cvt_pk_bf16(v0[2], v0[3]); w.z = cvt_pk_bf16(v1[0], v1[1]); w.w = cvt_pk_bf16(v1[2], v1[3]); return w; }

struct EpiProj {
    static constexpr bool PERM = true, AFTER_DRAIN = false;
    bf16_t *Q, *U; size_t qkv_stride  ; const PG8_LAS float* bglu  ; float qscale; unsigned* nrm;
    __device__ __forceinline__ void operator()(const f32x4 (&acc)[2][2][4][2], const Unit& u, int wr, int wc, int fr, int fq) const {
        const int row0 = u.pm * BM + wr * 64 + fr;
        if (u.pn < 6) {
            const int t = u.pn >> 1; bf16_t* base = Q + (size_t)t * qkv_stride; const float sc = (t == 0) ? qscale : 1.0f;
            const int col0 = (u.pn & 1) * 256 + wc * 32 + 8 * fq;
#pragma unroll
            for (int ai = 0; ai < 2; ++ai)
#pragma unroll
                for (int m = 0; m < 4; ++m) { bf16_t* rowp = base + (size_t)(row0 + ai * HALF + m * 16) * 512 + col0;
#pragma unroll
                    for (int bj = 0; bj < 2; ++bj) *(u32x4*)(rowp + bj * HALF) = pack8(acc[ai][bj][m][0] * sc, acc[ai][bj][m][1] * sc); }
            if (t < 2) {
#pragma unroll
                for (int bj = 0; bj < 2; ++bj) { float mx = 0.f;
#pragma unroll
                    for (int ai = 0; ai < 2; ++ai)
#pragma unroll
                        for (int m = 0; m < 4; ++m) { const f32x4 a0 = acc[ai][bj][m][0] * sc, a1 = acc[ai][bj][m][1] * sc;
                            float s = (a0[0] * a0[0] + a0[1] * a0[1]) + (a0[2] * a0[2] + a0[3] * a0[3]) + (a1[0] * a1[0] + a1[1] * a1[1]) + (a1[2] * a1[2] + a1[3] * a1[3]);
                            s += __shfl_xor(s, 16); s += __shfl_xor(s, 32); mx = fmaxf(mx, s); }
#pragma unroll
                    for (int o = 1; o < 16; o <<= 1) mx = fmaxf(mx, __shfl_xor(mx, o));
                    if (fr == 0 && fq == 0) { const int head = (u.pn & 1) * 4 + bj * 2 + (wc >> 1), bh = (u.pm >> 5) * 8 + head;
                        __hip_atomic_fetch_max(nrm + (size_t)(((t * 16 + bh) * 2 + (wc & 1)) * 64), __builtin_bit_cast(unsigned, mx), __ATOMIC_RELAXED, __HIP_MEMORY_SCOPE_AGENT); } } }
        } else {
            const int ch0 = (u.pn - 6) * 128 + wc * 32 + 8 * fq;
            f32x4 ba[2], bg[2];
#pragma unroll
            for (int n = 0; n < 2; ++n) { ba[n] = *(const PG8_LAS f32x4*)(bglu + ch0 + 4 * n); bg[n] = *(const PG8_LAS f32x4*)(bglu + 512 + ch0 + 4 * n); }
#pragma unroll
            for (int ai = 0; ai < 2; ++ai)
#pragma unroll
                for (int m = 0; m < 4; ++m) { f32x4 o[2];
#pragma unroll
                    for (int n = 0; n < 2; ++n) { const f32x4 a = acc[ai][0][m][n] + ba[n], g = acc[ai][1][m][n] + bg[n];
#pragma unroll
                        for (int j = 0; j < 4; ++j) o[n][j] = a[j] * sigmoid_f(g[j]); }
                    *(u32x4*)(U + (size_t)(row0 + ai * HALF + m * 16) * 512 + ch0) = pack8(o[0], o[1]); }
        }
    }
};
struct EpiH1 {
    static constexpr bool PERM = true, AFTER_DRAIN = false;
    const bf16_t* xn; const float* rms; const float* g; bf16_t* h1;
    __device__ __forceinline__ void operator()(const f32x4 (&acc)[2][2][4][2], const Unit& u, int wr, int wc, int fr, int fq) const {
        const int row0 = u.pm * BM + wr * 64 + fr, col0 = u.pn * BM + wc * 32 + 8 * fq;
        f32x4 gi[2][2];
#pragma unroll
        for (int bj = 0; bj < 2; ++bj)
#pragma unroll
            for (int n = 0; n < 2; ++n) { const f32x4 gv = *(const f32x4*)(g + col0 + bj * HALF + 4 * n);
                gi[bj][n] = (f32x4){__builtin_amdgcn_rcpf(gv[0]), __builtin_amdgcn_rcpf(gv[1]), __builtin_amdgcn_rcpf(gv[2]), __builtin_amdgcn_rcpf(gv[3])}; }
#pragma unroll
        for (int ai = 0; ai < 2; ++ai) {
            u32x4 xb[4][2]; float rr[4];
#pragma unroll
            for (int m = 0; m < 4; ++m) { const int row = row0 + ai * HALF + m * 16; rr[m] = rms[row];
#pragma unroll
                for (int bj = 0; bj < 2; ++bj) xb[m][bj] = *(const u32x4*)(xn + (size_t)row * 1024 + col0 + bj * HALF); }
            __builtin_amdgcn_sched_barrier(0);
#pragma unroll
            for (int m = 0; m < 4; ++m)
#pragma unroll
                for (int bj = 0; bj < 2; ++bj) { const int row = row0 + ai * HALF + m * 16; const size_t p = (size_t)row * 1024 + col0 + bj * HALF;
                    const u32x4 b = xb[m][bj]; const float r = rr[m];
                    const f32x4 x0 = (f32x4){__builtin_bit_cast(float, b.x << 16), __builtin_bit_cast(float, b.x & 0xffff0000u), __builtin_bit_cast(float, b.y << 16), __builtin_bit_cast(float, b.y & 0xffff0000u)} * r * gi[bj][0];
                    const f32x4 x1 = (f32x4){__builtin_bit_cast(float, b.z << 16), __builtin_bit_cast(float, b.z & 0xffff0000u), __builtin_bit_cast(float, b.w << 16), __builtin_bit_cast(float, b.w & 0xffff0000u)} * r * gi[bj][1];
                    *(u32x4*)(h1 + p) = pack8(acc[ai][bj][m][0] + x0, acc[ai][bj][m][1] + x1); }
            __builtin_amdgcn_sched_barrier(0);
        }
    }
};
struct EpiGU {
    static constexpr bool PERM = true, AFTER_DRAIN = false;
    unsigned char* act; const PG8_LAS float* tab  ; float acc_scale, out_scale;
    __device__ __forceinline__ void operator()(const f32x4 (&acc)[2][2][4][2], const Unit& u, int wr, int wc, int fr, int fq) const {
        const int row0 = u.pm * BM + wr * 64 + fr, pl = u.pn & 7, ch0 = pl * 128 + wc * 32 + 8 * fq;
        const PG8_LAS float* bp = tab + u.seq * 256 + wc * 32 + 8 * fq;
        f32x4 bgt[2], bup[2];
#pragma unroll
        for (int n = 0; n < 2; ++n) { bgt[n] = *(const PG8_LAS f32x4*)(bp + 4 * n); bup[n] = *(const PG8_LAS f32x4*)(bp + 128 + 4 * n); }
#pragma unroll
        for (int ai = 0; ai < 2; ++ai)
#pragma unroll
            for (int m = 0; m < 4; ++m) { f32x4 o[2];
#pragma unroll
                for (int n = 0; n < 2; ++n) { const f32x4 g = acc[ai][0][m][n] * acc_scale + bgt[n], up = acc[ai][1][m][n] * acc_scale + bup[n];
#pragma unroll
                    for (int j = 0; j < 4; ++j) { const float hg = fminf(g[j], 7.0f), hu = fminf(fmaxf(up[j], -7.0f), 7.0f);
                        o[n][j] = fmaf(hu, out_scale, out_scale) * (hg * __builtin_amdgcn_rcpf(1.0f + __builtin_amdgcn_exp2f(hg * (-1.702f * 1.4426950408889634f)))); } }
                u32x2 w; w.x = pk4_fp8_nc(o[0][0], o[0][1], o[0][2], o[0][3]); w.y = pk4_fp8_nc(o[1][0], o[1][1], o[1][2], o[1][3]);
                *(u32x2*)(act + (size_t)(row0 + ai * HALF + m * 16) * 1024 + ch0) = w; }
    }
};
struct EpiDown {
    static constexpr bool PERM = true, AFTER_DRAIN = false;
    unsigned char* y; const PG8_LAS float* tab  ; float acc_scale;
    __device__ __forceinline__ void operator()(const f32x4 (&acc)[2][2][4][2], const Unit& u, int wr, int wc, int fr, int fq) const {
        const int r0 = wr * 64 + fr, pl = u.pn & 3, col0 = pl * 256 + wc * 32 + 8 * fq;
        const PG8_LAS float* tp = tab + u.seq * 512; const PG8_LAS float* bp = tp + wc * 32 + 8 * fq;
        f32x4 bv[2][2];
#pragma unroll
        for (int bj = 0; bj < 2; ++bj)
#pragma unroll
            for (int n = 0; n < 2; ++n) bv[bj][n] = *(const PG8_LAS f32x4*)(bp + bj * HALF + 4 * n);
#pragma unroll
        for (int ai = 0; ai < 2; ++ai)
#pragma unroll
            for (int m = 0; m < 4; ++m) { const int r = r0 + ai * HALF + m * 16; const float gt = tp[256 + r];
                unsigned char* rowp = y + (size_t)(u.pm * BM + r) * 1024 + col0;
#pragma unroll
                for (int bj = 0; bj < 2; ++bj) { const f32x4 v0 = (acc[ai][bj][m][0] * acc_scale + bv[bj][0]) * gt, v1 = (acc[ai][bj][m][1] * acc_scale + bv[bj][1]) * gt;
                    u32x2 w; w.x = pk4_fp8(v0[0], v0[1], v0[2], v0[3]); w.y = pk4_fp8(v1[0], v1[1], v1[2], v1[3]); *(u32x2*)(rowp + bj * HALF) = w; } }
    }
};

struct MoeOrder {
    int nwg, G, c, NPN; const PG8_LAS int* ustart; const PG8_LAS int* ntile; const PG8_LAS int* tileoff;
    __device__ __forceinline__ bool next(int i, Unit& u) const {
        const int L = i * G + c; if (L >= nwg) return false;
        int wgid = L; { const int q = nwg / NXCD, r = nwg % NXCD, xcd = wgid % NXCD, off = wgid / NXCD; wgid = (xcd < r ? xcd * (q + 1) : r * (q + 1) + (xcd - r) * q) + off; }
        int e = 0;
        for (int k = 1; k < 32; ++k) e += (ustart[k] <= wgid) ? 1 : 0;
        e = __builtin_amdgcn_readfirstlane(e);
        const int l = wgid - ustart[e], rt = l / NPN, pl = l - rt * NPN;
        u.pm = __builtin_amdgcn_readfirstlane(tileoff[e] + rt); u.pn = __builtin_amdgcn_readfirstlane(e * NPN + pl); u.e = e; u.rt = __builtin_amdgcn_readfirstlane(rt); return true;
    }
    __device__ __forceinline__ void a_ready(const Unit&) const {}
    __device__ __forceinline__ void done(const Unit&) const {}
};

#ifndef PG8_BAUX
#define PG8_BAUX 0
#endif
template <class Epi, class Sched, bool ALIGN_EPI, bool GATHER, bool F8>
__device__ __forceinline__ void gemm_phase(PG8_LAS unsigned char* lds, const Gemm g, const Sched& S, const Epi& E, const PG8_LAS int* tokl) {
    const int tid = threadIdx.x, wid = __builtin_amdgcn_readfirstlane(tid >> 6), lane = tid & 63, wr = wid >> 2, wc = wid & 3, fr = lane & 15, fq = lane >> 4;
    const int KB = g.KB, nt = KB / 128;
    unsigned voffB[2];
#pragma unroll
    for (int i = 0; i < 2; ++i) { int R, C; stage_rc(tid * 16 + i * 8192, R, C); const int Rb = Epi::PERM ? ((R & ~31) + perm32(R & 31)) : R;
        voffB[i] = (unsigned)(Rb * KB + C * 2); }
    const size_t kstep = (size_t)(BK * 2);
    const size_t hstep = (size_t)HALF * KB;
    const size_t tstep = 2 * hstep;
    const unsigned ldsw = (unsigned)wid * 1024u;
    const int aoff = lds_byte(wr * 64 + fr, fq * 8), boff = lds_byte(wc * 32 + fr, fq * 8);
#define PG8_SA(b, h) (((b) * 2 + (h)) * HTB)
#define PG8_SB(b, h) ((4 + (b) * 2 + (h)) * HTB)
#define PG8_STAGE(bufoff, gbase, voff) do { _Pragma("unroll") for (int _i = 0; _i < 2; ++_i) \
        __builtin_amdgcn_global_load_lds((const unsigned*)((const char*)(gbase) + (voff)[_i]), (PG8_LAS unsigned*)(lds + (bufoff) + ldsw + _i * 8192), 16, 0, 0); } while (0)
#define PG8_STAGEB(bufoff, gbase, voff) do { _Pragma("unroll") for (int _i = 0; _i < 2; ++_i) \
        __builtin_amdgcn_global_load_lds((const unsigned*)((const char*)(gbase) + (voff)[_i]), (PG8_LAS unsigned*)(lds + (bufoff) + ldsw + _i * 8192), 16, 0, PG8_BAUX); } while (0)
#define PG8_LDA(dst, b, h) do { _Pragma("unroll") for (int m = 0; m < 4; ++m) _Pragma("unroll") for (int k = 0; k < 2; ++k) dst[m][k] = *(const PG8_LAS bf16x8*)(lds + PG8_SA(b, h) + aoff + m * 2048 + k * 1024); } while (0)
#define PG8_LDB(dst, b, h) do { _Pragma("unroll") for (int n = 0; n < 2; ++n) _Pragma("unroll") for (int k = 0; k < 2; ++k) dst[n][k] = *(const PG8_LAS bf16x8*)(lds + PG8_SB(b, h) + boff + n * 2048 + k * 1024); } while (0)
#define PG8_CAT(X) __builtin_shufflevector(__builtin_bit_cast(i32x4, (X)[0]), __builtin_bit_cast(i32x4, (X)[1]), 0, 1, 2, 3, 4, 5, 6, 7)
#define PG8_MMA(ai, bj, At, Bt) do { __builtin_amdgcn_s_setprio(1); if constexpr (F8) { _Pragma("unroll") for (int m = 0; m < 4; ++m) _Pragma("unroll") for (int n = 0; n < 2; ++n) \
        acc[ai][bj][m][n] = __builtin_amdgcn_mfma_scale_f32_16x16x128_f8f6f4(PG8_CAT(Bt[n]), PG8_CAT(At[m]), acc[ai][bj][m][n], 0, 0, 0, 0x7f7f7f7f, 0, 0x7f7f7f7f); } else { \
        _Pragma("unroll") for (int m = 0; m < 4; ++m) _Pragma("unroll") for (int n = 0; n < 2; ++n) _Pragma("unroll") for (int k = 0; k < 2; ++k) \
        acc[ai][bj][m][n] = __builtin_amdgcn_mfma_f32_16x16x32_bf16(Bt[n][k], At[m][k], acc[ai][bj][m][n], 0, 0, 0); } __builtin_amdgcn_s_setprio(0); } while (0)
#define PG8_WAIT_V(n) asm volatile("s_waitcnt vmcnt(" #n ")" ::: "memory")
#define PG8_WAIT_L(n) asm volatile("s_waitcnt lgkmcnt(" #n ")" ::: "memory")
#define PG8_BAR __builtin_amdgcn_s_barrier()
#define PG8_SCHED __builtin_amdgcn_sched_barrier(0)
#define PG8_SETOFF(V, UIDX) do { _Pragma("unroll") for (int _i = 0; _i < 2; ++_i) { int _R, _C; { int _t = threadIdx.x; asm volatile("" : "+v"(_t)); stage_rc(_t * 16 + _i * 8192, _R, _C); } \
        _Pragma("unroll") for (int _h = 0; _h < 2; ++_h) { const unsigned _r = GATHER ? (unsigned)tokl[(UIDX) * 256 + _h * HALF + _R] : (unsigned)(_h * HALF + _R); V[_h][_i] = _r * (unsigned)KB + (unsigned)(_C * 2); } } } while (0)
    Unit cur, nxt; int ui = 0;
    if (!S.next(0, cur)) return;
    cur.seq = 0;
    f32x4 acc[2][2][4][2];
#pragma unroll
    for (int a = 0; a < 2; ++a)
#pragma unroll
        for (int b = 0; b < 2; ++b)
#pragma unroll
            for (int m = 0; m < 4; ++m)
#pragma unroll
                for (int n = 0; n < 2; ++n) acc[a][b][m][n] = (f32x4){0.f, 0.f, 0.f, 0.f};
    bf16x8 At[4][2], B0[2][2], B1[2][2];
    unsigned voA[2][2];
    const char* cA = GATHER ? (const char*)g.A : (const char*)g.A + (size_t)cur.pm * tstep; const char* cB = (const char*)g.Bt + (size_t)cur.pn * tstep;
    PG8_SETOFF(voA, 0);
    S.a_ready(cur);
    PG8_STAGEB(PG8_SB(0, 0), cB, voffB); PG8_STAGEB(PG8_SB(0, 1), cB + hstep, voffB); PG8_STAGE(PG8_SA(0, 0), cA, voA[0]); PG8_STAGE(PG8_SA(0, 1), cA, voA[1]);
    if (wr == 1) PG8_BAR;
    PG8_WAIT_V(2); PG8_BAR;
    PG8_STAGEB(PG8_SB(1, 0), cB + kstep, voffB); PG8_STAGE(PG8_SA(1, 0), cA + kstep, voA[0]); PG8_STAGEB(PG8_SB(1, 1), cB + hstep + kstep, voffB);
    PG8_WAIT_V(6); PG8_BAR;
    for (;;) {
        const bool has_next = S.next(ui + 1, nxt);
        const char* nA = has_next ? (GATHER ? (const char*)g.A : (const char*)g.A + (size_t)nxt.pm * tstep) : cA; const char* nB = has_next ? (const char*)g.Bt + (size_t)nxt.pn * tstep : cB;
#pragma clang loop unroll(disable)
        for (int t = 0; t < nt; t += 2) {
            const bool last = (t == nt - 2);
            const char* a1 = cA + (size_t)(t + 1) * kstep;
            const char* a2 = last ? nA : cA + (size_t)(t + 2) * kstep; const char* b2 = last ? nB : cB + (size_t)(t + 2) * kstep;
            const char* a3 = a2 + kstep; const char* b3 = b2 + kstep;
            if (last && has_next) S.a_ready(nxt);
            PG8_LDB(B0, 0, 0); PG8_LDB(B1, 0, 1); PG8_SCHED; PG8_LDA(At, 0, 0); PG8_STAGE(PG8_SA(1, 1), a1, voA[1]);
            if (GATHER && last && has_next) { PG8_SETOFF(voA, ui + 1); }
            PG8_WAIT_V(8); PG8_WAIT_L(0); PG8_BAR; PG8_MMA(0, 0, At, B0); PG8_MMA(0, 1, At, B1); PG8_BAR; PG8_SCHED;
            PG8_LDA(At, 0, 1); PG8_STAGEB(PG8_SB(0, 0), b2, voffB); PG8_STAGEB(PG8_SB(0, 1), b2 + hstep, voffB); PG8_STAGE(PG8_SA(0, 0), a2, voA[0]);
            PG8_WAIT_V(8); PG8_WAIT_L(0); PG8_BAR; PG8_MMA(1, 0, At, B0); PG8_MMA(1, 1, At, B1); PG8_BAR; PG8_SCHED;
            PG8_LDB(B0, 1, 0); PG8_LDB(B1, 1, 1); PG8_SCHED; PG8_LDA(At, 1, 0); PG8_STAGE(PG8_SA(0, 1), a2, voA[1]);
            PG8_WAIT_V(8); PG8_WAIT_L(0); PG8_BAR; PG8_MMA(0, 0, At, B0); PG8_MMA(0, 1, At, B1); PG8_BAR; PG8_SCHED;
            PG8_LDA(At, 1, 1); PG8_STAGEB(PG8_SB(1, 0), b3, voffB); PG8_STAGEB(PG8_SB(1, 1), b3 + hstep, voffB); PG8_STAGE(PG8_SA(1, 0), a3, voA[0]);
            PG8_WAIT_V(8); PG8_WAIT_L(0); PG8_BAR; PG8_MMA(1, 0, At, B0); PG8_MMA(1, 1, At, B1); PG8_BAR; PG8_SCHED;
        }
        if constexpr (ALIGN_EPI) { if (wr == 0) PG8_BAR; }
        E(acc, cur, wr, wc, fr, fq); S.done(cur);
        if (!has_next) break;
#pragma unroll
        for (int a = 0; a < 2; ++a)
#pragma unroll
            for (int b = 0; b < 2; ++b)
#pragma unroll
                for (int m = 0; m < 4; ++m)
#pragma unroll
                    for (int n = 0; n < 2; ++n) acc[a][b][m][n] = (f32x4){0.f, 0.f, 0.f, 0.f};
        cur = nxt; cA = nA; cB = nB; ++ui; cur.seq = ui;
        if constexpr (ALIGN_EPI) { if (wr == 1) PG8_BAR; }
    }
    PG8_WAIT_V(0);
    if constexpr (!ALIGN_EPI) { if (wr == 0) PG8_BAR; }
    PG8_BAR;
#undef PG8_SA
#undef PG8_SB
#undef PG8_STAGE
#undef PG8_STAGEB
#undef PG8_LDA
#undef PG8_LDB
#undef PG8_MMA
#undef PG8_CAT
#undef PG8_WAIT_V
#undef PG8_WAIT_L
#undef PG8_BAR
#undef PG8_SCHED
#undef PG8_SETOFF
}
}
namespace attn_body {
using bf16=__hip_bfloat16;
using bf16x8=__attribute__((ext_vector_type(8)))short;
using s16x4=__attribute__((ext_vector_type(4)))short;
using f32x16=__attribute__((ext_vector_type(16)))float;
using u32x4=__attribute__((ext_vector_type(4)))unsigned;
using f32x4_t=__attribute__((ext_vector_type(4)))float;
constexpr int BATCH=2,NHEAD=8,SEQ=8192,D=64,DM=NHEAD*D,OPITCH=1024;
constexpr int NW=8,QBLK=32,QB=QBLK*NW,KVBLK=64,NQB=SEQ/QB;
constexpr int ATTN_PITCH=DM, ATTN_UNIT_ROWS=QB;
__device__ __forceinline__ int crow(int r,int hi){return (r&3)+8*(r>>2)+4*hi;}
#define SBAR() __builtin_amdgcn_sched_barrier(0)
__device__ __forceinline__ void cmask(f32x16&p0,f32x16&p1,int jb,int qrel,int hi){
  const float NEG=-INFINITY; int kb=64*jb+4*hi;
  #pragma unroll
  for(int r=0;r<16;++r){int kv=kb+(r&3)+8*(r>>2); if(kv>qrel)p0[r]=NEG; if(kv+32>qrel)p1[r]=NEG;}
}

constexpr int NSLOT=3, SLOTB=8192;
constexpr int LDS_K=0, LDS_V=NSLOT*SLOTB, LDS_WS=2*NSLOT*SLOTB, LDS_OST=LDS_WS+NW*64*4, LDS_C=LDS_OST+NW*4096, LDS_BYTES=LDS_C+SEQ*4;
constexpr float C2=0.125f*1.4426950408889634f;
__device__ __forceinline__ void glds16(const void*gsrc,unsigned lds_dst){unsigned keep;
  asm volatile("s_mov_b32 %0, m0\n\ts_mov_b32 m0, %2\n\ts_nop 0\n\tglobal_load_lds_dwordx4 %1, off\n\ts_mov_b32 m0, %0":"=&s"(keep):"v"(gsrc),"s"(lds_dst):"memory");}
__device__ __forceinline__ float max3f(float a,float b,float c){float r;asm("v_max3_f32 %0, %1, %2, %3":"=v"(r):"v"(a),"v"(b),"v"(c));return r;}
__device__ __forceinline__ float max2f(float a,float b){float r;asm("v_max_f32_e32 %0, %1, %2":"=v"(r):"v"(a),"v"(b));return r;}
__device__ __forceinline__ float fadd_s(float a,float b){float r;asm("v_add_f32_e32 %0, %1, %2":"=v"(r):"v"(a),"v"(b));return r;}
__device__ __forceinline__ float fsub_s(float a,float b){float r;asm("v_sub_f32_e32 %0, %1, %2":"=v"(r):"v"(a),"v"(b));return r;}
typedef float f32x2_t __attribute__((ext_vector_type(2))); typedef __bf16 bf16x2_t __attribute__((ext_vector_type(2)));
__device__ __forceinline__ unsigned cvtpk_s(float lo,float hi){f32x2_t v={lo,hi};bf16x2_t b=__builtin_convertvector(v,bf16x2_t);return __builtin_bit_cast(unsigned,b);}
#define WAIT_BAR(N) asm volatile("s_waitcnt vmcnt(" #N ") lgkmcnt(0)\n\ts_barrier":::"memory")

__device__ __forceinline__ void qkt(f32x16&p0,f32x16&p1,const char*Kslot,const bf16x8*qr,const f32x16&c0,const f32x16&c1,int r32,int hi){
  const char*kb=Kslot+hi*1024+r32*16;
  #pragma unroll
  for(int d0=0;d0<4;++d0){
    const bf16x8 b0=*reinterpret_cast<const bf16x8*>(kb+d0*2048);
    const bf16x8 b1=*reinterpret_cast<const bf16x8*>(kb+d0*2048+512);
    if(d0==0){p0=__builtin_amdgcn_mfma_f32_32x32x16_bf16(b0,qr[0],c0,0,0,0);p1=__builtin_amdgcn_mfma_f32_32x32x16_bf16(b1,qr[0],c1,0,0,0);}
    else{p0=__builtin_amdgcn_mfma_f32_32x32x16_bf16(b0,qr[d0],p0,0,0,0);p1=__builtin_amdgcn_mfma_f32_32x32x16_bf16(b1,qr[d0],p1,0,0,0);}}
}
typedef __attribute__((address_space(3))) const char* lds_cptr;
typedef short v4i16_t __attribute__((ext_vector_type(4)));
__device__ __forceinline__ void kload8(bf16x8*kf,lds_cptr kp){
  kf[0]=*(const __attribute__((address_space(3))) bf16x8*)(kp);      kf[1]=*(const __attribute__((address_space(3))) bf16x8*)(kp+512);
  kf[2]=*(const __attribute__((address_space(3))) bf16x8*)(kp+2048); kf[3]=*(const __attribute__((address_space(3))) bf16x8*)(kp+2560);
  kf[4]=*(const __attribute__((address_space(3))) bf16x8*)(kp+4096); kf[5]=*(const __attribute__((address_space(3))) bf16x8*)(kp+4608);
  kf[6]=*(const __attribute__((address_space(3))) bf16x8*)(kp+6144); kf[7]=*(const __attribute__((address_space(3))) bf16x8*)(kp+6656);
}
__device__ __forceinline__ void kload2(bf16x8*kf,lds_cptr kp,int j){ kf[2*j]=*(const __attribute__((address_space(3))) bf16x8*)(kp+j*2048); kf[2*j+1]=*(const __attribute__((address_space(3))) bf16x8*)(kp+j*2048+512); }
__device__ __forceinline__ s16x4 vtr(lds_cptr p){ return __builtin_bit_cast(s16x4,__builtin_amdgcn_ds_read_tr16_b64_v4i16((__attribute__((address_space(3))) v4i16_t*)p)); }
__device__ __forceinline__ float rowmax(const f32x16&p0,const f32x16&p1){
  float a=max3f(p0[0],p0[1],p1[0]),b=max3f(p0[2],p0[3],p1[1]);a=max3f(a,p1[2],p1[3]);
  #pragma unroll
  for(int r=4;r<16;r+=4){a=max3f(a,p0[r],p0[r+1]);b=max3f(b,p0[r+2],p0[r+3]);a=max3f(a,p1[r],p1[r+1]);b=max3f(b,p1[r+2],p1[r+3]);}
  const float m=max2f(a,b);
  auto rr=__builtin_amdgcn_permlane32_swap(__float_as_uint(m),__float_as_uint(m),false,false);
  return max2f(__uint_as_float(rr[0]),__uint_as_float(rr[1]));
}
__device__ __forceinline__ void pv(f32x16*o,int vb,bf16x8 pa0,bf16x8 pa1,bf16x8 pa2,bf16x8 pa3){
  #pragma unroll
  for(int d0=0;d0<2;++d0){s16x4 lo[4],hi[4];
    #pragma unroll
    for(int ks=0;ks<4;++ks){
      asm volatile("ds_read_b64_tr_b16 %0,%1 offset:%c2":"=&v"(lo[ks]):"v"(vb),"i"(d0*4096+ks*1024):"memory");
      asm volatile("ds_read_b64_tr_b16 %0,%1 offset:%c2":"=&v"(hi[ks]):"v"(vb),"i"(d0*4096+ks*1024+512):"memory");}
    asm volatile("s_waitcnt lgkmcnt(0)":::"memory");SBAR();
    #define PK(k) (bf16x8){lo[k][0],lo[k][1],lo[k][2],lo[k][3],hi[k][0],hi[k][1],hi[k][2],hi[k][3]}
    o[d0]=__builtin_amdgcn_mfma_f32_32x32x16_bf16(pa0,PK(0),o[d0],0,0,0);
    o[d0]=__builtin_amdgcn_mfma_f32_32x32x16_bf16(pa1,PK(1),o[d0],0,0,0);
    o[d0]=__builtin_amdgcn_mfma_f32_32x32x16_bf16(pa2,PK(2),o[d0],0,0,0);
    o[d0]=__builtin_amdgcn_mfma_f32_32x32x16_bf16(pa3,PK(3),o[d0],0,0,0);
    #undef PK
  }
}

#ifndef ATTN_STORE16
#define ATTN_STORE16(p,v) (*(u32x4*)(p)=(v))
#endif
template<int THRL> __device__ __forceinline__ void attn_unit(int b,int h,int qb,const bf16*Q,const bf16*__restrict__ K,const bf16*__restrict__ V,bf16*O,const float*__restrict__ CP,const unsigned*__restrict__ NRM,char*shm){
  const int tid=threadIdx.x,lane=tid&63,r32=lane&31,hi=lane>>5; const int wid=__builtin_amdgcn_readfirstlane(tid>>6);
  const long rowbase=(long)b*SEQ; const int q0=qb*QB;
  const bf16*Qw=Q+(rowbase+q0+wid*QBLK)*DM+h*D;
  const bf16*Kh=K+rowbase*DM+h*D,*Vh=V+rowbase*DM+h*D;
  const unsigned lds0=(unsigned)(uintptr_t)shm;
  const lds_cptr shm3=(lds_cptr)shm;
  float*wsf=(float*)(shm+LDS_WS)+wid*64;
  const bf16*ksrc=Kh+(long)lane*DM+wid*8;
  const bf16*vsrc=Vh+(long)(16*(wid&3)+(lane>>2))*DM+(wid>>2)*32+(lane&3)*8;
  const unsigned kdst=lds0+LDS_K+wid*1024, vdst=lds0+LDS_V+wid*1024;
  #define DMA_K(t,slot) glds16(ksrc+(long)TIDX(t)*KVBLK*DM,(unsigned)__builtin_amdgcn_readfirstlane(kdst+(slot)))
  #define DMA_V(t,slot) glds16(vsrc+(long)TIDX(t)*KVBLK*DM,(unsigned)__builtin_amdgcn_readfirstlane(vdst+(slot)))
  const int vb0=(int)(lds0+LDS_V)+((lane>>4)&1)*32+(lane&3)*8+(4*hi+((lane&15)>>2))*64;
  const char*Kbase=shm+LDS_K; bf16x8 kf[8];
  const lds_cptr kp0=shm3+LDS_K+hi*1024+r32*16; const lds_cptr vp0=shm3+LDS_V+((lane>>4)&1)*32+(lane&3)*8+(4*hi+((lane&15)>>2))*64;
  const int NT=(q0+QB)/KVBLK;
#if defined(ATT_ORIGORDER)
  #define TIDX(p) (p)
  #define JBOF(t) ((t)-(NT-4))
#else
  #define TIDX(p) (((p)<4)?(NT-4+(p)):(NT-1-(p)))
  #define JBOF(t) (((t)<4)?(t):-1)
#endif
  const float*cg=CP+(long)(b*NHEAD+h)*SEQ;
  typedef __attribute__((address_space(3))) const f32x4_t* lds_c4;
#if !defined(ATT_NOSTAGE)
  { float*cl=(float*)(shm+LDS_C); const int nk=q0+QB; for(int i=tid*4;i<nk;i+=NW*64*4)*(f32x4_t*)(cl+i)=*(const f32x4_t*)(cg+i); }
#endif
  const lds_c4 cl4=(lds_c4)(shm3+LDS_C)+hi;
#if defined(ATT_NOBIAS)
  #define CBIAS(C0,C1,a) do{ _Pragma("unroll") for(int g_=0;g_<16;++g_){ C0[g_]=nm; C1[g_]=nm; } }while(0)
#else
  #define CBIAS(C0,C1,a) do{ const lds_c4 cp_=cl4+16*(a); _Pragma("unroll") for(int g_=0;g_<4;++g_){ const f32x4_t v_=cp_[2*g_], w_=cp_[8+2*g_]; \
      C0[4*g_]=nm-v_[0];C0[4*g_+1]=nm-v_[1];C0[4*g_+2]=nm-v_[2];C0[4*g_+3]=nm-v_[3]; C1[4*g_]=nm-w_[0];C1[4*g_+1]=nm-w_[1];C1[4*g_+2]=nm-w_[2];C1[4*g_+3]=nm-w_[3]; } }while(0)
#endif
  DMA_K(0,0);DMA_V(0,0);DMA_K(1,SLOTB);
  bf16x8 qr[4];
  #pragma unroll
  for(int d0=0;d0<4;++d0)qr[d0]=*reinterpret_cast<const bf16x8*>(&Qw[(long)r32*DM+d0*16+hi*8]);
  #if defined(ATT_NOBIAS)
  float l_reg=0.f,nm=0.f;
#else
  float l_reg=0.f,nm=cg[q0+wid*QBLK+r32];
#endif
  f32x16 o[2];o[0]=f32x16{};o[1]=f32x16{};
  const int qrel=wid*QBLK+r32;
  #define CMASK(P0,P1,t) do{int jb_=JBOF(t); if(jb_>=0)cmask(P0,P1,jb_,qrel,hi);}while(0)
  bool resc=false;
  #define START(P0,P1) do{ const float rm=rowmax(P0,P1); resc=false; \
    { const float dl=rm; \
      _Pragma("unroll") for(int r=0;r<16;++r){P0[r]=fsub_s(P0[r],dl);P1[r]=fsub_s(P1[r],dl);} \
      nm=fsub_s(nm,dl); } \
    _Pragma("unroll") for(int r=0;r<16;++r)P0[r]=__builtin_amdgcn_exp2f(P0[r]); }while(0)
  #define RESC() do{ if(resc){ asm volatile("s_waitcnt lgkmcnt(0)":::"memory"); \
      _Pragma("unroll") for(int d_=0;d_<2;++d_) _Pragma("unroll") for(int r=0;r<16;++r)o[d_][r]*=wsf[crow(r,hi)]; } }while(0)
  f32x16 pA0,pA1,pB0,pB1;
  int sl_prev=0,sl_cur=0,sl_next=SLOTB;
  #define ROT() do{sl_prev=sl_cur;sl_cur=sl_next;sl_next=(sl_next==(NSLOT-1)*SLOTB)?0:sl_next+SLOTB;}while(0)
  DMA_K(2,2*SLOTB);
  WAIT_BAR(3);
  int NTe=NT;
#if !defined(ATT_NOSKIP)
  { const unsigned*np=NRM+(size_t)((b*NHEAD+h)*2)*64; const float qn=__builtin_bit_cast(float,np[0])+__builtin_bit_cast(float,np[64]), kn=__builtin_bit_cast(float,np[16*2*64])+__builtin_bit_cast(float,np[16*2*64+64]);
    const float thr=40.0f+2.0f*1.02f*sqrtf(qn*kn); const __attribute__((address_space(3))) float*cls=(const __attribute__((address_space(3))) float*)(shm3+LDS_C);
    const float cq0=cls[q0]; int lo_=0,hi_=NT-4;
    while(lo_<hi_){ const int mid=(lo_+hi_)>>1; if(cq0-cls[64*mid+63]>=-thr)hi_=mid; else lo_=mid+1; }
    NTe=4+(NT-4-lo_); NTe+=NTe&1; NTe=__builtin_amdgcn_readfirstlane(NTe); }
#endif
  { f32x16 cb0,cb1; CBIAS(cb0,cb1,TIDX(0)); qkt(pA0,pA1,Kbase,qr,cb0,cb1,r32,hi); } asm volatile("s_nop 15\n\ts_nop 7":"+v"(pA0),"+v"(pA1));CMASK(pA0,pA1,0);
  START(pA0,pA1);
  _Pragma("unroll") for(int r=0;r<16;++r)pA1[r]=__builtin_amdgcn_exp2f(pA1[r]);
  WAIT_BAR(0);
  DMA_K(3,0);DMA_V(1,SLOTB);
  ROT();
  kload8(kf,kp0+sl_cur);
  WAIT_BAR(2);
  s16x4 vlo[8],vhi[8]; u32x4 pw0,pw1,pw2,pw3;
  #define PKW(P,B) cvtpk_s(P[B],P[B+1])
  #define PAF(k) __builtin_bit_cast(bf16x8,pw##k)
  #define VFR(i) (bf16x8){vlo[i][0],vlo[i][1],vlo[i][2],vlo[i][3],vhi[i][0],vhi[i][1],vhi[i][2],vhi[i][3]}
  #define PIN(x) asm volatile("":"+v"(x))
  #define MX3(a,b,c) __builtin_fmaxf(__builtin_fmaxf((a),(b)),(c))
  #define GAPA(MF,A0,A1,A2,A3,W0,W1,PW) do{ MF; sacc+=A0; sacc+=A1; sacc+=A2; sacc+=A3; PIN(sacc); W0; W1; PIN(PW); SBAR(); }while(0)
  #define EX(v) __builtin_amdgcn_exp2f(v)
  #define GAPB(MF,X,B) do{ MF; X[B]=EX(X[B]); X[B+1]=EX(X[B+1]); X[B+2]=EX(X[B+2]); X[B+3]=EX(X[B+3]); PIN(X); SBAR(); }while(0)
  #define VRD(i) do{ vlo[i]=vtr(vp_+(((i)>>2)*4096+((i)&3)*1024)); vhi[i]=vtr(vp_+(((i)>>2)*4096+((i)&3)*1024+512)); }while(0)
  #define KRD(G,j) do{ if(G){ kload2(kf,kp0+sl_next,j); SBAR(); } }while(0)
  #define STEP(C0,C1,P0,P1,t,GK,GV,GL) do{ SBAR(); \
    CBIAS(C0,C1,TIDX(t)); SBAR(); \
    const lds_cptr vp_=vp0+sl_prev; \
    VRD(0); SBAR(); float sacc=(P0[0]+P0[1]); \
    GAPA(C0=__builtin_amdgcn_mfma_f32_32x32x16_bf16(kf[0],qr[0],C0,0,0,0), P0[2],P0[3],P0[4],P0[5],     pw0[0]=PKW(P0,0), pw0[1]=PKW(P0,2), pw0); \
    VRD(4); SBAR(); GAPA(C1=__builtin_amdgcn_mfma_f32_32x32x16_bf16(kf[1],qr[0],C1,0,0,0), P0[6],P0[7],P0[8],P0[9],     pw0[2]=PKW(P0,4), pw0[3]=PKW(P0,6), pw0); \
    VRD(1); SBAR(); GAPA(C0=__builtin_amdgcn_mfma_f32_32x32x16_bf16(kf[2],qr[1],C0,0,0,0),   P0[10],P0[11],P0[12],P0[13], pw1[0]=PKW(P0,8), pw1[1]=PKW(P0,10), pw1); \
    VRD(5); SBAR(); GAPA(C1=__builtin_amdgcn_mfma_f32_32x32x16_bf16(kf[3],qr[1],C1,0,0,0),   P0[14],P0[15],P1[0],P1[1],   pw1[2]=PKW(P0,12),pw1[3]=PKW(P0,14), pw1); \
    VRD(2); SBAR(); GAPA(C0=__builtin_amdgcn_mfma_f32_32x32x16_bf16(kf[4],qr[2],C0,0,0,0),   P1[2],P1[3],P1[4],P1[5],     pw2[0]=PKW(P1,0), pw2[1]=PKW(P1,2), pw2); \
    VRD(6); SBAR(); GAPA(C1=__builtin_amdgcn_mfma_f32_32x32x16_bf16(kf[5],qr[2],C1,0,0,0),   P1[6],P1[7],P1[8],P1[9],     pw2[2]=PKW(P1,4), pw2[3]=PKW(P1,6), pw2); \
    VRD(3); SBAR(); GAPA(C0=__builtin_amdgcn_mfma_f32_32x32x16_bf16(kf[6],qr[3],C0,0,0,0),   P1[10],P1[11],P1[12],P1[13], pw3[0]=PKW(P1,8), pw3[1]=PKW(P1,10), pw3); \
    VRD(7); SBAR(); GAPA(C1=__builtin_amdgcn_mfma_f32_32x32x16_bf16(kf[7],qr[3],C1,0,0,0),   P1[14],P1[15],0.f,0.f,       pw3[2]=PKW(P1,12),pw3[3]=PKW(P1,14), pw3); \
    l_reg+=sacc; \
    if(GK){DMA_K((t)+3,sl_cur);} if(GV){DMA_V((t)+1,sl_next);} \
    CMASK(C0,C1,t); \
    { float a=MX3(C0[0],C0[1],C1[0]),b=MX3(C0[2],C0[3],C1[1]); a=MX3(a,C1[2],C1[3]); \
      _Pragma("unroll") for(int r=4;r<16;r+=4){a=MX3(a,C0[r],C0[r+1]);b=MX3(b,C0[r+2],C0[r+3]);a=MX3(a,C1[r],C1[r+1]);b=MX3(b,C1[r+2],C1[r+3]);} \
      float rm=__builtin_fmaxf(a,b); { auto rr=__builtin_amdgcn_permlane32_swap(__float_as_uint(rm),__float_as_uint(rm),false,false); rm=__builtin_fmaxf(__uint_as_float(rr[0]),__uint_as_float(rr[1])); } \
      resc=false; \
      if(__builtin_expect(__any(rm>(float)THRL),0)){ const float dl=__builtin_fmaxf(rm,0.f); \
        _Pragma("unroll") for(int r=0;r<16;++r){C0[r]-=dl;C1[r]-=dl;} \
        nm-=dl; \
        const float f=__builtin_amdgcn_exp2f(-dl); l_reg*=f; if(hi==0)wsf[r32]=f; resc=true; } } \
    SBAR(); \
    GAPB(o[0]=__builtin_amdgcn_mfma_f32_32x32x16_bf16(PAF(0),VFR(0),o[0],0,0,0), C0,0); \
    GAPB(o[1]=__builtin_amdgcn_mfma_f32_32x32x16_bf16(PAF(0),VFR(4),o[1],0,0,0), C0,4); \
    KRD(GL,0); GAPB(o[0]=__builtin_amdgcn_mfma_f32_32x32x16_bf16(PAF(1),VFR(1),o[0],0,0,0), C0,8); \
    KRD(GL,1); GAPB(o[1]=__builtin_amdgcn_mfma_f32_32x32x16_bf16(PAF(1),VFR(5),o[1],0,0,0), C0,12); \
    KRD(GL,2); GAPB(o[0]=__builtin_amdgcn_mfma_f32_32x32x16_bf16(PAF(2),VFR(2),o[0],0,0,0), C1,0); \
    KRD(GL,3); GAPB(o[1]=__builtin_amdgcn_mfma_f32_32x32x16_bf16(PAF(2),VFR(6),o[1],0,0,0), C1,4); \
    GAPB(o[0]=__builtin_amdgcn_mfma_f32_32x32x16_bf16(PAF(3),VFR(3),o[0],0,0,0), C1,8); \
    GAPB(o[1]=__builtin_amdgcn_mfma_f32_32x32x16_bf16(PAF(3),VFR(7),o[1],0,0,0), C1,12); \
    }while(0)
  int t=1;
  #define ENDW(tt) do{ if((tt)+3<NTe){WAIT_BAR(2);} else if((tt)+2<NTe){WAIT_BAR(1);} else {WAIT_BAR(0);} }while(0)
  for(;t<5&&t+1<NTe;t+=2){
    STEP(pB0,pB1,pA0,pA1,t,(t+3<NTe),(t+1<NTe),(t+1<NTe));       ENDW(t);   RESC(); ROT();
    STEP(pA0,pA1,pB0,pB1,t+1,(t+4<NTe),(t+2<NTe),(t+2<NTe));     ENDW(t+1); RESC(); ROT();
  }
  #undef CMASK
  #define CMASK(P0,P1,t) do{}while(0)
  for(;t+5<NTe;t+=2){
    STEP(pB0,pB1,pA0,pA1,t,true,true,true);     WAIT_BAR(2); RESC(); ROT();
    STEP(pA0,pA1,pB0,pB1,t+1,true,true,true);   WAIT_BAR(2); RESC(); ROT();
  }
  #undef CMASK
  #define CMASK(P0,P1,t) do{int jb_=JBOF(t); if(jb_>=0)cmask(P0,P1,jb_,qrel,hi);}while(0)
  for(;t+1<NTe;t+=2){
    STEP(pB0,pB1,pA0,pA1,t,(t+3<NTe),(t+1<NTe),(t+1<NTe));       ENDW(t);   RESC(); ROT();
    STEP(pA0,pA1,pB0,pB1,t+1,(t+4<NTe),(t+2<NTe),(t+2<NTe));     ENDW(t+1); RESC(); ROT();
  }
  STEP(pB0,pB1,pA0,pA1,NTe-1,false,false,false); RESC();
  { float sacc=pB0[0]+pB0[1]; _Pragma("unroll") for(int r=2;r<16;++r)sacc+=pB0[r]; _Pragma("unroll") for(int r=0;r<16;++r)sacc+=pB1[r]; l_reg+=sacc;
    pw0=(u32x4){PKW(pB0,0),PKW(pB0,2),PKW(pB0,4),PKW(pB0,6)};pw1=(u32x4){PKW(pB0,8),PKW(pB0,10),PKW(pB0,12),PKW(pB0,14)};pw2=(u32x4){PKW(pB1,0),PKW(pB1,2),PKW(pB1,4),PKW(pB1,6)};pw3=(u32x4){PKW(pB1,8),PKW(pB1,10),PKW(pB1,12),PKW(pB1,14)};
    SBAR(); pv(o,vb0+sl_cur,PAF(0),PAF(1),PAF(2),PAF(3)); }
  #undef PKW
  #undef PAF
  #undef VFR
  #undef PIN
  #undef MX3
  #undef GAPA
  #undef GAPB
  #undef EX
  #undef VRD
  #undef KRD
  #undef STEP
  #undef ENDW
  {auto rr=__builtin_amdgcn_permlane32_swap(__float_as_uint(l_reg),__float_as_uint(l_reg),false,false);l_reg=__uint_as_float(rr[0])+__uint_as_float(rr[1]);}
  if(hi==0)wsf[32+r32]=l_reg;asm volatile("s_waitcnt lgkmcnt(0)":::"memory");
  float rli[16];
  #pragma unroll
  for(int r=0;r<16;++r)rli[r]=__builtin_amdgcn_rcpf(wsf[32+crow(r,hi)]);
  bf16*Ow=O+(rowbase+q0+wid*QBLK)*OPITCH+h*D;
  { bf16*stg=(bf16*)(shm+LDS_OST)+wid*2048;
    #pragma unroll
    for(int r=0;r<16;++r){const int orow=crow(r,hi);
      #pragma unroll
      for(int d0=0;d0<2;++d0)stg[orow*64+d0*32+r32]=__float2bfloat16(o[d0][r]*rli[r]);}
    asm volatile("s_waitcnt lgkmcnt(0)":::"memory");
    #pragma unroll
    for(int i=0;i<4;++i){const int row=i*8+(lane>>3),ch=lane&7; const u32x4 v=*(const u32x4*)(stg+row*64+ch*8); ATTN_STORE16(Ow+(long)row*OPITCH+ch*8,v);} }
  asm volatile("s_waitcnt lgkmcnt(0)\n\ts_barrier":::"memory");
  #undef DMA_K
  #undef DMA_V
  #undef TIDX
  #undef JBOF
  #undef CBIAS
  #undef CMASK
  #undef START
  #undef RESC
  #undef ROT
}
constexpr int ATTN_LDS_BYTES=LDS_BYTES;
struct AttnTensors { const bf16* Q; const bf16* K; const bf16* V; bf16* O; const float* CP; const unsigned* NRM; };
struct AttnUnit { int bh; int qb; };
struct StaticOrder {
  int vcu;
  __device__ __forceinline__ explicit StaticOrder(int grid,int block):vcu((grid%8==0)?((block%8)*(grid/8)+block/8):block){}
  __device__ __forceinline__ bool next(int i,AttnUnit&u)const{ const int j=vcu+256*(i>>1); if(j>=256)return false; const int s=j&15; u.bh=j>>4; u.qb=(i&1)?s:31-s; return true; }
  __device__ __forceinline__ void a_ready(const AttnUnit&)const{}
  __device__ __forceinline__ void done(const AttnUnit&)const{}
};
struct QueueOrder {
  unsigned* head; volatile unsigned* slot;
  __device__ __forceinline__ bool next(int,AttnUnit&u)const{
    if(threadIdx.x==0)*slot=__hip_atomic_fetch_add(head,1u,__ATOMIC_RELAXED,__HIP_MEMORY_SCOPE_AGENT);
    __syncthreads(); const unsigned j=*slot; __syncthreads();
    if(j>=512u)return false; u.bh=(int)(j&15u); u.qb=31-(int)(j>>4); return true; }
  __device__ __forceinline__ void a_ready(const AttnUnit&)const{}
  __device__ __forceinline__ void done(const AttnUnit&)const{}
};
template<class Sched,int THRL=8> __device__ __forceinline__ void attn_phase(char*lds,const AttnTensors&T,const Sched&S){
  AttnUnit u;
  for(int i=0;S.next(i,u);++i){ S.a_ready(u); attn_unit<THRL>(u.bh/NHEAD,u.bh%NHEAD,u.qb,T.Q,T.K,T.V,T.O,T.CP,T.NRM,lds); S.done(u); }
}
#undef SBAR
#undef WAIT_BAR
}

constexpr int NWAVES = 8;
constexpr int BATCH = 2, T = 8192, D = 1024, M = BATCH * T;
constexpr int NH = 8, DATT = 512, DCONV = 512, CWID = 31, NE = 32, TOPK = 4, DFF = 1024, DIN = 2568, NP1 = 2560;
constexpr int COL_F = 1536, COL_A = 1544, COL_G = 2056;
constexpr int CAP = 16384;
constexpr int MAXTILES = (M * TOPK) / 256 + NE;
constexpr float LOG2E = 1.4426950408889634f;
constexpr float W8_SCALE = 64.0f, HN8_SCALE = 8.0f, ACT8_SCALE = 4.0f, Y8_SCALE = 32.0f;
constexpr int MAXU = 12;

constexpr size_t MiB = 1u << 20;
constexpr size_t WS_CTL = 0, CTL_ZERO_BYTES = 1 * MiB;
constexpr size_t WS_WIN = 2 * MiB, WS_WO = 8 * MiB, WS_LF = 10 * MiB, WS_CP = 10 * MiB + 512 * 1024, WS_RMS = 11 * MiB + 512 * 1024  , WS_TOKINFO = 11 * MiB, WS_TOKIDX = 12 * MiB, WS_GATEW = 14 * MiB;
constexpr size_t WS_XN = 16 * MiB, WS_Q = 48 * MiB, WS_K = 64 * MiB, WS_V = 80 * MiB, WS_U = 96 * MiB, WS_MIX = 112 * MiB, WS_H1 = 144 * MiB, WS_HN = 208 * MiB;
constexpr size_t WS_WGU = 240 * MiB, WS_WD = 368 * MiB, WS_ACT = 432 * MiB, WS_Y = 576 * MiB, WS_END = 720 * MiB;
static_assert(WS_V - WS_K == WS_K - WS_Q && WS_ACT + (size_t)MAXTILES * 256 * 1024 * 2 <= WS_Y && WS_Y + (size_t)MAXTILES * 256 * 1024 * 2 <= WS_END, "d_ws map");
constexpr int CW_TMO = 0, CW_CODE = 1, CW_CNT = 64  , CW_BAR = 4096;
static_assert(CW_CNT + 64 * NE <= CW_BAR, "CTL words");
constexpr int CW_NRM = 16384  , CW_QHEAD = 24576  ;
static_assert((CW_QHEAD + 64) * 4 <= (int)CTL_ZERO_BYTES, "CTL words inside the memset region");

constexpr int RING_OFF = 0, RING_BYTES = 131072;
constexpr int LDSCTL_OFF = RING_BYTES, MISC_OFF = LDSCTL_OFF;
constexpr int META_OFF = LDSCTL_OFF + 512;
constexpr int TOKL_OFF = LDSCTL_OFF + 2048;
constexpr int EPIL_OFF = TOKL_OFF + MAXU * 1024, EPIL_BYTES = 12288;
constexpr int LDS_BYTES = 163840;
static_assert(EPIL_OFF + EPIL_BYTES <= LDS_BYTES && 9 * 256 * 4 <= EPIL_BYTES && 6 * 512 * 4 <= EPIL_BYTES, "LDS map");

#define GAS __attribute__((address_space(1)))
#define LAS __attribute__((address_space(3)))
typedef unsigned short bf16;
typedef unsigned v4u __attribute__((ext_vector_type(4)));
typedef unsigned v2u __attribute__((ext_vector_type(2)));
typedef float f32x4 __attribute__((ext_vector_type(4)));
typedef GAS unsigned gu32;
#define RLX_AGENT __ATOMIC_RELAXED, __HIP_MEMORY_SCOPE_AGENT
#define LDS_WAIT() asm volatile("s_waitcnt lgkmcnt(0)" ::: "memory")
#define VM_WAIT() asm volatile("s_waitcnt vmcnt(0)" ::: "memory")
__device__ __forceinline__ unsigned f2bf(float f) { unsigned u = __builtin_bit_cast(unsigned, f); return (u + 0x7fffu + ((u >> 16) & 1u)) >> 16; }
__device__ __forceinline__ unsigned pk2(float lo, float hi) { return f2bf(lo) | (f2bf(hi) << 16); }
__device__ __forceinline__ float bf2f(unsigned short h) { return __builtin_bit_cast(float, (unsigned)h << 16); }
#define XB_TMO      128
#define XB_XCNT(j)  (256  + 64 * (j))
#define XB_XSUB(j)  (1280 + 64 * (j))
#define XB_XGEN(j)  (2304 + 64 * (j))
#define XB_TOP      3328
#define XB_TOPGEN   3392
#define XCD_BAR_WORDS 3456
#define XB_SPIN_CAP (1u << 18)

__device__ __forceinline__ unsigned xb_ld(unsigned* p)              { return __hip_atomic_load(p, __ATOMIC_RELAXED, __HIP_MEMORY_SCOPE_AGENT); }
__device__ __forceinline__ unsigned xb_add(unsigned* p, unsigned v) { return __hip_atomic_fetch_add(p, v, __ATOMIC_RELAXED, __HIP_MEMORY_SCOPE_AGENT); }
__device__ __forceinline__ unsigned xb_xcc_id() { return (unsigned)__builtin_amdgcn_s_getreg((3 << 11) | 20) & 0xFu; }
#define XB_SPIN(cond, bar) do { unsigned _sp = 0; while (cond) { __builtin_amdgcn_s_sleep(1); \
    if ((++_sp & 255u) == 0u) { if (xb_ld(&(bar)[XB_TMO])) break; if (_sp > XB_SPIN_CAP) { atomicAdd(&(bar)[XB_TMO], 1u); break; } } } } while (0)

struct XcdBarrier {
    unsigned* bar; unsigned x;
    volatile LAS unsigned* st;
};

__device__ __forceinline__ XcdBarrier xcd_barrier_post(unsigned* bar, volatile LAS unsigned* st) {
    XcdBarrier b; b.bar = bar; b.x = xb_xcc_id(); b.st = st;
    if (threadIdx.x == 0) (void)xb_add(&bar[XB_XCNT(b.x)], 1u);
    return b;
}
__device__ __forceinline__ void xcd_barrier_complete(unsigned* bar, unsigned x, unsigned& nloc, unsigned& nx) {
    const unsigned G = gridDim.x * gridDim.y * gridDim.z;
    unsigned sum, cnt, mine, sp = 0u;
    for (;;) {
        sum = 0u; cnt = 0u; mine = 0u;
#pragma unroll
        for (unsigned j = 0; j < 16; ++j) { const unsigned c = xb_ld(&bar[XB_XCNT(j)]); sum += c; cnt += (c > 0u) ? 1u : 0u; mine = (j == x) ? c : mine; }
        if (sum == G) break;
        __builtin_amdgcn_s_sleep(1);
        if ((++sp & 255u) == 0u) { if (xb_ld(&bar[XB_TMO])) break; if (sp > XB_SPIN_CAP) { atomicAdd(&bar[XB_TMO], 1u); break; } }
    }
    nloc = mine > 0u ? mine : 1u; nx = cnt > 0u ? cnt : 1u;
}

__device__ __forceinline__ void xcd_barrier(const XcdBarrier& b) {
    asm volatile("s_waitcnt vmcnt(0)" ::: "memory");
    __syncthreads();
    if (threadIdx.x == 0) {
        unsigned* bar = b.bar;
        __builtin_amdgcn_s_waitcnt(0);
        unsigned nloc = b.st[0], nx = b.st[1];
        if (nloc == 0u) { xcd_barrier_complete(bar, b.x, nloc, nx); b.st[0] = nloc; b.st[1] = nx; }
        const unsigned old = xb_add(&bar[XB_XSUB(b.x)], 1u);
        const unsigned gen = old / nloc;
        if (old + 1u == (gen + 1u) * nloc) {
            __builtin_amdgcn_fence(__ATOMIC_RELEASE, "agent");
            asm volatile("s_waitcnt vmcnt(0)" ::: "memory");
            const unsigned og = xb_add(&bar[XB_TOP], 1u);
            const unsigned tg = og / nx;
            if (og + 1u == (tg + 1u) * nx) xb_add(&bar[XB_TOPGEN], 1u);
            else XB_SPIN(xb_ld(&bar[XB_TOPGEN]) == tg, bar);
            __builtin_amdgcn_fence(__ATOMIC_ACQUIRE, "agent");
            xb_add(&bar[XB_XGEN(b.x)], 1u);
            asm volatile("s_waitcnt vmcnt(0)" ::: "memory");
        } else {
            XB_SPIN(xb_ld(&bar[XB_XGEN(b.x)]) == gen, bar);
            __builtin_amdgcn_fence(__ATOMIC_ACQUIRE, "agent");
            asm volatile("s_waitcnt vmcnt(0)" ::: "memory");
        }
    }
    __syncthreads();
}

struct Args {
    const float *x, *norm_mix_g, *w_in, *b_f, *b_glu, *w_dw, *b_dw, *ln_g, *ln_b, *w_out, *norm_ffn_g, *w_router, *b_router, *w_gu, *b_gu, *w_down, *b_down, *norm_final_g;
    float* out; unsigned char* ws; int ph_lo, ph_hi, li, pad;
};
struct Frame {
    LAS unsigned char* lds;
    volatile LAS unsigned* MISC;
    gu32* ctl;
    int tid, lane, wave, vcu, G;
};
__device__ __forceinline__ float wave_sum(float v) {
#pragma unroll
    for (int o = 1; o < 64; o <<= 1) v += __shfl_xor(v, o);
    return v;
}

__device__ __forceinline__ void p0_transpose_item(const float* W, int K, int N, int k0, int sc0, bf16* WTrow0, LAS float* scr, int lane) {
#pragma unroll 8
    for (int i = 0; i < 32; ++i) { const int kk = 2 * i + (lane >> 5); scr[kk * 33 + (lane & 31)] = __builtin_nontemporal_load(W + (size_t)(k0 + kk) * N + sc0 + (lane & 31)); }
    LDS_WAIT(); asm volatile("" ::: "memory");
    const int c = lane & 7;
#pragma unroll
    for (int j = 0; j < 4; ++j) { const int n = (lane >> 3) + 8 * j; const LAS float* s = scr + (8 * c) * 33 + n;
        v4u o; o.x = pk2(s[0 * 33], s[1 * 33]); o.y = pk2(s[2 * 33], s[3 * 33]); o.z = pk2(s[4 * 33], s[5 * 33]); o.w = pk2(s[6 * 33], s[7 * 33]);
        *(GAS v4u*)(WTrow0 + (size_t)n * K + k0 + 8 * c) = o; }
    LDS_WAIT(); asm volatile("" ::: "memory");
}
__device__ __forceinline__ void p0_transpose_item_f8(const float* W, int K, int N, int k0, int sc0, unsigned char* WTrow0, int lane, float sc) {
    const int kr = lane >> 3, c4 = lane & 7;
    const GAS f32x4* src = (const GAS f32x4*)(W + (size_t)(k0 + 16 * kr) * N + sc0 + 4 * c4);
    f32x4 v[16];
#pragma unroll
    for (int i = 0; i < 16; ++i) v[i] = __builtin_nontemporal_load(src + (size_t)i * (N / 4));
    __builtin_amdgcn_sched_barrier(0);
#pragma unroll
    for (int c = 0; c < 4; ++c) { v4u o;
        o.x = pg8::pk4_fp8(v[0][c] * sc, v[1][c] * sc, v[2][c] * sc, v[3][c] * sc); o.y = pg8::pk4_fp8(v[4][c] * sc, v[5][c] * sc, v[6][c] * sc, v[7][c] * sc);
        o.z = pg8::pk4_fp8(v[8][c] * sc, v[9][c] * sc, v[10][c] * sc, v[11][c] * sc); o.w = pg8::pk4_fp8(v[12][c] * sc, v[13][c] * sc, v[14][c] * sc, v[15][c] * sc);
        *(GAS v4u*)(WTrow0 + (size_t)(4 * c4 + c) * K + k0 + 16 * kr) = o; }
}
constexpr int P0_KB = D / 64, P0_KB8 = D / 128;
constexpr int P0_I_IN = P0_KB * (NP1 / 32), P0_I_O = P0_KB * (D / 32), P0_I_GU = NE * P0_KB8 * (2 * DFF / 32), P0_I_DN = NE * P0_KB8 * (D / 32);
constexpr int P0_NITEMS = P0_I_IN + P0_I_O + P0_I_GU + P0_I_DN;
__device__ __forceinline__ void p0_items(Frame& F, const Args& a, int first, int last) {
    unsigned char* ws = a.ws;
    LAS float* scr = (LAS float*)(F.lds + RING_OFF + F.wave * 16384);
    const int gw = F.vcu * NWAVES + F.wave, NGW = F.G * NWAVES;
    bf16* Win_t = (bf16*)(ws + WS_WIN); bf16* Wo_t = (bf16*)(ws + WS_WO); unsigned char* Wgu_t = ws + WS_WGU; unsigned char* Wd_t = ws + WS_WD;
    constexpr int KB = P0_KB, I_IN = P0_I_IN, I_O = P0_I_O, I_GU = P0_I_GU;
    for (int it = first + gw; it < last; it += NGW) {
        int r = it;
        if (r < I_IN) { const int nb = r % (NP1 / 32), kb = r / (NP1 / 32), n0 = nb * 32; int sc;
            if (n0 < 1536) sc = n0; else { const int j = (n0 - 1536) >> 8, i = (n0 - 1536) & 255; sc = (i < 128) ? (COL_A + 128 * j + i) : (COL_G + 128 * j + (i - 128)); }
            p0_transpose_item(a.w_in, D, DIN, kb * 64, sc, Win_t + (size_t)n0 * D, scr, F.lane); continue; }
        r -= I_IN;
        if (r < I_O) { const int nb = r % (D / 32), kb = r / (D / 32); p0_transpose_item(a.w_out, D, D, kb * 64, nb * 32, Wo_t + (size_t)nb * 32 * D, scr, F.lane); continue; }
        r -= I_O;
        if (r < I_GU) { const int per = P0_KB8 * (2 * DFF / 32), e = r / per, q = r % per, nb = q % (2 * DFF / 32), kb = q / (2 * DFF / 32), n0 = nb * 32;
            const int pl = n0 >> 8, i = n0 & 255, sc = (i < 128) ? (128 * pl + i) : (DFF + 128 * pl + (i - 128));
            p0_transpose_item_f8(a.w_gu + (size_t)e * D * 2 * DFF, D, 2 * DFF, kb * 128, sc, Wgu_t + ((size_t)e * 2 * DFF + n0) * D, F.lane, W8_SCALE); continue; }
        r -= I_GU;
        { const int per = P0_KB8 * (D / 32), e = r / per, q = r % per, nb = q % (D / 32), kb = q / (D / 32);
            p0_transpose_item_f8(a.w_down + (size_t)e * DFF * D, DFF, D, kb * 128, nb * 32, Wd_t + ((size_t)e * D + nb * 32) * DFF, F.lane, W8_SCALE); }
    }
}
__device__ __forceinline__ void p0_prologue(Frame& F, const Args& a) {
    unsigned char* ws = a.ws;
    const int gw = F.vcu * NWAVES + F.wave, NGW = F.G * NWAVES;
    p0_items(F, a, 0, P0_I_IN + P0_I_O); p0_items(F, a, P0_I_IN + P0_I_O + P0_I_GU, P0_NITEMS);
    __syncthreads();
    LAS float* wf = (LAS float*)(F.lds + RING_OFF);
    for (int i = F.tid; i < D * NH; i += NWAVES * 64) { const int k = i >> 3, h = i & 7; wf[h * D + k] = a.w_in[(size_t)k * DIN + COL_F + h]; }
    __syncthreads();
    bf16* XN = (bf16*)(ws + WS_XN); float* LF = (float*)(ws + WS_LF);
    f32x4 gv[4];
#pragma unroll
    for (int j = 0; j < 4; ++j) gv[j] = ((const GAS f32x4*)a.norm_mix_g)[F.lane + 64 * j];
    for (int m = gw; m < M; m += NGW) {
        const GAS f32x4* xr = (const GAS f32x4*)(a.x + (size_t)m * D) + F.lane;
        f32x4 v[4]; float s = 0.f;
#pragma unroll
        for (int j = 0; j < 4; ++j) { v[j] = xr[64 * j]; s += (v[j].x * v[j].x + v[j].y * v[j].y) + (v[j].z * v[j].z + v[j].w * v[j].w); }
        const float ms = wave_sum(s) * (1.f / D) + 1e-6f, rs = 1.0f / sqrtf(ms);
        if (F.lane == 0) ((float*)(ws + WS_RMS))[m] = sqrtf(ms);
#pragma unroll
        for (int j = 0; j < 4; ++j) v[j] = v[j] * rs * gv[j];
        GAS unsigned long long* o8 = (GAS unsigned long long*)(XN + (size_t)m * D) + F.lane;
#pragma unroll
        for (int j = 0; j < 4; ++j) o8[64 * j] = (unsigned long long)pk2(v[j].x, v[j].y) | ((unsigned long long)pk2(v[j].z, v[j].w) << 32);
        float fl[NH];
#pragma unroll
        for (int h = 0; h < NH; ++h) { float acc = 0.f;
#pragma unroll
            for (int j = 0; j < 4; ++j) { const f32x4 w = *(const LAS f32x4*)(wf + h * D + 4 * F.lane + 256 * j); acc += (v[j].x * w.x + v[j].y * w.y) + (v[j].z * w.z + v[j].w * w.w); }
            fl[h] = wave_sum(acc); }
        if (F.lane < NH) { float z = fl[0];
#pragma unroll
            for (int h = 1; h < NH; ++h) z = (F.lane == h) ? fl[h] : z;
            z += a.b_f[F.lane];
            const float ls = fminf(z, 0.f) - log1pf(expf(-fabsf(z)));
            const int b = m / T, t = m % T;
            LF[(size_t)(b * NH + F.lane) * T + t] = ls; }
    }
}
__device__ __forceinline__ void scan_bh(Frame& F, const float* LF, float* CP, int bh) {
    LAS double* wtot = (LAS double*)(F.lds + RING_OFF);
    const GAS f32x4* src = (const GAS f32x4*)(LF + (size_t)bh * T) + F.tid * 4;
    f32x4 v[4];
#pragma unroll
    for (int j = 0; j < 4; ++j) v[j] = src[j];
    double pre[16]; double run = 0.0;
#pragma unroll
    for (int j = 0; j < 4; ++j)
#pragma unroll
        for (int c = 0; c < 4; ++c) { run += (double)v[j][c]; pre[j * 4 + c] = run; }
    double inc = run;
#pragma unroll
    for (int o = 1; o < 64; o <<= 1) { const double up = __shfl_up(inc, o); if (F.lane >= o) inc += up; }
    if (F.lane == 63) wtot[F.wave] = inc;
    __syncthreads();
    double base = inc - run;
    for (int w = 0; w < F.wave; ++w) base += wtot[w];
    GAS f32x4* dst = (GAS f32x4*)(CP + (size_t)bh * T) + F.tid * 4;
#pragma unroll
    for (int j = 0; j < 4; ++j) { f32x4 o;
#pragma unroll
        for (int c = 0; c < 4; ++c) o[c] = (float)((base + pre[j * 4 + c]) * (double)LOG2E);
        dst[j] = o; }
    __syncthreads();
}

__device__ __forceinline__ void conv_phase(Frame& F, const Args& a, int blk, int grp0, int grp1) {
    const bf16* U = (const bf16*)(a.ws + WS_U); bf16* MIX = (bf16*)(a.ws + WS_MIX);
    LAS float* yl = (LAS float*)(F.lds + RING_OFF);
    LAS float* st = (LAS float*)(F.lds + RING_OFF + 65536);
    int ch = threadIdx.x; asm volatile("" : "+v"(ch));
    const int clane = ch & 63, cwave = __builtin_amdgcn_readfirstlane(ch >> 6);
    float w[CWID];
#pragma unroll
    for (int j = 0; j < CWID; ++j) w[j] = a.w_dw[j * DCONV + ch];
    const float bdw = a.b_dw[ch], lg = a.ln_g[ch], lb = a.ln_b[ch];
    for (int grp = grp0; grp < grp1; ++grp) {
        const int n0 = blk * 64 + grp * 32, t0 = n0 % T;
        unsigned short raw[CWID - 1 + 32];
#pragma unroll
        for (int i = 0; i < CWID - 1 + 32; ++i) { const int ts = t0 - (CWID - 1) + i; const int rowc = (ts >= 0) ? (n0 - (CWID - 1) + i) : n0;
            raw[i] = U[(size_t)rowc * DCONV + ch]; }
        __builtin_amdgcn_sched_barrier(0);
        float uin[CWID - 1 + 32];
#pragma unroll
        for (int i = 0; i < CWID - 1 + 32; ++i) { const int ts = t0 - (CWID - 1) + i; uin[i] = (ts >= 0) ? bf2f(raw[i]) : 0.f; }
        float y[32];
#pragma unroll
        for (int o = 0; o < 32; ++o) { float acc = bdw;
#pragma unroll
            for (int j = 0; j < CWID; ++j) acc = fmaf(w[j], uin[o + j], acc);
            y[o] = acc; yl[o * DCONV + ch] = acc; }
        __syncthreads();
#pragma unroll
        for (int q = 0; q < 4; ++q) { const int o = cwave * 4 + q;
            const f32x4 p0 = *(const LAS f32x4*)(yl + o * DCONV + 4 * clane), p1 = *(const LAS f32x4*)(yl + o * DCONV + 256 + 4 * clane);
            const float mu = wave_sum((p0.x + p0.y) + (p0.z + p0.w) + (p1.x + p1.y) + (p1.z + p1.w)) * (1.f / DCONV);
            const f32x4 d0 = p0 - mu, d1 = p1 - mu;
            const float var = wave_sum((d0.x * d0.x + d0.y * d0.y) + (d0.z * d0.z + d0.w * d0.w) + (d1.x * d1.x + d1.y * d1.y) + (d1.z * d1.z + d1.w * d1.w)) * (1.f / DCONV);
            if (clane == 0) { st[2 * o] = mu; st[2 * o + 1] = 1.0f / sqrtf(var + 1e-5f); } }
        __syncthreads();
#pragma unroll
        for (int o = 0; o < 32; ++o) { const float z = (y[o] - st[2 * o]) * st[2 * o + 1] * lg + lb; const float sw = z * pg8::sigmoid_f(z);
            MIX[(size_t)(n0 + o) * D + DATT + ch] = (bf16)f2bf(sw); }
        __syncthreads();
    }
}

#define RT_SWZ(col) ((((col) & 7) ^ ((((col) >> 3) & 1) << 2)))
__device__ __forceinline__ void router_table(Frame& F, const Args& a) {
    LAS unsigned char* tbl = F.lds + RING_OFF;
    { f32x4 wv[16]; float gg[16];
#pragma unroll
      for (int i = 0; i < 16; ++i) { const int f = F.tid + 512 * i; wv[i] = ((const GAS f32x4*)a.w_router)[f]; gg[i] = a.norm_ffn_g[f >> 3]; }
      __builtin_amdgcn_sched_barrier(0);
#pragma unroll
      for (int i = 0; i < 16; ++i) { const int f = F.tid + 512 * i, col = f >> 3, e4 = f & 7; *(LAS f32x4*)(tbl + col * 128 + ((e4 ^ RT_SWZ(col)) << 4)) = wv[i] * gg[i]; } }
}
__device__ __forceinline__ void router_phase(Frame& F, const Args& a, int blk, size_t dry  ) {
    const bf16* H1 = (const bf16*)(a.ws + WS_H1); unsigned char* HN = a.ws + WS_HN + dry;
    int* tokinfo = (int*)(a.ws + WS_TOKINFO + dry); int* tokidx = (int*)(a.ws + WS_TOKIDX + dry); float* gatew = (float*)(a.ws + WS_GATEW + dry);
    int* gcnt = (int*)(F.ctl + CW_CNT) + (dry ? 32 : 0);
    LAS unsigned char* tbl = F.lds + RING_OFF;
    LAS int* lcnt = (LAS int*)(F.lds + META_OFF) + 32 + 32 + 33 + 33 + 33;
    LAS int* lbase = lcnt + 32;
    LAS float* part = (LAS float*)(F.lds + TOKL_OFF);
    LAS float* ssp = part + 4 * 8 * 64;
    LAS float* rsl = ssp + 64;
    if (F.tid < 32) lcnt[F.tid] = 0;
    __syncthreads();
    const int rg = F.wave & 3, kh = F.wave >> 2, r16 = F.lane & 15, kq = F.lane >> 4;
    f32x4 c0 = {0.f, 0.f, 0.f, 0.f}, c1 = {0.f, 0.f, 0.f, 0.f}; float ss = 0.f;
    {
        const bf16* hp = H1 + (size_t)(blk * 64 + rg * 16 + r16) * D + kh * 512 + kq * 8;
        const int e4a = r16 >> 2, e4b = 4 + (r16 >> 2), wi = (r16 & 3) * 4;
        v4u avv[16];
#pragma unroll
        for (int j = 0; j < 16; ++j) avv[j] = *(const v4u*)(hp + 32 * j);
        __builtin_amdgcn_sched_barrier(0);
#pragma unroll
        for (int j = 0; j < 16; ++j) {
#pragma unroll
            for (int c = 0; c < 8; ++c) { const unsigned wv = avv[j][c >> 1]; const float av = __builtin_bit_cast(float, (c & 1) ? (wv & 0xffff0000u) : (wv << 16));
                ss += av * av;
                const int k = kh * 512 + 32 * j + 8 * kq + c; const LAS unsigned char* rp = tbl + k * 128 + wi; const int sw = RT_SWZ(k);
                const float b0 = *(const LAS float*)(rp + ((e4a ^ sw) << 4)), b1 = *(const LAS float*)(rp + ((e4b ^ sw) << 4));
                c0 = __builtin_amdgcn_mfma_f32_16x16x4f32(av, b0, c0, 0, 0, 0); c1 = __builtin_amdgcn_mfma_f32_16x16x4f32(av, b1, c1, 0, 0, 0); } }
    }
    ss += __shfl_xor(ss, 16); ss += __shfl_xor(ss, 32);
    if (kh == 1) {
#pragma unroll
        for (int i = 0; i < 4; ++i) { part[(rg * 8 + i) * 64 + F.lane] = c0[i]; part[(rg * 8 + 4 + i) * 64 + F.lane] = c1[i]; }
        if (F.lane < 16) ssp[rg * 16 + F.lane] = ss;
    }
    __syncthreads();
    int pe = 0, plr = 0; float pw = 0.f;
    if (kh == 0) {
#pragma unroll
        for (int i = 0; i < 4; ++i) { c0[i] += part[(rg * 8 + i) * 64 + F.lane]; c1[i] += part[(rg * 8 + 4 + i) * 64 + F.lane]; }
        if (F.lane < 16) rsl[rg * 16 + F.lane] = 1.0f / sqrtf((ss + ssp[rg * 16 + F.lane]) * (1.f / D) + 1e-6f);
        LDS_WAIT(); asm volatile("" ::: "memory");
        const float ba = a.b_router[r16], bb = a.b_router[16 + r16];
#pragma unroll
        for (int i = 0; i < 4; ++i) {
            const float rs = rsl[rg * 16 + 4 * kq + i];
            float za = c0[i] * rs + ba, zb = c1[i] * rs + bb;
            int idx[TOPK]; float val[TOPK];
#pragma unroll
            for (int k = 0; k < TOPK; ++k) { float bv = za; int bi = r16; if (zb > za) { bv = zb; bi = 16 + r16; }
#pragma unroll
                for (int o = 8; o > 0; o >>= 1) { const float ov = __shfl_xor(bv, o); const int oi = __shfl_xor(bi, o); if (ov > bv || (ov == bv && oi < bi)) { bv = ov; bi = oi; } }
                idx[k] = bi; val[k] = bv; if (bi == r16) za = -INFINITY; if (bi == 16 + r16) zb = -INFINITY; }
            float ex[TOPK], den = 0.f;
#pragma unroll
            for (int k = 0; k < TOPK; ++k) { ex[k] = __expf(val[k] - val[0]); den += ex[k]; }
            const float inv = 1.0f / den;
#pragma unroll
            for (int k = 0; k < TOPK; ++k) if (r16 == 4 * i + k) { pe = idx[k]; pw = ex[k] * inv; }
        }
        plr = __hip_atomic_fetch_add(&lcnt[pe], 1, __ATOMIC_RELAXED, __HIP_MEMORY_SCOPE_WORKGROUP);
    }
    __syncthreads();
    if (F.tid < 32) lbase[F.tid] = (int)__hip_atomic_fetch_add(gcnt + 64 * F.tid, lcnt[F.tid], RLX_AGENT);
    __syncthreads();
    if (kh == 0) { const int rank = lbase[pe] + plr, row = blk * 64 + rg * 16 + (F.lane >> 2), k = F.lane & 3;
        tokinfo[row * TOPK + k] = pe * CAP + rank; tokidx[pe * CAP + rank] = row; gatew[pe * CAP + rank] = pw; }
    f32x4 gv[4];
#pragma unroll
    for (int j = 0; j < 4; ++j) gv[j] = ((const GAS f32x4*)a.norm_ffn_g)[F.lane + 64 * j];
    for (int rb = 0; rb < 2; ++rb) { f32x4 hv[4][4];
#pragma unroll
        for (int rr = 0; rr < 4; ++rr) { const GAS v2u* hr = (const GAS v2u*)(H1 + (size_t)(blk * 64 + F.wave * 8 + rb * 4 + rr) * D) + F.lane;
#pragma unroll
            for (int j = 0; j < 4; ++j) { const v2u p = hr[64 * j]; hv[rr][j] = (f32x4){__builtin_bit_cast(float, p.x << 16), __builtin_bit_cast(float, p.x & 0xffff0000u), __builtin_bit_cast(float, p.y << 16), __builtin_bit_cast(float, p.y & 0xffff0000u)}; } }
        __builtin_amdgcn_sched_barrier(0);
#pragma unroll
        for (int rr = 0; rr < 4; ++rr) { const int lr = F.wave * 8 + rb * 4 + rr, row = blk * 64 + lr; const float rs = rsl[lr];
            GAS unsigned* o4 = (GAS unsigned*)(HN + (size_t)row * D) + F.lane;
#pragma unroll
            for (int j = 0; j < 4; ++j) { const f32x4 v = hv[rr][j] * (rs * HN8_SCALE) * gv[j]; o4[64 * j] = pg8::pk4_fp8(v.x, v.y, v.z, v.w); } } }
    __syncthreads();
}
__device__ __forceinline__ void moe_meta(Frame& F) {
    LAS int* meta = (LAS int*)(F.lds + META_OFF);
    if (F.tid < 32) { const int c = (int)__hip_atomic_load((int*)(F.ctl + CW_CNT) + 64 * F.tid, RLX_AGENT); meta[F.tid] = c; meta[32 + F.tid] = (c + 255) >> 8; }
    __syncthreads();
    if (F.tid == 0) { int o = 0; for (int e = 0; e < 32; ++e) { meta[64 + e] = o; meta[97 + e] = o * 8; meta[130 + e] = o * 4; o += meta[32 + e]; } meta[64 + 32] = o; meta[97 + 32] = o * 8; meta[130 + 32] = o * 4; }
    __syncthreads();
}

__device__ __forceinline__ void final_phase(Frame& F, const Args& a, int blk) {
    const bf16* H1 = (const bf16*)(a.ws + WS_H1); const unsigned char* Y = a.ws + WS_Y; const int* tokinfo = (const int*)(a.ws + WS_TOKINFO);
    const LAS int* tileoff = (const LAS int*)(F.lds + META_OFF) + 64;
    f32x4 gv[4];
#pragma unroll
    for (int j = 0; j < 4; ++j) gv[j] = ((const GAS f32x4*)a.norm_final_g)[F.lane + 64 * j];
    for (int rr = 0; rr < 8; ++rr) {
        const int row = blk * 64 + F.wave * 8 + rr;
        const GAS v2u* hr = (const GAS v2u*)(H1 + (size_t)row * D) + F.lane;
        f32x4 v[4];
#pragma unroll
        for (int j = 0; j < 4; ++j) { const v2u p = __builtin_nontemporal_load(hr + 64 * j); v[j] = (f32x4){__builtin_bit_cast(float, p.x << 16), __builtin_bit_cast(float, p.x & 0xffff0000u), __builtin_bit_cast(float, p.y << 16), __builtin_bit_cast(float, p.y & 0xffff0000u)}; }
#pragma unroll
        for (int k = 0; k < TOPK; ++k) { const int info = tokinfo[row * TOPK + k], e = info >> 14, rank = info & (CAP - 1);
            const GAS unsigned* yr = (const GAS unsigned*)(Y + ((size_t)tileoff[e] * 256 + rank) * D) + F.lane;
#pragma unroll
            for (int j = 0; j < 4; ++j) { const unsigned p = __builtin_nontemporal_load(yr + 64 * j);
                const auto lo2 = __builtin_amdgcn_cvt_pk_f32_fp8((int)p, false), hi2 = __builtin_amdgcn_cvt_pk_f32_fp8((int)p, true);
                v[j].x += lo2[0] * (1.0f / Y8_SCALE); v[j].y += lo2[1] * (1.0f / Y8_SCALE); v[j].z += hi2[0] * (1.0f / Y8_SCALE); v[j].w += hi2[1] * (1.0f / Y8_SCALE); } }
        float s = 0.f;
#pragma unroll
        for (int j = 0; j < 4; ++j) s += (v[j].x * v[j].x + v[j].y * v[j].y) + (v[j].z * v[j].z + v[j].w * v[j].w);
        const float rs = 1.0f / sqrtf(wave_sum(s) * (1.f / D) + 1e-6f);
        GAS f32x4* orow = (GAS f32x4*)(a.out + (size_t)row * D) + F.lane;
#pragma unroll
        for (int j = 0; j < 4; ++j) __builtin_nontemporal_store(v[j] * rs * gv[j], orow + 64 * j);
    }
}

constexpr int NPHASE = 8;
__global__ void __launch_bounds__(NWAVES * 64, 2) mega_fwd(Args args) {
    extern __shared__ __attribute__((aligned(16))) unsigned char lds[];
    Frame F;
    F.lds = (LAS unsigned char*)lds;
    F.MISC = (volatile LAS unsigned*)(F.lds + MISC_OFF);
    F.tid = threadIdx.x; F.lane = F.tid & 63; F.wave = __builtin_amdgcn_readfirstlane(F.tid >> 6);
    F.G = gridDim.x; { const int bx = blockIdx.x; F.vcu = (F.G % 8 == 0) ? (bx % 8) * (F.G / 8) + bx / 8 : bx; }
    unsigned char* ws = args.ws;
    F.ctl = (gu32*)(ws + WS_CTL);
    for (int u = F.tid; u < 512 / 4; u += NWAVES * 64) ((LAS unsigned*)(F.lds + LDSCTL_OFF))[u] = 0u;
    __syncthreads();
    const int lo = args.ph_lo, hi = args.ph_hi;
    XcdBarrier bar; bar.bar = (unsigned*)(F.ctl + CW_BAR); bar.x = 0; bar.st = nullptr;
    if (hi - lo > 1) bar = xcd_barrier_post((unsigned*)(F.ctl + CW_BAR) + args.li * XCD_BAR_WORDS, F.MISC + 8);
#ifdef MK_ONLY
#define IN(k) ((k) == MK_ONLY && lo <= (k) && (k) < hi)
#else
#define IN(k) (lo <= (k) && (k) < hi)
#endif
#define BOTH(k) (IN(k) && IN((k) + 1))
#define GRID_BAR() xcd_barrier(bar)
#define REFRESH() do { int t_ = threadIdx.x; asm volatile("" : "+v"(t_)); F.tid = t_; F.lane = t_ & 63; F.wave = __builtin_amdgcn_readfirstlane(t_ >> 6); } while (0)
    const int blk = blockIdx.x;

    if (IN(0)) {
        REFRESH();
        p0_prologue(F, args);
        if (BOTH(0)) GRID_BAR();
    }

    if (IN(1)) {
        REFRESH();
#ifndef NO_SCAN
        if (blk >= F.G - 16) scan_bh(F, (const float*)(ws + WS_LF), (float*)(ws + WS_CP), blk - (F.G - 16));
#endif
        pg8::Gemm g{ws + WS_XN, ws + WS_WIN, M, NP1, D, 2 * D}; pg8::StaticOrder S; S.init(M, NP1, F.G, blk);
        LAS float* epil = (LAS float*)(F.lds + EPIL_OFF);
        for (int i = F.tid; i < 2 * DCONV; i += NWAVES * 64) epil[i] = args.b_glu[i];
        __syncthreads();
        pg8::EpiProj E{(bf16*)(ws + WS_Q), (bf16*)(ws + WS_U), (size_t)(WS_K - WS_Q) / 2, epil, 0.125f * LOG2E, (unsigned*)(F.ctl + CW_NRM)};
        pg8::gemm_phase<pg8::EpiProj, pg8::StaticOrder, true, false, false>(F.lds + RING_OFF, g, S, E, nullptr);
        if (BOTH(1)) GRID_BAR();
#ifdef MK_XBAR
        if (BOTH(1)) { GRID_BAR(); GRID_BAR(); GRID_BAR(); GRID_BAR(); }
#endif
    }

    if (IN(2)) {
        REFRESH();
        const attn_body::AttnTensors AT{(const attn_body::bf16*)(ws + WS_Q), (const attn_body::bf16*)(ws + WS_K), (const attn_body::bf16*)(ws + WS_V), (attn_body::bf16*)(ws + WS_MIX), (const float*)(ws + WS_CP), (const unsigned*)(F.ctl + CW_NRM)};
        volatile unsigned* slot = (volatile unsigned*)(lds + MISC_OFF + 64);
        for (;;) {
            if (threadIdx.x == 0) *slot = __hip_atomic_fetch_add((unsigned*)(F.ctl + CW_QHEAD), 1u, __ATOMIC_RELAXED, __HIP_MEMORY_SCOPE_AGENT);
            __syncthreads(); const unsigned j = __builtin_amdgcn_readfirstlane(*slot); __syncthreads();
            if (j >= 512u + (unsigned)(M / 32)) break;
            if (j < 512u) { const int bh = (int)(j & 15u), qb = 31 - (int)(j >> 4); attn_body::attn_unit<8>(bh / NH, bh % NH, qb, AT.Q, AT.K, AT.V, AT.O, AT.CP, AT.NRM, (char*)lds + RING_OFF); }
            else { const int cj = (int)(j - 512u); conv_phase(F, args, cj >> 1, cj & 1, (cj & 1) + 1); }
        }
        if (BOTH(2)) GRID_BAR();
    }

    if (IN(3)) {
        REFRESH();
        pg8::Gemm g{ws + WS_MIX, ws + WS_WO, M, D, D, 2 * D}; pg8::StaticOrder S; S.init(M, D, F.G, blk);
        pg8::EpiH1 E{(const bf16*)(ws + WS_XN), (const float*)(ws + WS_RMS), args.norm_mix_g, (bf16*)(ws + WS_H1)};
        pg8::gemm_phase<pg8::EpiH1, pg8::StaticOrder, true, false, false>(F.lds + RING_OFF, g, S, E, nullptr);
        if (IN(4)) router_table(F, args);
        if (BOTH(3)) GRID_BAR();
    }

    if (IN(4)) {
        REFRESH();
        if (!IN(3)) router_table(F, args);
        router_phase(F, args, blk, 0);
        p0_items(F, args, P0_I_IN + P0_I_O, P0_I_IN + P0_I_O + P0_I_GU);
        if (BOTH(4)) GRID_BAR();
    }

    if (IN(5)) {
        REFRESH();
        moe_meta(F);
        const LAS int* meta = (const LAS int*)(F.lds + META_OFF);
        LAS int* tokl = (LAS int*)(F.lds + TOKL_OFF);
        pg8::MoeOrder S{meta[97 + 32], F.G, blk, 8, meta + 97, meta + 32, meta + 64};
        { pg8::Unit u; const int* tokidx = (const int*)(ws + WS_TOKIDX);
          LAS float* epil = (LAS float*)(F.lds + EPIL_OFF);
          for (int ui = 0; ui < MAXU && S.next(ui, u); ++ui) { if (F.tid < 256) { const int r = u.rt * 256 + F.tid; tokl[ui * 256 + F.tid] = (r < meta[u.e]) ? tokidx[u.e * CAP + r] : 0; }
              else { const int t = F.tid - 256, pl = u.pn & 7; epil[ui * 256 + t] = args.b_gu[(size_t)u.e * 2048 + ((t < 128) ? (128 * pl + t) : (DFF + 128 * pl + (t - 128)))]; } } }
        __syncthreads();
        pg8::Gemm g{ws + WS_HN, ws + WS_WGU, M, 2 * DFF, D, D};
        pg8::EpiGU E{ws + WS_ACT, (const LAS float*)(F.lds + EPIL_OFF), 1.0f / (HN8_SCALE * W8_SCALE), ACT8_SCALE};
        pg8::gemm_phase<pg8::EpiGU, pg8::MoeOrder, MK_ALIGN5, true, true>(F.lds + RING_OFF, g, S, E, tokl);
        if (BOTH(5)) GRID_BAR();
    }

    if (IN(6)) {
        REFRESH();
        if (!IN(5)) moe_meta(F);
        const LAS int* meta = (const LAS int*)(F.lds + META_OFF);
        pg8::MoeOrder S{meta[130 + 32], F.G, blk, 4, meta + 130, meta + 32, meta + 64};
        LAS int* tokl = (LAS int*)(F.lds + TOKL_OFF);
        { pg8::Unit u; LAS float* epil = (LAS float*)(F.lds + EPIL_OFF); const float* gatew = (const float*)(ws + WS_GATEW);
          for (int ui = 0; ui < 6 && S.next(ui, u); ++ui) { if (F.tid < 256) { tokl[ui * 256 + F.tid] = u.pm * 256 + F.tid; epil[ui * 512 + F.tid] = args.b_down[(size_t)u.e * 1024 + (u.pn & 3) * 256 + F.tid]; }
              else { const int r = u.rt * 256 + (F.tid - 256); epil[ui * 512 + F.tid] = (r < meta[u.e]) ? gatew[(size_t)u.e * CAP + r] * Y8_SCALE : 0.0f; } } }
        __syncthreads();
        pg8::Gemm g{ws + WS_ACT, ws + WS_WD, M, D, DFF, DFF};
        pg8::EpiDown E{ws + WS_Y, (const LAS float*)(F.lds + EPIL_OFF), 1.0f / (ACT8_SCALE * W8_SCALE)};
        pg8::gemm_phase<pg8::EpiDown, pg8::MoeOrder, MK_ALIGN6, true, true>(F.lds + RING_OFF, g, S, E, tokl);
        if (BOTH(6)) GRID_BAR();
    }

    if (IN(7)) {
        REFRESH();
        if (!IN(6)) moe_meta(F);
        final_phase(F, args, blk);
    }
#undef IN
#undef BOTH
#undef GRID_BAR
}

#ifndef MK_STAGE
#define MK_STAGE 0
#endif
#ifndef MK_SPLIT
#define MK_SPLIT 0
#endif

#if MK_STAGE != 0
#endif

extern "C" void kernel_launch(void* const* d_in, const int* in_sizes, int n_in, void* d_out, int out_size, void* d_ws, size_t ws_size, hipStream_t stream) {
    static int grid = 0;
    if (grid == 0) {
        if (n_in != 18 || in_sizes[0] != M * D || out_size != M * D || ws_size < (size_t)1024 * MiB) { fprintf(stderr, "kernel_launch: unexpected shapes / workspace (n_in %d, ws %zu); nothing launched\n", n_in, ws_size); grid = -1; return; }
        int dev = 0, cus = 0, per_cu = 0;
        if (hipGetDevice(&dev) != hipSuccess || hipDeviceGetAttribute(&cus, hipDeviceAttributeMultiprocessorCount, dev) != hipSuccess) { grid = -1; return; }
        if (hipFuncSetAttribute((const void*)mega_fwd, hipFuncAttributeMaxDynamicSharedMemorySize, LDS_BYTES) != hipSuccess) { fprintf(stderr, "kernel_launch: hipFuncSetAttribute failed\n"); grid = -1; return; }
        if (hipOccupancyMaxActiveBlocksPerMultiprocessor(&per_cu, (const void*)mega_fwd, NWAVES * 64, LDS_BYTES) != hipSuccess || per_cu < 1) { fprintf(stderr, "kernel_launch: occupancy query says %d workgroups per CU\n", per_cu); }
        (void)hipGetLastError();
        grid = cus;
        if (grid != 256) { fprintf(stderr, "kernel_launch: built for a 256-CU device, found %d CUs; nothing launched\n", cus); grid = -1; return; }
    }
    if (grid < 0) return;
    if (hipMemsetAsync((char*)d_ws + WS_CTL, 0, CTL_ZERO_BYTES, stream) != hipSuccess) return;
    Args a{};
    a.x = (const float*)d_in[0]; a.norm_mix_g = (const float*)d_in[1]; a.w_in = (const float*)d_in[2]; a.b_f = (const float*)d_in[3]; a.b_glu = (const float*)d_in[4];
    a.w_dw = (const float*)d_in[5]; a.b_dw = (const float*)d_in[6]; a.ln_g = (const float*)d_in[7]; a.ln_b = (const float*)d_in[8]; a.w_out = (const float*)d_in[9];
    a.norm_ffn_g = (const float*)d_in[10]; a.w_router = (const float*)d_in[11]; a.b_router = (const float*)d_in[12]; a.w_gu = (const float*)d_in[13]; a.b_gu = (const float*)d_in[14];
    a.w_down = (const float*)d_in[15]; a.b_down = (const float*)d_in[16]; a.norm_final_g = (const float*)d_in[17];
    a.out = (float*)d_out; a.ws = (unsigned char*)d_ws; a.pad = 0;
    const int ph_end = (MK_STAGE == 0) ? NPHASE : (MK_STAGE + 1);
#if defined(MK_PREFILL)
    (void)hipMemsetAsync((char*)d_ws + WS_MIX, 0xFF, (size_t)M * D * 2, stream);
#endif
#if MK_SPLIT
    for (int p = 0; p < ph_end; ++p) { a.ph_lo = p; a.ph_hi = p + 1; a.li = p; hipLaunchKernelGGL(mega_fwd, dim3(grid), dim3(NWAVES * 64), LDS_BYTES, stream, a); }
#else
    a.ph_lo = 0; a.ph_hi = ph_end; a.li = 0;
    hipLaunchKernelGGL(mega_fwd, dim3(grid), dim3(NWAVES * 64), LDS_BYTES, stream, a);
#endif
#if MK_STAGE != 0
    orc::finish(MK_STAGE, a, stream);
#endif
}
```

```cpp
#include <hip/hip_runtime.h>
#include <hip/hip_bf16.h>
#include <cstdio>
#include <cstdint>
#include <cmath>
#define MK_VARIANT 0
#define MK_DBGSTAT 0
#define MK_ROWA 32
#define MK_ROWB 64
#define MK_NCONV 128
#define PG8_BAUX 0
#define MK_CONVSPLIT 0
#define MK_ALIGN5 true
#define MK_ALIGN6 true
namespace pg8 {
#define PG8_LAS __attribute__((address_space(3)))
typedef unsigned short bf16_t;
typedef short bf16x8 __attribute__((ext_vector_type(8)));
typedef float f32x4 __attribute__((ext_vector_type(4)));
typedef unsigned u32x4 __attribute__((ext_vector_type(4)));
constexpr int BM = 256, BK = 64, HALF = 128, HTB = HALF * BK * 2  , STAGE_BYTES = 8 * HTB, NXCD = 8, WGM = 8;

__host__ __device__ __forceinline__ int lds_byte(int r, int c) { const int st = (r >> 4) * 2 + (c >> 5), rr = r & 15, cc = c & 31, ob = rr * 64 + cc * 2; return st * 1024 + (ob ^ (((ob >> 9) & 1) << 5)); }
__host__ __device__ __forceinline__ void stage_rc(int b, int& R, int& C) { const int st = b / 1024, sb = b % 1024, swz = sb ^ (((sb >> 9) & 1) << 5); R = (st >> 1) * 16 + swz / 64; C = (st & 1) * 32 + (swz % 64) / 2; }
__host__ __device__ __forceinline__ int perm32(int rho) { const int n = rho >> 4, i = rho & 15; return 8 * (i >> 2) + 4 * n + (i & 3); }

struct Unit { int pm, pn, e, rt, seq; };
struct Gemm { const void* A; const void* Bt; int M, N, K, KB; };

struct StaticOrder {
    int nM, nN, nwg, G, c;
    __host__ __device__ void init(int M, int N, int G_, int c_) { nM = M / BM; nN = N / BM; nwg = nM * nN; G = G_; c = c_; }
    __host__ __device__ bool next(int i, Unit& u) const {
        const long L = (long)i * G + c; if (L >= nwg) return false;
        int wgid = (int)L; { const int q = nwg / NXCD, r = nwg % NXCD, xcd = wgid % NXCD, off = wgid / NXCD; wgid = (xcd < r ? xcd * (q + 1) : r * (q + 1) + (xcd - r) * q) + off; }
        const int nig = WGM * nN, gid = wgid / nig, fm = gid * WGM, gsz = (nM - fm) < WGM ? (nM - fm) : WGM;
        u.pm = fm + ((wgid % nig) % gsz); u.pn = (wgid % nig) / gsz; u.e = 0; u.rt = 0; return true;
    }
    __device__ __forceinline__ void a_ready(const Unit&) const {}
    __device__ __forceinline__ void done(const Unit&) const {}
};

__device__ __forceinline__ unsigned cvt_pk_bf16(float lo, float hi) { unsigned r; asm volatile("v_cvt_pk_bf16_f32 %0, %1, %2" : "=v"(r) : "v"(lo), "v"(hi)); return r; }
__device__ __forceinline__ float sigmoid_f(float x) { return __builtin_amdgcn_rcpf(1.0f + __builtin_amdgcn_exp2f(-1.4426950408889634f * x)); }
typedef int i32x4 __attribute__((ext_vector_type(4))); typedef int i32x8 __attribute__((ext_vector_type(8))); typedef unsigned u32x2 __attribute__((ext_vector_type(2)));
__device__ __forceinline__ float clamp448(float x) { return fminf(fmaxf(x, -448.0f), 448.0f); }
__device__ __forceinline__ unsigned pk4_fp8(float a, float b, float c, float d) { int w = __builtin_amdgcn_cvt_pk_fp8_f32(clamp448(a), clamp448(b), 0, false); w = __builtin_amdgcn_cvt_pk_fp8_f32(clamp448(c), clamp448(d), w, true); return (unsigned)w; }
__device__ __forceinline__ unsigned pk4_fp8_nc(float a, float b, float c, float d) { int w = __builtin_amdgcn_cvt_pk_fp8_f32(a, b, 0, false); w = __builtin_amdgcn_cvt_pk_fp8_f32(c, d, w, true); return (unsigned)w; }
__device__ __forceinline__ u32x4 pack8(f32x4 v0, f32x4 v1) { u32x4 w; w.x = cvt_pk_bf16(v0[0], v0[1]); w.y = cvt_pk_bf16(v0[2], v0[3]); w.z = cvt_pk_bf16(v1[0], v1[1]); w.w = cvt_pk_bf16(v1[2], v1[3]); return w; }

struct EpiProj {
    static constexpr bool PERM = true, AFTER_DRAIN = false;
    bf16_t *Q, *U; size_t qkv_stride  ; const PG8_LAS float* bglu  ; float qscale; unsigned* nrm;
    __device__ __forceinline__ void operator()(const f32x4 (&acc)[2][2][4][2], const Unit& u, int wr, int wc, int fr, int fq) const {
        const int row0 = u.pm * BM + wr * 64 + fr;
        if (u.pn < 6) {
            const int t = u.pn >> 1; bf16_t* base = Q + (size_t)t * qkv_stride; const float sc = (t == 0) ? qscale : 1.0f;
            const int col0 = (u.pn & 1) * 256 + wc * 32 + 8 * fq;
#pragma unroll
            for (int ai = 0; ai < 2; ++ai)
#pragma unroll
                for (int m = 0; m < 4; ++m) { bf16_t* rowp = base + (size_t)(row0 + ai * HALF + m * 16) * 512 + col0;
#pragma unroll
                    for (int bj = 0; bj < 2; ++bj) *(u32x4*)(rowp + bj * HALF) = pack8(acc[ai][bj][m][0] * sc, acc[ai][bj][m][1] * sc); }
            if (t < 2) {
#pragma unroll
                for (int bj = 0; bj < 2; ++bj) { float mx = 0.f;
#pragma unroll
                    for (int ai = 0; ai < 2; ++ai)
#pragma unroll
                        for (int m = 0; m < 4; ++m) { const f32x4 a0 = acc[ai][bj][m][0] * sc, a1 = acc[ai][bj][m][1] * sc;
                            float s = (a0[0] * a0[0] + a0[1] * a0[1]) + (a0[2] * a0[2] + a0[3] * a0[3]) + (a1[0] * a1[0] + a1[1] * a1[1]) + (a1[2] * a1[2] + a1[3] * a1[3]);
                            s += __shfl_xor(s, 16); s += __shfl_xor(s, 32); mx = fmaxf(mx, s); }
#pragma unroll
                    for (int o = 1; o < 16; o <<= 1) mx = fmaxf(mx, __shfl_xor(mx, o));
                    if (fr == 0 && fq == 0) { const int head = (u.pn & 1) * 4 + bj * 2 + (wc >> 1), bh = (u.pm >> 5) * 8 + head;
                        __hip_atomic_fetch_max(nrm + (size_t)(((t * 16 + bh) * 2 + (wc & 1)) * 64), __builtin_bit_cast(unsigned, mx), __ATOMIC_RELAXED, __HIP_MEMORY_SCOPE_AGENT); } } }
        } else {
            const int ch0 = (u.pn - 6) * 128 + wc * 32 + 8 * fq;
            f32x4 ba[2], bg[2];
#pragma unroll
            for (int n = 0; n < 2; ++n) { ba[n] = *(const PG8_LAS f32x4*)(bglu + ch0 + 4 * n); bg[n] = *(const PG8_LAS f32x4*)(bglu + 512 + ch0 + 4 * n); }
#pragma unroll
            for (int ai = 0; ai < 2; ++ai)
#pragma unroll
                for (int m = 0; m < 4; ++m) { f32x4 o[2];
#pragma unroll
                    for (int n = 0; n < 2; ++n) { const f32x4 a = acc[ai][0][m][n] + ba[n], g = acc[ai][1][m][n] + bg[n];
#pragma unroll
                        for (int j = 0; j < 4; ++j) o[n][j] = a[j] * sigmoid_f(g[j]); }
                    *(u32x4*)(U + (size_t)(row0 + ai * HALF + m * 16) * 512 + ch0) = pack8(o[0], o[1]); }
        }
    }
};
struct EpiH1 {
    static constexpr bool PERM = true, AFTER_DRAIN = false;
    const bf16_t* xn; const float* rms; const float* g; bf16_t* h1;
    __device__ __forceinline__ void operator()(const f32x4 (&acc)[2][2][4][2], const Unit& u, int wr, int wc, int fr, int fq) const {
        const int row0 = u.pm * BM + wr * 64 + fr, col0 = u.pn * BM + wc * 32 + 8 * fq;
        f32x4 gi[2][2];
#pragma unroll
        for (int bj = 0; bj < 2; ++bj)
#pragma unroll
            for (int n = 0; n < 2; ++n) { const f32x4 gv = *(const f32x4*)(g + col0 + bj * HALF + 4 * n);
                gi[bj][n] = (f32x4){__builtin_amdgcn_rcpf(gv[0]), __builtin_amdgcn_rcpf(gv[1]), __builtin_amdgcn_rcpf(gv[2]), __builtin_amdgcn_rcpf(gv[3])}; }
#pragma unroll
        for (int ai = 0; ai < 2; ++ai) {
            u32x4 xb[4][2]; float rr[4];
#pragma unroll
            for (int m = 0; m < 4; ++m) { const int row = row0 + ai * HALF + m * 16; rr[m] = rms[row];
#pragma unroll
                for (int bj = 0; bj < 2; ++bj) xb[m][bj] = *(const u32x4*)(xn + (size_t)row * 1024 + col0 + bj * HALF); }
            __builtin_amdgcn_sched_barrier(0);
#pragma unroll
            for (int m = 0; m < 4; ++m)
#pragma unroll
                for (int bj = 0; bj < 2; ++bj) { const int row = row0 + ai * HALF + m * 16; const size_t p = (size_t)row * 1024 + col0 + bj * HALF;
                    const u32x4 b = xb[m][bj]; const float r = rr[m];
                    const f32x4 x0 = (f32x4){__builtin_bit_cast(float, b.x << 16), __builtin_bit_cast(float, b.x & 0xffff0000u), __builtin_bit_cast(float, b.y << 16), __builtin_bit_cast(float, b.y & 0xffff0000u)} * r * gi[bj][0];
                    const f32x4 x1 = (f32x4){__builtin_bit_cast(float, b.z << 16), __builtin_bit_cast(float, b.z & 0xffff0000u), __builtin_bit_cast(float, b.w << 16), __builtin_bit_cast(float, b.w & 0xffff0000u)} * r * gi[bj][1];
                    *(u32x4*)(h1 + p) = pack8(acc[ai][bj][m][0] + x0, acc[ai][bj][m][1] + x1); }
            __builtin_amdgcn_sched_barrier(0);
        }
    }
};
struct EpiGU {
    static constexpr bool PERM = true, AFTER_DRAIN = false;
    unsigned char* act; const PG8_LAS float* tab  ; float acc_scale, out_scale;
    __device__ __forceinline__ void operator()(const f32x4 (&acc)[2][2][4][2], const Unit& u, int wr, int wc, int fr, int fq) const {
        const int row0 = u.pm * BM + wr * 64 + fr, pl = u.pn & 7, ch0 = pl * 128 + wc * 32 + 8 * fq;
        const PG8_LAS float* bp = tab + u.seq * 256 + wc * 32 + 8 * fq;
        f32x4 bgt[2], bup[2];
#pragma unroll
        for (int n = 0; n < 2; ++n) { bgt[n] = *(const PG8_LAS f32x4*)(bp + 4 * n); bup[n] = *(const PG8_LAS f32x4*)(bp + 128 + 4 * n); }
#pragma unroll
        for (int ai = 0; ai < 2; ++ai)
#pragma unroll
            for (int m = 0; m < 4; ++m) { f32x4 o[2];
#pragma unroll
                for (int n = 0; n < 2; ++n) { const f32x4 g = acc[ai][0][m][n] * acc_scale + bgt[n], up = acc[ai][1][m][n] * acc_scale + bup[n];
#pragma unroll
                    for (int j = 0; j < 4; ++j) { const float hg = fminf(g[j], 7.0f), hu = fminf(fmaxf(up[j], -7.0f), 7.0f);
                        o[n][j] = fmaf(hu, out_scale, out_scale) * (hg * __builtin_amdgcn_rcpf(1.0f + __builtin_amdgcn_exp2f(hg * (-1.702f * 1.4426950408889634f)))); } }
                u32x2 w; w.x = pk4_fp8_nc(o[0][0], o[0][1], o[0][2], o[0][3]); w.y = pk4_fp8_nc(o[1][0], o[1][1], o[1][2], o[1][3]);
                *(u32x2*)(act + (size_t)(row0 + ai * HALF + m * 16) * 1024 + ch0) = w; }
    }
};
struct EpiDown {
    static constexpr bool PERM = true, AFTER_DRAIN = false;
    unsigned char* y; const PG8_LAS float* tab  ; float acc_scale;
    __device__ __forceinline__ void operator()(const f32x4 (&acc)[2][2][4][2], const Unit& u, int wr, int wc, int fr, int fq) const {
        const int r0 = wr * 64 + fr, pl = u.pn & 3, col0 = pl * 256 + wc * 32 + 8 * fq;
        const PG8_LAS float* tp = tab + u.seq * 512; const PG8_LAS float* bp = tp + wc * 32 + 8 * fq;
        f32x4 bv[2][2];
#pragma unroll
        for (int bj = 0; bj < 2; ++bj)
#pragma unroll
            for (int n = 0; n < 2; ++n) bv[bj][n] = *(const PG8_LAS f32x4*)(bp + bj * HALF + 4 * n);
#pragma unroll
        for (int ai = 0; ai < 2; ++ai)
#pragma unroll
            for (int m = 0; m < 4; ++m) { const int r = r0 + ai * HALF + m * 16; const float gt = tp[256 + r];
                unsigned char* rowp = y + (size_t)(u.pm * BM + r) * 1024 + col0;
#pragma unroll
                for (int bj = 0; bj < 2; ++bj) { const f32x4 v0 = (acc[ai][bj][m][0] * acc_scale + bv[bj][0]) * gt, v1 = (acc[ai][bj][m][1] * acc_scale + bv[bj][1]) * gt;
                    u32x2 w; w.x = pk4_fp8(v0[0], v0[1], v0[2], v0[3]); w.y = pk4_fp8(v1[0], v1[1], v1[2], v1[3]); *(u32x2*)(rowp + bj * HALF) = w; } }
    }
};

struct MoeOrder {
    int nwg, G, c, NPN; const PG8_LAS int* ustart; const PG8_LAS int* ntile; const PG8_LAS int* tileoff;
    __device__ __forceinline__ bool next(int i, Unit& u) const {
        const int L = i * G + c; if (L >= nwg) return false;
        int wgid = L; { const int q = nwg / NXCD, r = nwg % NXCD, xcd = wgid % NXCD, off = wgid / NXCD; wgid = (xcd < r ? xcd * (q + 1) : r * (q + 1) + (xcd - r) * q) + off; }
        int e = 0;
        for (int k = 1; k < 32; ++k) e += (ustart[k] <= wgid) ? 1 : 0;
        e = __builtin_amdgcn_readfirstlane(e);
        const int l = wgid - ustart[e], rt = l / NPN, pl = l - rt * NPN;
        u.pm = __builtin_amdgcn_readfirstlane(tileoff[e] + rt); u.pn = __builtin_amdgcn_readfirstlane(e * NPN + pl); u.e = e; u.rt = __builtin_amdgcn_readfirstlane(rt); return true;
    }
    __device__ __forceinline__ void a_ready(const Unit&) const {}
    __device__ __forceinline__ void done(const Unit&) const {}
};

#ifndef PG8_BAUX
#define PG8_BAUX 0
#endif
template <class Epi, class Sched, bool ALIGN_EPI, bool GATHER, bool F8>
__device__ __forceinline__ void gemm_phase(PG8_LAS unsigned char* lds, const Gemm g, const Sched& S, const Epi& E, const PG8_LAS int* tokl) {
    const int tid = threadIdx.x, wid = __builtin_amdgcn_readfirstlane(tid >> 6), lane = tid & 63, wr = wid >> 2, wc = wid & 3, fr = lane & 15, fq = lane >> 4;
    const int KB = g.KB, nt = KB / 128;
    unsigned voffB[2];
#pragma unroll
    for (int i = 0; i < 2; ++i) { int R, C; stage_rc(tid * 16 + i * 8192, R, C); const int Rb = Epi::PERM ? ((R & ~31) + perm32(R & 31)) : R;
        voffB[i] = (unsigned)(Rb * KB + C * 2); }
    const size_t kstep = (size_t)(BK * 2);
    const size_t hstep = (size_t)HALF * KB;
    const size_t tstep = 2 * hstep;
    const unsigned ldsw = (unsigned)wid * 1024u;
    const int aoff = lds_byte(wr * 64 + fr, fq * 8), boff = lds_byte(wc * 32 + fr, fq * 8);
#define PG8_SA(b, h) (((b) * 2 + (h)) * HTB)
#define PG8_SB(b, h) ((4 + (b) * 2 + (h)) * HTB)
#define PG8_STAGE(bufoff, gbase, voff) do { _Pragma("unroll") for (int _i = 0; _i < 2; ++_i) \
        __builtin_amdgcn_global_load_lds((const unsigned*)((const char*)(gbase) + (voff)[_i]), (PG8_LAS unsigned*)(lds + (bufoff) + ldsw + _i * 8192), 16, 0, 0); } while (0)
#define PG8_STAGEB(bufoff, gbase, voff) do { _Pragma("unroll") for (int _i = 0; _i < 2; ++_i) \
        __builtin_amdgcn_global_load_lds((const unsigned*)((const char*)(gbase) + (voff)[_i]), (PG8_LAS unsigned*)(lds + (bufoff) + ldsw + _i * 8192), 16, 0, PG8_BAUX); } while (0)
#define PG8_LDA(dst, b, h) do { _Pragma("unroll") for (int m = 0; m < 4; ++m) _Pragma("unroll") for (int k = 0; k < 2; ++k) dst[m][k] = *(const PG8_LAS bf16x8*)(lds + PG8_SA(b, h) + aoff + m * 2048 + k * 1024); } while (0)
#define PG8_LDB(dst, b, h) do { _Pragma("unroll") for (int n = 0; n < 2; ++n) _Pragma("unroll") for (int k = 0; k < 2; ++k) dst[n][k] = *(const PG8_LAS bf16x8*)(lds + PG8_SB(b, h) + boff + n * 2048 + k * 1024); } while (0)
#define PG8_CAT(X) __builtin_shufflevector(__builtin_bit_cast(i32x4, (X)[0]), __builtin_bit_cast(i32x4, (X)[1]), 0, 1, 2, 3, 4, 5, 6, 7)
#define PG8_MMA(ai, bj, At, Bt) do { __builtin_amdgcn_s_setprio(1); if constexpr (F8) { _Pragma("unroll") for (int m = 0; m < 4; ++m) _Pragma("unroll") for (int n = 0; n < 2; ++n) \
        acc[ai][bj][m][n] = __builtin_amdgcn_mfma_scale_f32_16x16x128_f8f6f4(PG8_CAT(Bt[n]), PG8_CAT(At[m]), acc[ai][bj][m][n], 0, 0, 0, 0x7f7f7f7f, 0, 0x7f7f7f7f); } else { \
        _Pragma("unroll") for (int m = 0; m < 4; ++m) _Pragma("unroll") for (int n = 0; n < 2; ++n) _Pragma("unroll") for (int k = 0; k < 2; ++k) \
        acc[ai][bj][m][n] = __builtin_amdgcn_mfma_f32_16x16x32_bf16(Bt[n][k], At[m][k], acc[ai][bj][m][n], 0, 0, 0); } __builtin_amdgcn_s_setprio(0); } while (0)
#define PG8_WAIT_V(n) asm volatile("s_waitcnt vmcnt(" #n ")" ::: "memory")
#define PG8_WAIT_L(n) asm volatile("s_waitcnt lgkmcnt(" #n ")" ::: "memory")
#define PG8_BAR __builtin_amdgcn_s_barrier()
#define PG8_SCHED __builtin_amdgcn_sched_barrier(0)
#define PG8_SETOFF(V, UIDX) do { _Pragma("unroll") for (int _i = 0; _i < 2; ++_i) { int _R, _C; { int _t = threadIdx.x; asm volatile("" : "+v"(_t)); stage_rc(_t * 16 + _i * 8192, _R, _C); } \
        _Pragma("unroll") for (int _h = 0; _h < 2; ++_h) { const unsigned _r = GATHER ? (unsigned)tokl[(UIDX) * 256 + _h * HALF + _R] : (unsigned)(_h * HALF + _R); V[_h][_i] = _r * (unsigned)KB + (unsigned)(_C * 2); } } } while (0)
    Unit cur, nxt; int ui = 0;
    if (!S.next(0, cur)) return;
    cur.seq = 0;
    f32x4 acc[2][2][4][2];
#pragma unroll
    for (int a = 0; a < 2; ++a)
#pragma unroll
        for (int b = 0; b < 2; ++b)
#pragma unroll
            for (int m = 0; m < 4; ++m)
#pragma unroll
                for (int n = 0; n < 2; ++n) acc[a][b][m][n] = (f32x4){0.f, 0.f, 0.f, 0.f};
    bf16x8 At[4][2], B0[2][2], B1[2][2];
    unsigned voA[2][2];
    const char* cA = GATHER ? (const char*)g.A : (const char*)g.A + (size_t)cur.pm * tstep; const char* cB = (const char*)g.Bt + (size_t)cur.pn * tstep;
    PG8_SETOFF(voA, 0);
    S.a_ready(cur);
    PG8_STAGEB(PG8_SB(0, 0), cB, voffB); PG8_STAGEB(PG8_SB(0, 1), cB + hstep, voffB); PG8_STAGE(PG8_SA(0, 0), cA, voA[0]); PG8_STAGE(PG8_SA(0, 1), cA, voA[1]);
    if (wr == 1) PG8_BAR;
    PG8_WAIT_V(2); PG8_BAR;
    PG8_STAGEB(PG8_SB(1, 0), cB + kstep, voffB); PG8_STAGE(PG8_SA(1, 0), cA + kstep, voA[0]); PG8_STAGEB(PG8_SB(1, 1), cB + hstep + kstep, voffB);
    PG8_WAIT_V(6); PG8_BAR;
    for (;;) {
        const bool has_next = S.next(ui + 1, nxt);
        const char* nA = has_next ? (GATHER ? (const char*)g.A : (const char*)g.A + (size_t)nxt.pm * tstep) : cA; const char* nB = has_next ? (const char*)g.Bt + (size_t)nxt.pn * tstep : cB;
#pragma clang loop unroll(disable)
        for (int t = 0; t < nt; t += 2) {
            const bool last = (t == nt - 2);
            const char* a1 = cA + (size_t)(t + 1) * kstep;
            const char* a2 = last ? nA : cA + (size_t)(t + 2) * kstep; const char* b2 = last ? nB : cB + (size_t)(t + 2) * kstep;
            const char* a3 = a2 + kstep; const char* b3 = b2 + kstep;
            if (last && has_next) S.a_ready(nxt);
            PG8_LDB(B0, 0, 0); PG8_LDB(B1, 0, 1); PG8_SCHED; PG8_LDA(At, 0, 0); PG8_STAGE(PG8_SA(1, 1), a1, voA[1]);
            if (GATHER && last && has_next) { PG8_SETOFF(voA, ui + 1); }
            PG8_WAIT_V(8); PG8_WAIT_L(0); PG8_BAR; PG8_MMA(0, 0, At, B0); PG8_MMA(0, 1, At, B1); PG8_BAR; PG8_SCHED;
            PG8_LDA(At, 0, 1); PG8_STAGEB(PG8_SB(0, 0), b2, voffB); PG8_STAGEB(PG8_SB(0, 1), b2 + hstep, voffB); PG8_STAGE(PG8_SA(0, 0), a2, voA[0]);
            PG8_WAIT_V(8); PG8_WAIT_L(0); PG8_BAR; PG8_MMA(1, 0, At, B0); PG8_MMA(1, 1, At, B1); PG8_BAR; PG8_SCHED;
            PG8_LDB(B0, 1, 0); PG8_LDB(B1, 1, 1); PG8_SCHED; PG8_LDA(At, 1, 0); PG8_STAGE(PG8_SA(0, 1), a2, voA[1]);
            PG8_WAIT_V(8); PG8_WAIT_L(0); PG8_BAR; PG8_MMA(0, 0, At, B0); PG8_MMA(0, 1, At, B1); PG8_BAR; PG8_SCHED;
            PG8_LDA(At, 1, 1); PG8_STAGEB(PG8_SB(1, 0), b3, voffB); PG8_STAGEB(PG8_SB(1, 1), b3 + hstep, voffB); PG8_STAGE(PG8_SA(1, 0), a3, voA[0]);
            PG8_WAIT_V(8); PG8_WAIT_L(0); PG8_BAR; PG8_MMA(1, 0, At, B0); PG8_MMA(1, 1, At, B1); PG8_BAR; PG8_SCHED;
        }
        if constexpr (ALIGN_EPI) { if (wr == 0) PG8_BAR; }
        E(acc, cur, wr, wc, fr, fq); S.done(cur);
        if (!has_next) break;
#pragma unroll
        for (int a = 0; a < 2; ++a)
#pragma unroll
            for (int b = 0; b < 2; ++b)
#pragma unroll
                for (int m = 0; m < 4; ++m)
#pragma unroll
                    for (int n = 0; n < 2; ++n) acc[a][b][m][n] = (f32x4){0.f, 0.f, 0.f, 0.f};
        cur = nxt; cA = nA; cB = nB; ++ui; cur.seq = ui;
        if constexpr (ALIGN_EPI) { if (wr == 1) PG8_BAR; }
    }
    PG8_WAIT_V(0);
    if constexpr (!ALIGN_EPI) { if (wr == 0) PG8_BAR; }
    PG8_BAR;
#undef PG8_SA
#undef PG8_SB
#undef PG8_STAGE
#undef PG8_STAGEB
#undef PG8_LDA
#undef PG8_LDB
#undef PG8_MMA
#undef PG8_CAT
#undef PG8_WAIT_V
#undef PG8_WAIT_L
#undef PG8_BAR
#undef PG8_SCHED
#undef PG8_SETOFF
}
}
namespace attn_body {
using bf16=__hip_bfloat16;
using bf16x8=__attribute__((ext_vector_type(8)))short;
using s16x4=__attribute__((ext_vector_type(4)))short;
using f32x16=__attribute__((ext_vector_type(16)))float;
using u32x4=__attribute__((ext_vector_type(4)))unsigned;
using f32x4_t=__attribute__((ext_vector_type(4)))float;
constexpr int BATCH=2,NHEAD=8,SEQ=8192,D=64,DM=NHEAD*D,OPITCH=1024;
constexpr int NW=8,QBLK=32,QB=QBLK*NW,KVBLK=64,NQB=SEQ/QB;
constexpr int ATTN_PITCH=DM, ATTN_UNIT_ROWS=QB;
__device__ __forceinline__ int crow(int r,int hi){return (r&3)+8*(r>>2)+4*hi;}
#define SBAR() __builtin_amdgcn_sched_barrier(0)
__device__ __forceinline__ void cmask(f32x16&p0,f32x16&p1,int jb,int qrel,int hi){
  const float NEG=-INFINITY; int kb=64*jb+4*hi;
  #pragma unroll
  for(int r=0;r<16;++r){int kv=kb+(r&3)+8*(r>>2); if(kv>qrel)p0[r]=NEG; if(kv+32>qrel)p1[r]=NEG;}
}

constexpr int NSLOT=3, SLOTB=8192;
constexpr int LDS_K=0, LDS_V=NSLOT*SLOTB, LDS_WS=2*NSLOT*SLOTB, LDS_OST=LDS_WS+NW*64*4, LDS_C=LDS_OST+NW*4096, LDS_BYTES=LDS_C+SEQ*4;
constexpr float C2=0.125f*1.4426950408889634f;
__device__ __forceinline__ void glds16(const void*gsrc,unsigned lds_dst){unsigned keep;
  asm volatile("s_mov_b32 %0, m0\n\ts_mov_b32 m0, %2\n\ts_nop 0\n\tglobal_load_lds_dwordx4 %1, off\n\ts_mov_b32 m0, %0":"=&s"(keep):"v"(gsrc),"s"(lds_dst):"memory");}
__device__ __forceinline__ float max3f(float a,float b,float c){float r;asm("v_max3_f32 %0, %1, %2, %3":"=v"(r):"v"(a),"v"(b),"v"(c));return r;}
__device__ __forceinline__ float max2f(float a,float b){float r;asm("v_max_f32_e32 %0, %1, %2":"=v"(r):"v"(a),"v"(b));return r;}
__device__ __forceinline__ float fadd_s(float a,float b){float r;asm("v_add_f32_e32 %0, %1, %2":"=v"(r):"v"(a),"v"(b));return r;}
__device__ __forceinline__ float fsub_s(float a,float b){float r;asm("v_sub_f32_e32 %0, %1, %2":"=v"(r):"v"(a),"v"(b));return r;}
typedef float f32x2_t __attribute__((ext_vector_type(2))); typedef __bf16 bf16x2_t __attribute__((ext_vector_type(2)));
__device__ __forceinline__ unsigned cvtpk_s(float lo,float hi){f32x2_t v={lo,hi};bf16x2_t b=__builtin_convertvector(v,bf16x2_t);return __builtin_bit_cast(unsigned,b);}
#define WAIT_BAR(N) asm volatile("s_waitcnt vmcnt(" #N ") lgkmcnt(0)\n\ts_barrier":::"memory")

__device__ __forceinline__ void qkt(f32x16&p0,f32x16&p1,const char*Kslot,const bf16x8*qr,const f32x16&c0,const f32x16&c1,int r32,int hi){
  const char*kb=Kslot+hi*1024+r32*16;
  #pragma unroll
  for(int d0=0;d0<4;++d0){
    const bf16x8 b0=*reinterpret_cast<const bf16x8*>(kb+d0*2048);
    const bf16x8 b1=*reinterpret_cast<const bf16x8*>(kb+d0*2048+512);
    if(d0==0){p0=__builtin_amdgcn_mfma_f32_32x32x16_bf16(b0,qr[0],c0,0,0,0);p1=__builtin_amdgcn_mfma_f32_32x32x16_bf16(b1,qr[0],c1,0,0,0);}
    else{p0=__builtin_amdgcn_mfma_f32_32x32x16_bf16(b0,qr[d0],p0,0,0,0);p1=__builtin_amdgcn_mfma_f32_32x32x16_bf16(b1,qr[d0],p1,0,0,0);}}
}
typedef __attribute__((address_space(3))) const char* lds_cptr;
typedef short v4i16_t __attribute__((ext_vector_type(4)));
__device__ __forceinline__ void kload8(bf16x8*kf,lds_cptr kp){
  kf[0]=*(const __attribute__((address_space(3))) bf16x8*)(kp);      kf[1]=*(const __attribute__((address_space(3))) bf16x8*)(kp+512);
  kf[2]=*(const __attribute__((address_space(3))) bf16x8*)(kp+2048); kf[3]=*(const __attribute__((address_space(3))) bf16x8*)(kp+2560);
  kf[4]=*(const __attribute__((address_space(3))) bf16x8*)(kp+4096); kf[5]=*(const __attribute__((address_space(3))) bf16x8*)(kp+4608);
  kf[6]=*(const __attribute__((address_space(3))) bf16x8*)(kp+6144); kf[7]=*(const __attribute__((address_space(3))) bf16x8*)(kp+6656);
}
__device__ __forceinline__ void kload2(bf16x8*kf,lds_cptr kp,int j){ kf[2*j]=*(const __attribute__((address_space(3))) bf16x8*)(kp+j*2048); kf[2*j+1]=*(const __attribute__((address_space(3))) bf16x8*)(kp+j*2048+512); }
__device__ __forceinline__ s16x4 vtr(lds_cptr p){ return __builtin_bit_cast(s16x4,__builtin_amdgcn_ds_read_tr16_b64_v4i16((__attribute__((address_space(3))) v4i16_t*)p)); }
__device__ __forceinline__ float rowmax(const f32x16&p0,const f32x16&p1){
  float a=max3f(p0[0],p0[1],p1[0]),b=max3f(p0[2],p0[3],p1[1]);a=max3f(a,p1[2],p1[3]);
  #pragma unroll
  for(int r=4;r<16;r+=4){a=max3f(a,p0[r],p0[r+1]);b=max3f(b,p0[r+2],p0[r+3]);a=max3f(a,p1[r],p1[r+1]);b=max3f(b,p1[r+2],p1[r+3]);}
  const float m=max2f(a,b);
  auto rr=__builtin_amdgcn_permlane32_swap(__float_as_uint(m),__float_as_uint(m),false,false);
  return max2f(__uint_as_float(rr[0]),__uint_as_float(rr[1]));
}
__device__ __forceinline__ void pv(f32x16*o,int vb,bf16x8 pa0,bf16x8 pa1,bf16x8 pa2,bf16x8 pa3){
  #pragma unroll
  for(int d0=0;d0<2;++d0){s16x4 lo[4],hi[4];
    #pragma unroll
    for(int ks=0;ks<4;++ks){
      asm volatile("ds_read_b64_tr_b16 %0,%1 offset:%c2":"=&v"(lo[ks]):"v"(vb),"i"(d0*4096+ks*1024):"memory");
      asm volatile("ds_read_b64_tr_b16 %0,%1 offset:%c2":"=&v"(hi[ks]):"v"(vb),"i"(d0*4096+ks*1024+512):"memory");}
    asm volatile("s_waitcnt lgkmcnt(0)":::"memory");SBAR();
    #define PK(k) (bf16x8){lo[k][0],lo[k][1],lo[k][2],lo[k][3],hi[k][0],hi[k][1],hi[k][2],hi[k][3]}
    o[d0]=__builtin_amdgcn_mfma_f32_32x32x16_bf16(pa0,PK(0),o[d0],0,0,0);
    o[d0]=__builtin_amdgcn_mfma_f32_32x32x16_bf16(pa1,PK(1),o[d0],0,0,0);
    o[d0]=__builtin_amdgcn_mfma_f32_32x32x16_bf16(pa2,PK(2),o[d0],0,0,0);
    o[d0]=__builtin_amdgcn_mfma_f32_32x32x16_bf16(pa3,PK(3),o[d0],0,0,0);
    #undef PK
  }
}

#ifndef ATTN_STORE16
#define ATTN_STORE16(p,v) (*(u32x4*)(p)=(v))
#endif
template<int THRL> __device__ __forceinline__ void attn_unit(int b,int h,int qb,const bf16*Q,const bf16*__restrict__ K,const bf16*__restrict__ V,bf16*O,const float*__restrict__ CP,const unsigned*__restrict__ NRM,char*shm){
  const int tid=threadIdx.x,lane=tid&63,r32=lane&31,hi=lane>>5; const int wid=__builtin_amdgcn_readfirstlane(tid>>6);
  const long rowbase=(long)b*SEQ; const int q0=qb*QB;
  const bf16*Qw=Q+(rowbase+q0+wid*QBLK)*DM+h*D;
  const bf16*Kh=K+rowbase*DM+h*D,*Vh=V+rowbase*DM+h*D;
  const unsigned lds0=(unsigned)(uintptr_t)shm;
  const lds_cptr shm3=(lds_cptr)shm;
  float*wsf=(float*)(shm+LDS_WS)+wid*64;
  const bf16*ksrc=Kh+(long)lane*DM+wid*8;
  const bf16*vsrc=Vh+(long)(16*(wid&3)+(lane>>2))*DM+(wid>>2)*32+(lane&3)*8;
  const unsigned kdst=lds0+LDS_K+wid*1024, vdst=lds0+LDS_V+wid*1024;
  #define DMA_K(t,slot) glds16(ksrc+(long)TIDX(t)*KVBLK*DM,(unsigned)__builtin_amdgcn_readfirstlane(kdst+(slot)))
  #define DMA_V(t,slot) glds16(vsrc+(long)TIDX(t)*KVBLK*DM,(unsigned)__builtin_amdgcn_readfirstlane(vdst+(slot)))
  const int vb0=(int)(lds0+LDS_V)+((lane>>4)&1)*32+(lane&3)*8+(4*hi+((lane&15)>>2))*64;
  const char*Kbase=shm+LDS_K; bf16x8 kf[8];
  const lds_cptr kp0=shm3+LDS_K+hi*1024+r32*16; const lds_cptr vp0=shm3+LDS_V+((lane>>4)&1)*32+(lane&3)*8+(4*hi+((lane&15)>>2))*64;
  const int NT=(q0+QB)/KVBLK;
#if defined(ATT_ORIGORDER)
  #define TIDX(p) (p)
  #define JBOF(t) ((t)-(NT-4))
#else
  #define TIDX(p) (((p)<4)?(NT-4+(p)):(NT-1-(p)))
  #define JBOF(t) (((t)<4)?(t):-1)
#endif
  const float*cg=CP+(long)(b*NHEAD+h)*SEQ;
  typedef __attribute__((address_space(3))) const f32x4_t* lds_c4;
#if !defined(ATT_NOSTAGE)
  { float*cl=(float*)(shm+LDS_C); const int nk=q0+QB; for(int i=tid*4;i<nk;i+=NW*64*4)*(f32x4_t*)(cl+i)=*(const f32x4_t*)(cg+i); }
#endif
  const lds_c4 cl4=(lds_c4)(shm3+LDS_C)+hi;
#if defined(ATT_NOBIAS)
  #define CBIAS(C0,C1,a) do{ _Pragma("unroll") for(int g_=0;g_<16;++g_){ C0[g_]=nm; C1[g_]=nm; } }while(0)
#else
  #define CBIAS(C0,C1,a) do{ const lds_c4 cp_=cl4+16*(a); _Pragma("unroll") for(int g_=0;g_<4;++g_){ const f32x4_t v_=cp_[2*g_], w_=cp_[8+2*g_]; \
      C0[4*g_]=nm-v_[0];C0[4*g_+1]=nm-v_[1];C0[4*g_+2]=nm-v_[2];C0[4*g_+3]=nm-v_[3]; C1[4*g_]=nm-w_[0];C1[4*g_+1]=nm-w_[1];C1[4*g_+2]=nm-w_[2];C1[4*g_+3]=nm-w_[3]; } }while(0)
#endif
  DMA_K(0,0);DMA_V(0,0);DMA_K(1,SLOTB);
  bf16x8 qr[4];
  #pragma unroll
  for(int d0=0;d0<4;++d0)qr[d0]=*reinterpret_cast<const bf16x8*>(&Qw[(long)r32*DM+d0*16+hi*8]);
  #if defined(ATT_NOBIAS)
  float l_reg=0.f,nm=0.f;
#else
  float l_reg=0.f,nm=cg[q0+wid*QBLK+r32];
#endif
  f32x16 o[2];o[0]=f32x16{};o[1]=f32x16{};
  const int qrel=wid*QBLK+r32;
  #define CMASK(P0,P1,t) do{int jb_=JBOF(t); if(jb_>=0)cmask(P0,P1,jb_,qrel,hi);}while(0)
  bool resc=false;
  #define START(P0,P1) do{ const float rm=rowmax(P0,P1); resc=false; \
    { const float dl=rm; \
      _Pragma("unroll") for(int r=0;r<16;++r){P0[r]=fsub_s(P0[r],dl);P1[r]=fsub_s(P1[r],dl);} \
      nm=fsub_s(nm,dl); } \
    _Pragma("unroll") for(int r=0;r<16;++r)P0[r]=__builtin_amdgcn_exp2f(P0[r]); }while(0)
  #define RESC() do{ if(resc){ asm volatile("s_waitcnt lgkmcnt(0)":::"memory"); \
      _Pragma("unroll") for(int d_=0;d_<2;++d_) _Pragma("unroll") for(int r=0;r<16;++r)o[d_][r]*=wsf[crow(r,hi)]; } }while(0)
  f32x16 pA0,pA1,pB0,pB1;
  int sl_prev=0,sl_cur=0,sl_next=SLOTB;
  #define ROT() do{sl_prev=sl_cur;sl_cur=sl_next;sl_next=(sl_next==(NSLOT-1)*SLOTB)?0:sl_next+SLOTB;}while(0)
  DMA_K(2,2*SLOTB);
  WAIT_BAR(3);
  int NTe=NT;
#if !defined(ATT_NOSKIP)
  { const unsigned*np=NRM+(size_t)((b*NHEAD+h)*2)*64; const float qn=__builtin_bit_cast(float,np[0])+__builtin_bit_cast(float,np[64]), kn=__builtin_bit_cast(float,np[16*2*64])+__builtin_bit_cast(float,np[16*2*64+64]);
    const float thr=40.0f+2.0f*1.02f*sqrtf(qn*kn); const __attribute__((address_space(3))) float*cls=(const __attribute__((address_space(3))) float*)(shm3+LDS_C);
    const float cq0=cls[q0]; int lo_=0,hi_=NT-4;
    while(lo_<hi_){ const int mid=(lo_+hi_)>>1; if(cq0-cls[64*mid+63]>=-thr)hi_=mid; else lo_=mid+1; }
    NTe=4+(NT-4-lo_); NTe+=NTe&1; NTe=__builtin_amdgcn_readfirstlane(NTe); }
#endif
  { f32x16 cb0,cb1; CBIAS(cb0,cb1,TIDX(0)); qkt(pA0,pA1,Kbase,qr,cb0,cb1,r32,hi); } asm volatile("s_nop 15\n\ts_nop 7":"+v"(pA0),"+v"(pA1));CMASK(pA0,pA1,0);
  START(pA0,pA1);
  _Pragma("unroll") for(int r=0;r<16;++r)pA1[r]=__builtin_amdgcn_exp2f(pA1[r]);
  WAIT_BAR(0);
  DMA_K(3,0);DMA_V(1,SLOTB);
  ROT();
  kload8(kf,kp0+sl_cur);
  WAIT_BAR(2);
  s16x4 vlo[8],vhi[8]; u32x4 pw0,pw1,pw2,pw3;
  #define PKW(P,B) cvtpk_s(P[B],P[B+1])
  #define PAF(k) __builtin_bit_cast(bf16x8,pw##k)
  #define VFR(i) (bf16x8){vlo[i][0],vlo[i][1],vlo[i][2],vlo[i][3],vhi[i][0],vhi[i][1],vhi[i][2],vhi[i][3]}
  #define PIN(x) asm volatile("":"+v"(x))
  #define MX3(a,b,c) __builtin_fmaxf(__builtin_fmaxf((a),(b)),(c))
  #define GAPA(MF,A0,A1,A2,A3,W0,W1,PW) do{ MF; sacc+=A0; sacc+=A1; sacc+=A2; sacc+=A3; PIN(sacc); W0; W1; PIN(PW); SBAR(); }while(0)
  #define EX(v) __builtin_amdgcn_exp2f(v)
  #define GAPB(MF,X,B) do{ MF; X[B]=EX(X[B]); X[B+1]=EX(X[B+1]); X[B+2]=EX(X[B+2]); X[B+3]=EX(X[B+3]); PIN(X); SBAR(); }while(0)
  #define VRD(i) do{ vlo[i]=vtr(vp_+(((i)>>2)*4096+((i)&3)*1024)); vhi[i]=vtr(vp_+(((i)>>2)*4096+((i)&3)*1024+512)); }while(0)
  #define KRD(G,j) do{ if(G){ kload2(kf,kp0+sl_next,j); SBAR(); } }while(0)
  #define STEP(C0,C1,P0,P1,t,GK,GV,GL) do{ SBAR(); \
    CBIAS(C0,C1,TIDX(t)); SBAR(); \
    const lds_cptr vp_=vp0+sl_prev; \
    VRD(0); SBAR(); float sacc=(P0[0]+P0[1]); \
    GAPA(C0=__builtin_amdgcn_mfma_f32_32x32x16_bf16(kf[0],qr[0],C0,0,0,0), P0[2],P0[3],P0[4],P0[5],     pw0[0]=PKW(P0,0), pw0[1]=PKW(P0,2), pw0); \
    VRD(4); SBAR(); GAPA(C1=__builtin_amdgcn_mfma_f32_32x32x16_bf16(kf[1],qr[0],C1,0,0,0), P0[6],P0[7],P0[8],P0[9],     pw0[2]=PKW(P0,4), pw0[3]=PKW(P0,6), pw0); \
    VRD(1); SBAR(); GAPA(C0=__builtin_amdgcn_mfma_f32_32x32x16_bf16(kf[2],qr[1],C0,0,0,0),   P0[10],P0[11],P0[12],P0[13], pw1[0]=PKW(P0,8), pw1[1]=PKW(P0,10), pw1); \
    VRD(5); SBAR(); GAPA(C1=__builtin_amdgcn_mfma_f32_32x32x16_bf16(kf[3],qr[1],C1,0,0,0),   P0[14],P0[15],P1[0],P1[1],   pw1[2]=PKW(P0,12),pw1[3]=PKW(P0,14), pw1); \
    VRD(2); SBAR(); GAPA(C0=__builtin_amdgcn_mfma_f32_32x32x16_bf16(kf[4],qr[2],C0,0,0,0),   P1[2],P1[3],P1[4],P1[5],     pw2[0]=PKW(P1,0), pw2[1]=PKW(P1,2), pw2); \
    VRD(6); SBAR(); GAPA(C1=__builtin_amdgcn_mfma_f32_32x32x16_bf16(kf[5],qr[2],C1,0,0,0),   P1[6],P1[7],P1[8],P1[9],     pw2[2]=PKW(P1,4), pw2[3]=PKW(P1,6), pw2); \
    VRD(3); SBAR(); GAPA(C0=__builtin_amdgcn_mfma_f32_32x32x16_bf16(kf[6],qr[3],C0,0,0,0),   P1[10],P1[11],P1[12],P1[13], pw3[0]=PKW(P1,8), pw3[1]=PKW(P1,10), pw3); \
    VRD(7); SBAR(); GAPA(C1=__builtin_amdgcn_mfma_f32_32x32x16_bf16(kf[7],qr[3],C1,0,0,0),   P1[14],P1[15],0.f,0.f,       pw3[2]=PKW(P1,12),pw3[3]=PKW(P1,14), pw3); \
    l_reg+=sacc; \
    if(GK){DMA_K((t)+3,sl_cur);} if(GV){DMA_V((t)+1,sl_next);} \
    CMASK(C0,C1,t); \
    { float a=MX3(C0[0],C0[1],C1[0]),b=MX3(C0[2],C0[3],C1[1]); a=MX3(a,C1[2],C1[3]); \
      _Pragma("unroll") for(int r=4;r<16;r+=4){a=MX3(a,C0[r],C0[r+1]);b=MX3(b,C0[r+2],C0[r+3]);a=MX3(a,C1[r],C1[r+1]);b=MX3(b,C1[r+2],C1[r+3]);} \
      float rm=__builtin_fmaxf(a,b); { auto rr=__builtin_amdgcn_permlane32_swap(__float_as_uint(rm),__float_as_uint(rm),false,false); rm=__builtin_fmaxf(__uint_as_float(rr[0]),__uint_as_float(rr[1])); } \
      resc=false; \
      if(__builtin_expect(__any(rm>(float)THRL),0)){ const float dl=__builtin_fmaxf(rm,0.f); \
        _Pragma("unroll") for(int r=0;r<16;++r){C0[r]-=dl;C1[r]-=dl;} \
        nm-=dl; \
        const float f=__builtin_amdgcn_exp2f(-dl); l_reg*=f; if(hi==0)wsf[r32]=f; resc=true; } } \
    SBAR(); \
    GAPB(o[0]=__builtin_amdgcn_mfma_f32_32x32x16_bf16(PAF(0),VFR(0),o[0],0,0,0), C0,0); \
    GAPB(o[1]=__builtin_amdgcn_mfma_f32_32x32x16_bf16(PAF(0),VFR(4),o[1],0,0,0), C0,4); \
    KRD(GL,0); GAPB(o[0]=__builtin_amdgcn_mfma_f32_32x32x16_bf16(PAF(1),VFR(1),o[0],0,0,0), C0,8); \
    KRD(GL,1); GAPB(o[1]=__builtin_amdgcn_mfma_f32_32x32x16_bf16(PAF(1),VFR(5),o[1],0,0,0), C0,12); \
    KRD(GL,2); GAPB(o[0]=__builtin_amdgcn_mfma_f32_32x32x16_bf16(PAF(2),VFR(2),o[0],0,0,0), C1,0); \
    KRD(GL,3); GAPB(o[1]=__builtin_amdgcn_mfma_f32_32x32x16_bf16(PAF(2),VFR(6),o[1],0,0,0), C1,4); \
    GAPB(o[0]=__builtin_amdgcn_mfma_f32_32x32x16_bf16(PAF(3),VFR(3),o[0],0,0,0), C1,8); \
    GAPB(o[1]=__builtin_amdgcn_mfma_f32_32x32x16_bf16(PAF(3),VFR(7),o[1],0,0,0), C1,12); \
    }while(0)
  int t=1;
  #define ENDW(tt) do{ if((tt)+3<NTe){WAIT_BAR(2);} else if((tt)+2<NTe){WAIT_BAR(1);} else {WAIT_BAR(0);} }while(0)
  for(;t<5&&t+1<NTe;t+=2){
    STEP(pB0,pB1,pA0,pA1,t,(t+3<NTe),(t+1<NTe),(t+1<NTe));       ENDW(t);   RESC(); ROT();
    STEP(pA0,pA1,pB0,pB1,t+1,(t+4<NTe),(t+2<NTe),(t+2<NTe));     ENDW(t+1); RESC(); ROT();
  }
  #undef CMASK
  #define CMASK(P0,P1,t) do{}while(0)
  for(;t+5<NTe;t+=2){
    STEP(pB0,pB1,pA0,pA1,t,true,true,true);     WAIT_BAR(2); RESC(); ROT();
    STEP(pA0,pA1,pB0,pB1,t+1,true,true,true);   WAIT_BAR(2); RESC(); ROT();
  }
  #undef CMASK
  #define CMASK(P0,P1,t) do{int jb_=JBOF(t); if(jb_>=0)cmask(P0,P1,jb_,qrel,hi);}while(0)
  for(;t+1<NTe;t+=2){
    STEP(pB0,pB1,pA0,pA1,t,(t+3<NTe),(t+1<NTe),(t+1<NTe));       ENDW(t);   RESC(); ROT();
    STEP(pA0,pA1,pB0,pB1,t+1,(t+4<NTe),(t+2<NTe),(t+2<NTe));     ENDW(t+1); RESC(); ROT();
  }
  STEP(pB0,pB1,pA0,pA1,NTe-1,false,false,false); RESC();
  { float sacc=pB0[0]+pB0[1]; _Pragma("unroll") for(int r=2;r<16;++r)sacc+=pB0[r]; _Pragma("unroll") for(int r=0;r<16;++r)sacc+=pB1[r]; l_reg+=sacc;
    pw0=(u32x4){PKW(pB0,0),PKW(pB0,2),PKW(pB0,4),PKW(pB0,6)};pw1=(u32x4){PKW(pB0,8),PKW(pB0,10),PKW(pB0,12),PKW(pB0,14)};pw2=(u32x4){PKW(pB1,0),PKW(pB1,2),PKW(pB1,4),PKW(pB1,6)};pw3=(u32x4){PKW(pB1,8),PKW(pB1,10),PKW(pB1,12),PKW(pB1,14)};
    SBAR(); pv(o,vb0+sl_cur,PAF(0),PAF(1),PAF(2),PAF(3)); }
  #undef PKW
  #undef PAF
  #undef VFR
  #undef PIN
  #undef MX3
  #undef GAPA
  #undef GAPB
  #undef EX
  #undef VRD
  #undef KRD
  #undef STEP
  #undef ENDW
  {auto rr=__builtin_amdgcn_permlane32_swap(__float_as_uint(l_reg),__float_as_uint(l_reg),false,false);l_reg=__uint_as_float(rr[0])+__uint_as_float(rr[1]);}
  if(hi==0)wsf[32+r32]=l_reg;asm volatile("s_waitcnt lgkmcnt(0)":::"memory");
  float rli[16];
  #pragma unroll
  for(int r=0;r<16;++r)rli[r]=__builtin_amdgcn_rcpf(wsf[32+crow(r,hi)]);
  bf16*Ow=O+(rowbase+q0+wid*QBLK)*OPITCH+h*D;
  { bf16*stg=(bf16*)(shm+LDS_OST)+wid*2048;
    #pragma unroll
    for(int r=0;r<16;++r){const int orow=crow(r,hi);
      #pragma unroll
      for(int d0=0;d0<2;++d0)stg[orow*64+d0*32+r32]=__float2bfloat16(o[d0][r]*rli[r]);}
    asm volatile("s_waitcnt lgkmcnt(0)":::"memory");
    #pragma unroll
    for(int i=0;i<4;++i){const int row=i*8+(lane>>3),ch=lane&7; const u32x4 v=*(const u32x4*)(stg+row*64+ch*8); ATTN_STORE16(Ow+(long)row*OPITCH+ch*8,v);} }
  asm volatile("s_waitcnt lgkmcnt(0)\n\ts_barrier":::"memory");
  #undef DMA_K
  #undef DMA_V
  #undef TIDX
  #undef JBOF
  #undef CBIAS
  #undef CMASK
  #undef START
  #undef RESC
  #undef ROT
}
constexpr int ATTN_LDS_BYTES=LDS_BYTES;
struct AttnTensors { const bf16* Q; const bf16* K; const bf16* V; bf16* O; const float* CP; const unsigned* NRM; };
struct AttnUnit { int bh; int qb; };
struct StaticOrder {
  int vcu;
  __device__ __forceinline__ explicit StaticOrder(int grid,int block):vcu((grid%8==0)?((block%8)*(grid/8)+block/8):block){}
  __device__ __forceinline__ bool next(int i,AttnUnit&u)const{ const int j=vcu+256*(i>>1); if(j>=256)return false; const int s=j&15; u.bh=j>>4; u.qb=(i&1)?s:31-s; return true; }
  __device__ __forceinline__ void a_ready(const AttnUnit&)const{}
  __device__ __forceinline__ void done(const AttnUnit&)const{}
};
struct QueueOrder {
  unsigned* head; volatile unsigned* slot;
  __device__ __forceinline__ bool next(int,AttnUnit&u)const{
    if(threadIdx.x==0)*slot=__hip_atomic_fetch_add(head,1u,__ATOMIC_RELAXED,__HIP_MEMORY_SCOPE_AGENT);
    __syncthreads(); const unsigned j=*slot; __syncthreads();
    if(j>=512u)return false; u.bh=(int)(j&15u); u.qb=31-(int)(j>>4); return true; }
  __device__ __forceinline__ void a_ready(const AttnUnit&)const{}
  __device__ __forceinline__ void done(const AttnUnit&)const{}
};
template<class Sched,int THRL=8> __device__ __forceinline__ void attn_phase(char*lds,const AttnTensors&T,const Sched&S){
  AttnUnit u;
  for(int i=0;S.next(i,u);++i){ S.a_ready(u); attn_unit<THRL>(u.bh/NHEAD,u.bh%NHEAD,u.qb,T.Q,T.K,T.V,T.O,T.CP,T.NRM,lds); S.done(u); }
}
#undef SBAR
#undef WAIT_BAR
}

constexpr int NWAVES = 8;
constexpr int BATCH = 2, T = 8192, D = 1024, M = BATCH * T;
constexpr int NH = 8, DATT = 512, DCONV = 512, CWID = 31, NE = 32, TOPK = 4, DFF = 1024, DIN = 2568, NP1 = 2560;
constexpr int COL_F = 1536, COL_A = 1544, COL_G = 2056;
constexpr int CAP = 16384;
constexpr int MAXTILES = (M * TOPK) / 256 + NE;
constexpr float LOG2E = 1.4426950408889634f;
constexpr float W8_SCALE = 64.0f, HN8_SCALE = 8.0f, ACT8_SCALE = 4.0f, Y8_SCALE = 32.0f;
constexpr int MAXU = 12;

constexpr size_t MiB = 1u << 20;
constexpr size_t WS_CTL = 0, CTL_ZERO_BYTES = 1 * MiB;
constexpr size_t WS_WIN = 2 * MiB, WS_WO = 8 * MiB, WS_LF = 10 * MiB, WS_CP = 10 * MiB + 512 * 1024, WS_RMS = 11 * MiB + 512 * 1024  , WS_TOKINFO = 11 * MiB, WS_TOKIDX = 12 * MiB, WS_GATEW = 14 * MiB;
constexpr size_t WS_XN = 16 * MiB, WS_Q = 48 * MiB, WS_K = 64 * MiB, WS_V = 80 * MiB, WS_U = 96 * MiB, WS_MIX = 112 * MiB, WS_H1 = 144 * MiB, WS_HN = 208 * MiB;
constexpr size_t WS_WGU = 240 * MiB, WS_WD = 368 * MiB, WS_ACT = 432 * MiB, WS_Y = 576 * MiB, WS_END = 720 * MiB;
static_assert(WS_V - WS_K == WS_K - WS_Q && WS_ACT + (size_t)MAXTILES * 256 * 1024 * 2 <= WS_Y && WS_Y + (size_t)MAXTILES * 256 * 1024 * 2 <= WS_END, "d_ws map");
constexpr int CW_TMO = 0, CW_CODE = 1, CW_CNT = 64  , CW_BAR = 4096;
static_assert(CW_CNT + 64 * NE <= CW_BAR, "CTL words");
constexpr int CW_NRM = 16384  , CW_QHEAD = 24576  ;
static_assert((CW_QHEAD + 64) * 4 <= (int)CTL_ZERO_BYTES, "CTL words inside the memset region");

constexpr int RING_OFF = 0, RING_BYTES = 131072;
constexpr int LDSCTL_OFF = RING_BYTES, MISC_OFF = LDSCTL_OFF;
constexpr int META_OFF = LDSCTL_OFF + 512;
constexpr int TOKL_OFF = LDSCTL_OFF + 2048;
constexpr int EPIL_OFF = TOKL_OFF + MAXU * 1024, EPIL_BYTES = 12288;
constexpr int LDS_BYTES = 163840;
static_assert(EPIL_OFF + EPIL_BYTES <= LDS_BYTES && 9 * 256 * 4 <= EPIL_BYTES && 6 * 512 * 4 <= EPIL_BYTES, "LDS map");

#define GAS __attribute__((address_space(1)))
#define LAS __attribute__((address_space(3)))
typedef unsigned short bf16;
typedef unsigned v4u __attribute__((ext_vector_type(4)));
typedef unsigned v2u __attribute__((ext_vector_type(2)));
typedef float f32x4 __attribute__((ext_vector_type(4)));
typedef GAS unsigned gu32;
#define RLX_AGENT __ATOMIC_RELAXED, __HIP_MEMORY_SCOPE_AGENT
#define LDS_WAIT() asm volatile("s_waitcnt lgkmcnt(0)" ::: "memory")
#define VM_WAIT() asm volatile("s_waitcnt vmcnt(0)" ::: "memory")
__device__ __forceinline__ unsigned f2bf(float f) { unsigned u = __builtin_bit_cast(unsigned, f); return (u + 0x7fffu + ((u >> 16) & 1u)) >> 16; }
__device__ __forceinline__ unsigned pk2(float lo, float hi) { return f2bf(lo) | (f2bf(hi) << 16); }
__device__ __forceinline__ float bf2f(unsigned short h) { return __builtin_bit_cast(float, (unsigned)h << 16); }
#define XB_TMO      128
#define XB_XCNT(j)  (256  + 64 * (j))
#define XB_XSUB(j)  (1280 + 64 * (j))
#define XB_XGEN(j)  (2304 + 64 * (j))
#define XB_TOP      3328
#define XB_TOPGEN   3392
#define XCD_BAR_WORDS 3456
#define XB_SPIN_CAP (1u << 18)

__device__ __forceinline__ unsigned xb_ld(unsigned* p)              { return __hip_atomic_load(p, __ATOMIC_RELAXED, __HIP_MEMORY_SCOPE_AGENT); }
__device__ __forceinline__ unsigned xb_add(unsigned* p, unsigned v) { return __hip_atomic_fetch_add(p, v, __ATOMIC_RELAXED, __HIP_MEMORY_SCOPE_AGENT); }
__device__ __forceinline__ unsigned xb_xcc_id() { return (unsigned)__builtin_amdgcn_s_getreg((3 << 11) | 20) & 0xFu; }
#define XB_SPIN(cond, bar) do { unsigned _sp = 0; while (cond) { __builtin_amdgcn_s_sleep(1); \
    if ((++_sp & 255u) == 0u) { if (xb_ld(&(bar)[XB_TMO])) break; if (_sp > XB_SPIN_CAP) { atomicAdd(&(bar)[XB_TMO], 1u); break; } } } } while (0)

struct XcdBarrier {
    unsigned* bar; unsigned x;
    volatile LAS unsigned* st;
};

__device__ __forceinline__ XcdBarrier xcd_barrier_post(unsigned* bar, volatile LAS unsigned* st) {
    XcdBarrier b; b.bar = bar; b.x = xb_xcc_id(); b.st = st;
    if (threadIdx.x == 0) (void)xb_add(&bar[XB_XCNT(b.x)], 1u);
    return b;
}
__device__ __forceinline__ void xcd_barrier_complete(unsigned* bar, unsigned x, unsigned& nloc, unsigned& nx) {
    const unsigned G = gridDim.x * gridDim.y * gridDim.z;
    unsigned sum, cnt, mine, sp = 0u;
    for (;;) {
        sum = 0u; cnt = 0u; mine = 0u;
#pragma unroll
        for (unsigned j = 0; j < 16; ++j) { const unsigned c = xb_ld(&bar[XB_XCNT(j)]); sum += c; cnt += (c > 0u) ? 1u : 0u; mine = (j == x) ? c : mine; }
        if (sum == G) break;
        __builtin_amdgcn_s_sleep(1);
        if ((++sp & 255u) == 0u) { if (xb_ld(&bar[XB_TMO])) break; if (sp > XB_SPIN_CAP) { atomicAdd(&bar[XB_TMO], 1u); break; } }
    }
    nloc = mine > 0u ? mine : 1u; nx = cnt > 0u ? cnt : 1u;
}

__device__ __forceinline__ void xcd_barrier(const XcdBarrier& b) {
    asm volatile("s_waitcnt vmcnt(0)" ::: "memory");
    __syncthreads();
    if (threadIdx.x == 0) {
        unsigned* bar = b.bar;
        __builtin_amdgcn_s_waitcnt(0);
        unsigned nloc = b.st[0], nx = b.st[1];
        if (nloc == 0u) { xcd_barrier_complete(bar, b.x, nloc, nx); b.st[0] = nloc; b.st[1] = nx; }
        const unsigned old = xb_add(&bar[XB_XSUB(b.x)], 1u);
        const unsigned gen = old / nloc;
        if (old + 1u == (gen + 1u) * nloc) {
            __builtin_amdgcn_fence(__ATOMIC_RELEASE, "agent");
            asm volatile("s_waitcnt vmcnt(0)" ::: "memory");
            const unsigned og = xb_add(&bar[XB_TOP], 1u);
            const unsigned tg = og / nx;
            if (og + 1u == (tg + 1u) * nx) xb_add(&bar[XB_TOPGEN], 1u);
            else XB_SPIN(xb_ld(&bar[XB_TOPGEN]) == tg, bar);
            __builtin_amdgcn_fence(__ATOMIC_ACQUIRE, "agent");
            xb_add(&bar[XB_XGEN(b.x)], 1u);
            asm volatile("s_waitcnt vmcnt(0)" ::: "memory");
        } else {
            XB_SPIN(xb_ld(&bar[XB_XGEN(b.x)]) == gen, bar);
            __builtin_amdgcn_fence(__ATOMIC_ACQUIRE, "agent");
            asm volatile("s_waitcnt vmcnt(0)" ::: "memory");
        }
    }
    __syncthreads();
}

struct Args {
    const float *x, *norm_mix_g, *w_in, *b_f, *b_glu, *w_dw, *b_dw, *ln_g, *ln_b, *w_out, *norm_ffn_g, *w_router, *b_router, *w_gu, *b_gu, *w_down, *b_down, *norm_final_g;
    float* out; unsigned char* ws; int ph_lo, ph_hi, li, pad;
};
struct Frame {
    LAS unsigned char* lds;
    volatile LAS unsigned* MISC;
    gu32* ctl;
    int tid, lane, wave, vcu, G;
};
__device__ __forceinline__ float wave_sum(float v) {
#pragma unroll
    for (int o = 1; o < 64; o <<= 1) v += __shfl_xor(v, o);
    return v;
}

__device__ __forceinline__ void p0_transpose_item(const float* W, int K, int N, int k0, int sc0, bf16* WTrow0, LAS float* scr, int lane) {
#pragma unroll 8
    for (int i = 0; i < 32; ++i) { const int kk = 2 * i + (lane >> 5); scr[kk * 33 + (lane & 31)] = __builtin_nontemporal_load(W + (size_t)(k0 + kk) * N + sc0 + (lane & 31)); }
    LDS_WAIT(); asm volatile("" ::: "memory");
    const int c = lane & 7;
#pragma unroll
    for (int j = 0; j < 4; ++j) { const int n = (lane >> 3) + 8 * j; const LAS float* s = scr + (8 * c) * 33 + n;
        v4u o; o.x = pk2(s[0 * 33], s[1 * 33]); o.y = pk2(s[2 * 33], s[3 * 33]); o.z = pk2(s[4 * 33], s[5 * 33]); o.w = pk2(s[6 * 33], s[7 * 33]);
        *(GAS v4u*)(WTrow0 + (size_t)n * K + k0 + 8 * c) = o; }
    LDS_WAIT(); asm volatile("" ::: "memory");
}
__device__ __forceinline__ void p0_transpose_item_f8(const float* W, int K, int N, int k0, int sc0, unsigned char* WTrow0, int lane, float sc) {
    const int kr = lane >> 3, c4 = lane & 7;
    const GAS f32x4* src = (const GAS f32x4*)(W + (size_t)(k0 + 16 * kr) * N + sc0 + 4 * c4);
    f32x4 v[16];
#pragma unroll
    for (int i = 0; i < 16; ++i) v[i] = __builtin_nontemporal_load(src + (size_t)i * (N / 4));
    __builtin_amdgcn_sched_barrier(0);
#pragma unroll
    for (int c = 0; c < 4; ++c) { v4u o;
        o.x = pg8::pk4_fp8(v[0][c] * sc, v[1][c] * sc, v[2][c] * sc, v[3][c] * sc); o.y = pg8::pk4_fp8(v[4][c] * sc, v[5][c] * sc, v[6][c] * sc, v[7][c] * sc);
        o.z = pg8::pk4_fp8(v[8][c] * sc, v[9][c] * sc, v[10][c] * sc, v[11][c] * sc); o.w = pg8::pk4_fp8(v[12][c] * sc, v[13][c] * sc, v[14][c] * sc, v[15][c] * sc);
        *(GAS v4u*)(WTrow0 + (size_t)(4 * c4 + c) * K + k0 + 16 * kr) = o; }
}
constexpr int P0_KB = D / 64, P0_KB8 = D / 128;
constexpr int P0_I_IN = P0_KB * (NP1 / 32), P0_I_O = P0_KB * (D / 32), P0_I_GU = NE * P0_KB8 * (2 * DFF / 32), P0_I_DN = NE * P0_KB8 * (D / 32);
constexpr int P0_NITEMS = P0_I_IN + P0_I_O + P0_I_GU + P0_I_DN;
__device__ __forceinline__ void p0_items(Frame& F, const Args& a, int first, int last, int gw, int NGW) {
    unsigned char* ws = a.ws;
    LAS float* scr = (LAS float*)(F.lds + RING_OFF + F.wave * 16384);
    bf16* Win_t = (bf16*)(ws + WS_WIN); bf16* Wo_t = (bf16*)(ws + WS_WO); unsigned char* Wgu_t = ws + WS_WGU; unsigned char* Wd_t = ws + WS_WD;
    constexpr int KB = P0_KB, I_IN = P0_I_IN, I_O = P0_I_O, I_GU = P0_I_GU;
    for (int it = first + gw; it < last; it += NGW) {
        int r = it;
        if (r < I_IN) { const int nb = r % (NP1 / 32), kb = r / (NP1 / 32), n0 = nb * 32; int sc;
            if (n0 < 1536) sc = n0; else { const int j = (n0 - 1536) >> 8, i = (n0 - 1536) & 255; sc = (i < 128) ? (COL_A + 128 * j + i) : (COL_G + 128 * j + (i - 128)); }
            p0_transpose_item(a.w_in, D, DIN, kb * 64, sc, Win_t + (size_t)n0 * D, scr, F.lane); continue; }
        r -= I_IN;
        if (r < I_O) { const int nb = r % (D / 32), kb = r / (D / 32); p0_transpose_item(a.w_out, D, D, kb * 64, nb * 32, Wo_t + (size_t)nb * 32 * D, scr, F.lane); continue; }
        r -= I_O;
        if (r < I_GU) { const int per = P0_KB8 * (2 * DFF / 32), e = r / per, q = r % per, nb = q % (2 * DFF / 32), kb = q / (2 * DFF / 32), n0 = nb * 32;
            const int pl = n0 >> 8, i = n0 & 255, sc = (i < 128) ? (128 * pl + i) : (DFF + 128 * pl + (i - 128));
            p0_transpose_item_f8(a.w_gu + (size_t)e * D * 2 * DFF, D, 2 * DFF, kb * 128, sc, Wgu_t + ((size_t)e * 2 * DFF + n0) * D, F.lane, W8_SCALE); continue; }
        r -= I_GU;
        { const int per = P0_KB8 * (D / 32), e = r / per, q = r % per, nb = q % (D / 32), kb = q / (D / 32);
            p0_transpose_item_f8(a.w_down + (size_t)e * DFF * D, DFF, D, kb * 128, nb * 32, Wd_t + ((size_t)e * D + nb * 32) * DFF, F.lane, W8_SCALE); }
    }
}
__device__ __forceinline__ void p0_prologue(Frame& F, const Args& a) {
    unsigned char* ws = a.ws;
    const int gw = F.vcu * NWAVES + F.wave, NGW = F.G * NWAVES;
    p0_items(F, a, 0, P0_I_IN + P0_I_O, gw, NGW);
    __syncthreads();
    LAS float* wf = (LAS float*)(F.lds + RING_OFF);
    for (int i = F.tid; i < D * NH; i += NWAVES * 64) { const int k = i >> 3, h = i & 7; wf[h * D + k] = a.w_in[(size_t)k * DIN + COL_F + h]; }
    __syncthreads();
    bf16* XN = (bf16*)(ws + WS_XN); float* LF = (float*)(ws + WS_LF);
    f32x4 gv[4];
#pragma unroll
    for (int j = 0; j < 4; ++j) gv[j] = ((const GAS f32x4*)a.norm_mix_g)[F.lane + 64 * j];
    for (int m = gw; m < M; m += NGW) {
        const GAS f32x4* xr = (const GAS f32x4*)(a.x + (size_t)m * D) + F.lane;
        f32x4 v[4]; float s = 0.f;
#pragma unroll
        for (int j = 0; j < 4; ++j) { v[j] = xr[64 * j]; s += (v[j].x * v[j].x + v[j].y * v[j].y) + (v[j].z * v[j].z + v[j].w * v[j].w); }
        const float ms = wave_sum(s) * (1.f / D) + 1e-6f, rs = 1.0f / sqrtf(ms);
        if (F.lane == 0) ((float*)(ws + WS_RMS))[m] = sqrtf(ms);
#pragma unroll
        for (int j = 0; j < 4; ++j) v[j] = v[j] * rs * gv[j];
        GAS unsigned long long* o8 = (GAS unsigned long long*)(XN + (size_t)m * D) + F.lane;
#pragma unroll
        for (int j = 0; j < 4; ++j) o8[64 * j] = (unsigned long long)pk2(v[j].x, v[j].y) | ((unsigned long long)pk2(v[j].z, v[j].w) << 32);
        float fl[NH];
#pragma unroll
        for (int h = 0; h < NH; ++h) { float acc = 0.f;
#pragma unroll
            for (int j = 0; j < 4; ++j) { const f32x4 w = *(const LAS f32x4*)(wf + h * D + 4 * F.lane + 256 * j); acc += (v[j].x * w.x + v[j].y * w.y) + (v[j].z * w.z + v[j].w * w.w); }
            fl[h] = wave_sum(acc); }
        if (F.lane < NH) { float z = fl[0];
#pragma unroll
            for (int h = 1; h < NH; ++h) z = (F.lane == h) ? fl[h] : z;
            z += a.b_f[F.lane];
            const float ls = fminf(z, 0.f) - log1pf(expf(-fabsf(z)));
            const int b = m / T, t = m % T;
            LF[(size_t)(b * NH + F.lane) * T + t] = ls; }
    }
}
__device__ __forceinline__ void scan_bh(Frame& F, const float* LF, float* CP, int bh) {
    LAS double* wtot = (LAS double*)(F.lds + RING_OFF);
    const GAS f32x4* src = (const GAS f32x4*)(LF + (size_t)bh * T) + F.tid * 4;
    f32x4 v[4];
#pragma unroll
    for (int j = 0; j < 4; ++j) v[j] = src[j];
    double pre[16]; double run = 0.0;
#pragma unroll
    for (int j = 0; j < 4; ++j)
#pragma unroll
        for (int c = 0; c < 4; ++c) { run += (double)v[j][c]; pre[j * 4 + c] = run; }
    double inc = run;
#pragma unroll
    for (int o = 1; o < 64; o <<= 1) { const double up = __shfl_up(inc, o); if (F.lane >= o) inc += up; }
    if (F.lane == 63) wtot[F.wave] = inc;
    __syncthreads();
    double base = inc - run;
    for (int w = 0; w < F.wave; ++w) base += wtot[w];
    GAS f32x4* dst = (GAS f32x4*)(CP + (size_t)bh * T) + F.tid * 4;
#pragma unroll
    for (int j = 0; j < 4; ++j) { f32x4 o;
#pragma unroll
        for (int c = 0; c < 4; ++c) o[c] = (float)((base + pre[j * 4 + c]) * (double)LOG2E);
        dst[j] = o; }
    __syncthreads();
}

__device__ __forceinline__ void conv_phase(Frame& F, const Args& a, int blk, int grp0, int grp1) {
    const bf16* U = (const bf16*)(a.ws + WS_U); bf16* MIX = (bf16*)(a.ws + WS_MIX);
    LAS float* yl = (LAS float*)(F.lds + RING_OFF);
    LAS float* st = (LAS float*)(F.lds + RING_OFF + 65536);
    int ch = threadIdx.x; asm volatile("" : "+v"(ch));
    const int clane = ch & 63, cwave = __builtin_amdgcn_readfirstlane(ch >> 6);
    float w[CWID];
#pragma unroll
    for (int j = 0; j < CWID; ++j) w[j] = a.w_dw[j * DCONV + ch];
    const float bdw = a.b_dw[ch], lg = a.ln_g[ch], lb = a.ln_b[ch];
    for (int grp = grp0; grp < grp1; ++grp) {
        const int n0 = blk * 64 + grp * 32, t0 = n0 % T;
        unsigned short raw[CWID - 1 + 32];
#pragma unroll
        for (int i = 0; i < CWID - 1 + 32; ++i) { const int ts = t0 - (CWID - 1) + i; const int rowc = (ts >= 0) ? (n0 - (CWID - 1) + i) : n0;
            raw[i] = U[(size_t)rowc * DCONV + ch]; }
        __builtin_amdgcn_sched_barrier(0);
        float uin[CWID - 1 + 32];
#pragma unroll
        for (int i = 0; i < CWID - 1 + 32; ++i) { const int ts = t0 - (CWID - 1) + i; uin[i] = (ts >= 0) ? bf2f(raw[i]) : 0.f; }
        float y[32];
#pragma unroll
        for (int o = 0; o < 32; ++o) { float acc = bdw;
#pragma unroll
            for (int j = 0; j < CWID; ++j) acc = fmaf(w[j], uin[o + j], acc);
            y[o] = acc; yl[o * DCONV + ch] = acc; }
        __syncthreads();
#pragma unroll
        for (int q = 0; q < 4; ++q) { const int o = cwave * 4 + q;
            const f32x4 p0 = *(const LAS f32x4*)(yl + o * DCONV + 4 * clane), p1 = *(const LAS f32x4*)(yl + o * DCONV + 256 + 4 * clane);
            const float mu = wave_sum((p0.x + p0.y) + (p0.z + p0.w) + (p1.x + p1.y) + (p1.z + p1.w)) * (1.f / DCONV);
            const f32x4 d0 = p0 - mu, d1 = p1 - mu;
            const float var = wave_sum((d0.x * d0.x + d0.y * d0.y) + (d0.z * d0.z + d0.w * d0.w) + (d1.x * d1.x + d1.y * d1.y) + (d1.z * d1.z + d1.w * d1.w)) * (1.f / DCONV);
            if (clane == 0) { st[2 * o] = mu; st[2 * o + 1] = 1.0f / sqrtf(var + 1e-5f); } }
        __syncthreads();
#pragma unroll
        for (int o = 0; o < 32; ++o) { const float z = (y[o] - st[2 * o]) * st[2 * o + 1] * lg + lb; const float sw = z * pg8::sigmoid_f(z);
            MIX[(size_t)(n0 + o) * D + DATT + ch] = (bf16)f2bf(sw); }
        __syncthreads();
    }
}

#define RT_SWZ(col) ((((col) & 7) ^ ((((col) >> 3) & 1) << 2)))
__device__ __forceinline__ void router_table(Frame& F, const Args& a) {
    LAS unsigned char* tbl = F.lds + RING_OFF;
    { f32x4 wv[16]; float gg[16];
#pragma unroll
      for (int i = 0; i < 16; ++i) { const int f = F.tid + 512 * i; wv[i] = ((const GAS f32x4*)a.w_router)[f]; gg[i] = a.norm_ffn_g[f >> 3]; }
      __builtin_amdgcn_sched_barrier(0);
#pragma unroll
      for (int i = 0; i < 16; ++i) { const int f = F.tid + 512 * i, col = f >> 3, e4 = f & 7; *(LAS f32x4*)(tbl + col * 128 + ((e4 ^ RT_SWZ(col)) << 4)) = wv[i] * gg[i]; } }
}
__device__ __forceinline__ void router_phase(Frame& F, const Args& a, int blk, size_t dry  ) {
    const bf16* H1 = (const bf16*)(a.ws + WS_H1); unsigned char* HN = a.ws + WS_HN + dry;
    int* tokinfo = (int*)(a.ws + WS_TOKINFO + dry); int* tokidx = (int*)(a.ws + WS_TOKIDX + dry); float* gatew = (float*)(a.ws + WS_GATEW + dry);
    int* gcnt = (int*)(F.ctl + CW_CNT) + (dry ? 32 : 0);
    LAS unsigned char* tbl = F.lds + RING_OFF;
    LAS int* lcnt = (LAS int*)(F.lds + META_OFF) + 32 + 32 + 33 + 33 + 33;
    LAS int* lbase = lcnt + 32;
    LAS float* part = (LAS float*)(F.lds + TOKL_OFF);
    LAS float* ssp = part + 4 * 8 * 64;
    LAS float* rsl = ssp + 64;
    if (F.tid < 32) lcnt[F.tid] = 0;
    __syncthreads();
    const int rg = F.wave & 3, kh = F.wave >> 2, r16 = F.lane & 15, kq = F.lane >> 4;
    f32x4 c0 = {0.f, 0.f, 0.f, 0.f}, c1 = {0.f, 0.f, 0.f, 0.f}; float ss = 0.f;
    {
        const bf16* hp = H1 + (size_t)(blk * 64 + rg * 16 + r16) * D + kh * 512 + kq * 8;
        const int e4a = r16 >> 2, e4b = 4 + (r16 >> 2), wi = (r16 & 3) * 4;
        v4u avv[16];
#pragma unroll
        for (int j = 0; j < 16; ++j) avv[j] = *(const v4u*)(hp + 32 * j);
        __builtin_amdgcn_sched_barrier(0);
#pragma unroll
        for (int j = 0; j < 16; ++j) {
#pragma unroll
            for (int c = 0; c < 8; ++c) { const unsigned wv = avv[j][c >> 1]; const float av = __builtin_bit_cast(float, (c & 1) ? (wv & 0xffff0000u) : (wv << 16));
                ss += av * av;
                const int k = kh * 512 + 32 * j + 8 * kq + c; const LAS unsigned char* rp = tbl + k * 128 + wi; const int sw = RT_SWZ(k);
                const float b0 = *(const LAS float*)(rp + ((e4a ^ sw) << 4)), b1 = *(const LAS float*)(rp + ((e4b ^ sw) << 4));
                c0 = __builtin_amdgcn_mfma_f32_16x16x4f32(av, b0, c0, 0, 0, 0); c1 = __builtin_amdgcn_mfma_f32_16x16x4f32(av, b1, c1, 0, 0, 0); } }
    }
    ss += __shfl_xor(ss, 16); ss += __shfl_xor(ss, 32);
    if (kh == 1) {
#pragma unroll
        for (int i = 0; i < 4; ++i) { part[(rg * 8 + i) * 64 + F.lane] = c0[i]; part[(rg * 8 + 4 + i) * 64 + F.lane] = c1[i]; }
        if (F.lane < 16) ssp[rg * 16 + F.lane] = ss;
    }
    __syncthreads();
    int pe = 0, plr = 0; float pw = 0.f;
    if (kh == 0) {
#pragma unroll
        for (int i = 0; i < 4; ++i) { c0[i] += part[(rg * 8 + i) * 64 + F.lane]; c1[i] += part[(rg * 8 + 4 + i) * 64 + F.lane]; }
        if (F.lane < 16) rsl[rg * 16 + F.lane] = 1.0f / sqrtf((ss + ssp[rg * 16 + F.lane]) * (1.f / D) + 1e-6f);
        LDS_WAIT(); asm volatile("" ::: "memory");
        const float ba = a.b_router[r16], bb = a.b_router[16 + r16];
#pragma unroll
        for (int i = 0; i < 4; ++i) {
            const float rs = rsl[rg * 16 + 4 * kq + i];
            float za = c0[i] * rs + ba, zb = c1[i] * rs + bb;
            int idx[TOPK]; float val[TOPK];
#pragma unroll
            for (int k = 0; k < TOPK; ++k) { float bv = za; int bi = r16; if (zb > za) { bv = zb; bi = 16 + r16; }
#pragma unroll
                for (int o = 8; o > 0; o >>= 1) { const float ov = __shfl_xor(bv, o); const int oi = __shfl_xor(bi, o); if (ov > bv || (ov == bv && oi < bi)) { bv = ov; bi = oi; } }
                idx[k] = bi; val[k] = bv; if (bi == r16) za = -INFINITY; if (bi == 16 + r16) zb = -INFINITY; }
            float ex[TOPK], den = 0.f;
#pragma unroll
            for (int k = 0; k < TOPK; ++k) { ex[k] = __expf(val[k] - val[0]); den += ex[k]; }
            const float inv = 1.0f / den;
#pragma unroll
            for (int k = 0; k < TOPK; ++k) if (r16 == 4 * i + k) { pe = idx[k]; pw = ex[k] * inv; }
        }
        plr = __hip_atomic_fetch_add(&lcnt[pe], 1, __ATOMIC_RELAXED, __HIP_MEMORY_SCOPE_WORKGROUP);
    }
    __syncthreads();
    if (F.tid < 32) lbase[F.tid] = (int)__hip_atomic_fetch_add(gcnt + 64 * F.tid, lcnt[F.tid], RLX_AGENT);
    __syncthreads();
    if (kh == 0) { const int rank = lbase[pe] + plr, row = blk * 64 + rg * 16 + (F.lane >> 2), k = F.lane & 3;
        tokinfo[row * TOPK + k] = pe * CAP + rank; tokidx[pe * CAP + rank] = row; gatew[pe * CAP + rank] = pw; }
    f32x4 gv[4];
#pragma unroll
    for (int j = 0; j < 4; ++j) gv[j] = ((const GAS f32x4*)a.norm_ffn_g)[F.lane + 64 * j];
    for (int rb = 0; rb < 2; ++rb) { f32x4 hv[4][4];
#pragma unroll
        for (int rr = 0; rr < 4; ++rr) { const GAS v2u* hr = (const GAS v2u*)(H1 + (size_t)(blk * 64 + F.wave * 8 + rb * 4 + rr) * D) + F.lane;
#pragma unroll
            for (int j = 0; j < 4; ++j) { const v2u p = hr[64 * j]; hv[rr][j] = (f32x4){__builtin_bit_cast(float, p.x << 16), __builtin_bit_cast(float, p.x & 0xffff0000u), __builtin_bit_cast(float, p.y << 16), __builtin_bit_cast(float, p.y & 0xffff0000u)}; } }
        __builtin_amdgcn_sched_barrier(0);
#pragma unroll
        for (int rr = 0; rr < 4; ++rr) { const int lr = F.wave * 8 + rb * 4 + rr, row = blk * 64 + lr; const float rs = rsl[lr];
            GAS unsigned* o4 = (GAS unsigned*)(HN + (size_t)row * D) + F.lane;
#pragma unroll
            for (int j = 0; j < 4; ++j) { const f32x4 v = hv[rr][j] * (rs * HN8_SCALE) * gv[j]; o4[64 * j] = pg8::pk4_fp8(v.x, v.y, v.z, v.w); } } }
    __syncthreads();
}
__device__ __forceinline__ void moe_meta(Frame& F) {
    LAS int* meta = (LAS int*)(F.lds + META_OFF);
    if (F.tid < 32) { const int c = (int)__hip_atomic_load((int*)(F.ctl + CW_CNT) + 64 * F.tid, RLX_AGENT); meta[F.tid] = c; meta[32 + F.tid] = (c + 255) >> 8; }
    __syncthreads();
    if (F.tid == 0) { int o = 0; for (int e = 0; e < 32; ++e) { meta[64 + e] = o; meta[97 + e] = o * 8; meta[130 + e] = o * 4; o += meta[32 + e]; } meta[64 + 32] = o; meta[97 + 32] = o * 8; meta[130 + 32] = o * 4; }
    __syncthreads();
}

__device__ __forceinline__ void final_phase(Frame& F, const Args& a, int blk) {
    const bf16* H1 = (const bf16*)(a.ws + WS_H1); const unsigned char* Y = a.ws + WS_Y; const int* tokinfo = (const int*)(a.ws + WS_TOKINFO);
    const LAS int* tileoff = (const LAS int*)(F.lds + META_OFF) + 64;
    f32x4 gv[4];
#pragma unroll
    for (int j = 0; j < 4; ++j) gv[j] = ((const GAS f32x4*)a.norm_final_g)[F.lane + 64 * j];
    for (int rr = 0; rr < 8; ++rr) {
        const int row = blk * 64 + F.wave * 8 + rr;
        const GAS v2u* hr = (const GAS v2u*)(H1 + (size_t)row * D) + F.lane;
        f32x4 v[4];
#pragma unroll
        for (int j = 0; j < 4; ++j) { const v2u p = __builtin_nontemporal_load(hr + 64 * j); v[j] = (f32x4){__builtin_bit_cast(float, p.x << 16), __builtin_bit_cast(float, p.x & 0xffff0000u), __builtin_bit_cast(float, p.y << 16), __builtin_bit_cast(float, p.y & 0xffff0000u)}; }
#pragma unroll
        for (int k = 0; k < TOPK; ++k) { const int info = tokinfo[row * TOPK + k], e = info >> 14, rank = info & (CAP - 1);
            const GAS unsigned* yr = (const GAS unsigned*)(Y + ((size_t)tileoff[e] * 256 + rank) * D) + F.lane;
#pragma unroll
            for (int j = 0; j < 4; ++j) { const unsigned p = __builtin_nontemporal_load(yr + 64 * j);
                const auto lo2 = __builtin_amdgcn_cvt_pk_f32_fp8((int)p, false), hi2 = __builtin_amdgcn_cvt_pk_f32_fp8((int)p, true);
                v[j].x += lo2[0] * (1.0f / Y8_SCALE); v[j].y += lo2[1] * (1.0f / Y8_SCALE); v[j].z += hi2[0] * (1.0f / Y8_SCALE); v[j].w += hi2[1] * (1.0f / Y8_SCALE); } }
        float s = 0.f;
#pragma unroll
        for (int j = 0; j < 4; ++j) s += (v[j].x * v[j].x + v[j].y * v[j].y) + (v[j].z * v[j].z + v[j].w * v[j].w);
        const float rs = 1.0f / sqrtf(wave_sum(s) * (1.f / D) + 1e-6f);
        GAS f32x4* orow = (GAS f32x4*)(a.out + (size_t)row * D) + F.lane;
#pragma unroll
        for (int j = 0; j < 4; ++j) __builtin_nontemporal_store(v[j] * rs * gv[j], orow + 64 * j);
    }
}

constexpr int NPHASE = 8;
__global__ void __launch_bounds__(NWAVES * 64, 2) mega_fwd(Args args) {
    extern __shared__ __attribute__((aligned(16))) unsigned char lds[];
    Frame F;
    F.lds = (LAS unsigned char*)lds;
    F.MISC = (volatile LAS unsigned*)(F.lds + MISC_OFF);
    F.tid = threadIdx.x; F.lane = F.tid & 63; F.wave = __builtin_amdgcn_readfirstlane(F.tid >> 6);
    F.G = gridDim.x; { const int bx = blockIdx.x; F.vcu = (F.G % 8 == 0) ? (bx % 8) * (F.G / 8) + bx / 8 : bx; }
    unsigned char* ws = args.ws;
    F.ctl = (gu32*)(ws + WS_CTL);
    for (int u = F.tid; u < 512 / 4; u += NWAVES * 64) ((LAS unsigned*)(F.lds + LDSCTL_OFF))[u] = 0u;
    __syncthreads();
    const int lo = args.ph_lo, hi = args.ph_hi;
    XcdBarrier bar; bar.bar = (unsigned*)(F.ctl + CW_BAR); bar.x = 0; bar.st = nullptr;
    if (hi - lo > 1) bar = xcd_barrier_post((unsigned*)(F.ctl + CW_BAR) + args.li * XCD_BAR_WORDS, F.MISC + 8);
#ifdef MK_ONLY
#define IN(k) ((k) == MK_ONLY && lo <= (k) && (k) < hi)
#else
#define IN(k) (lo <= (k) && (k) < hi)
#endif
#define BOTH(k) (IN(k) && IN((k) + 1))
#define GRID_BAR() xcd_barrier(bar)
#define REFRESH() do { int t_ = threadIdx.x; asm volatile("" : "+v"(t_)); F.tid = t_; F.lane = t_ & 63; F.wave = __builtin_amdgcn_readfirstlane(t_ >> 6); } while (0)
    const int blk = blockIdx.x;

    if (IN(0)) {
        REFRESH();
        p0_prologue(F, args);
        if (BOTH(0)) GRID_BAR();
    }

    if (IN(1)) {
        REFRESH();
#ifndef NO_SCAN
        if (blk >= F.G - 16) scan_bh(F, (const float*)(ws + WS_LF), (float*)(ws + WS_CP), blk - (F.G - 16));
#endif
        pg8::Gemm g{ws + WS_XN, ws + WS_WIN, M, NP1, D, 2 * D}; pg8::StaticOrder S; S.init(M, NP1, F.G, blk);
        LAS float* epil = (LAS float*)(F.lds + EPIL_OFF);
        for (int i = F.tid; i < 2 * DCONV; i += NWAVES * 64) epil[i] = args.b_glu[i];
        __syncthreads();
        pg8::EpiProj E{(bf16*)(ws + WS_Q), (bf16*)(ws + WS_U), (size_t)(WS_K - WS_Q) / 2, epil, 0.125f * LOG2E, (unsigned*)(F.ctl + CW_NRM)};
        pg8::gemm_phase<pg8::EpiProj, pg8::StaticOrder, true, false, false>(F.lds + RING_OFF, g, S, E, nullptr);
        if (BOTH(1)) GRID_BAR();
#ifdef MK_XBAR
        if (BOTH(1)) { GRID_BAR(); GRID_BAR(); GRID_BAR(); GRID_BAR(); }
#endif
    }

    if (IN(2)) {
        REFRESH();
        const attn_body::AttnTensors AT{(const attn_body::bf16*)(ws + WS_Q), (const attn_body::bf16*)(ws + WS_K), (const attn_body::bf16*)(ws + WS_V), (attn_body::bf16*)(ws + WS_MIX), (const float*)(ws + WS_CP), (const unsigned*)(F.ctl + CW_NRM)};
        volatile unsigned* slot = (volatile unsigned*)(lds + MISC_OFF + 64);
        { constexpr int c = MK_NCONV / 8; const int r = blk >> 3, sel = ((r + 1) * c) / 32 - (r * c) / 32;
          if (sel) { const int cidx = ((r * c) / 32) * 8 + (blk & 7); p0_items(F, args, P0_I_IN + P0_I_O, P0_NITEMS, cidx * NWAVES + F.wave, MK_NCONV * NWAVES); } }
        for (;;) {
            if (threadIdx.x == 0) *slot = __hip_atomic_fetch_add((unsigned*)(F.ctl + CW_QHEAD), 1u, __ATOMIC_RELAXED, __HIP_MEMORY_SCOPE_AGENT);
            __syncthreads(); const unsigned j = __builtin_amdgcn_readfirstlane(*slot); __syncthreads();
            if (j >= 512u + (unsigned)(M / 32)) break;
            if (j < 512u) { const int bh = (int)(j & 15u), qb = 31 - (int)(j >> 4); attn_body::attn_unit<8>(bh / NH, bh % NH, qb, AT.Q, AT.K, AT.V, AT.O, AT.CP, AT.NRM, (char*)lds + RING_OFF); }
            else { const int cj = (int)(j - 512u); conv_phase(F, args, cj >> 1, cj & 1, (cj & 1) + 1); }
        }
        if (BOTH(2)) GRID_BAR();
    }

    if (IN(3)) {
        REFRESH();
        pg8::Gemm g{ws + WS_MIX, ws + WS_WO, M, D, D, 2 * D}; pg8::StaticOrder S; S.init(M, D, F.G, blk);
        pg8::EpiH1 E{(const bf16*)(ws + WS_XN), (const float*)(ws + WS_RMS), args.norm_mix_g, (bf16*)(ws + WS_H1)};
        pg8::gemm_phase<pg8::EpiH1, pg8::StaticOrder, true, false, false>(F.lds + RING_OFF, g, S, E, nullptr);
        if (IN(4)) router_table(F, args);
        if (BOTH(3)) GRID_BAR();
    }

    if (IN(4)) {
        REFRESH();
        if (!IN(3)) router_table(F, args);
        router_phase(F, args, blk, 0);
        if (BOTH(4)) GRID_BAR();
    }

    if (IN(5)) {
        REFRESH();
        moe_meta(F);
        const LAS int* meta = (const LAS int*)(F.lds + META_OFF);
        LAS int* tokl = (LAS int*)(F.lds + TOKL_OFF);
        pg8::MoeOrder S{meta[97 + 32], F.G, blk, 8, meta + 97, meta + 32, meta + 64};
        { pg8::Unit u; const int* tokidx = (const int*)(ws + WS_TOKIDX);
          LAS float* epil = (LAS float*)(F.lds + EPIL_OFF);
          for (int ui = 0; ui < MAXU && S.next(ui, u); ++ui) { if (F.tid < 256) { const int r = u.rt * 256 + F.tid; tokl[ui * 256 + F.tid] = (r < meta[u.e]) ? tokidx[u.e * CAP + r] : 0; }
              else { const int t = F.tid - 256, pl = u.pn & 7; epil[ui * 256 + t] = args.b_gu[(size_t)u.e * 2048 + ((t < 128) ? (128 * pl + t) : (DFF + 128 * pl + (t - 128)))]; } } }
        __syncthreads();
        pg8::Gemm g{ws + WS_HN, ws + WS_WGU, M, 2 * DFF, D, D};
        pg8::EpiGU E{ws + WS_ACT, (const LAS float*)(F.lds + EPIL_OFF), 1.0f / (HN8_SCALE * W8_SCALE), ACT8_SCALE};
        pg8::gemm_phase<pg8::EpiGU, pg8::MoeOrder, MK_ALIGN5, true, true>(F.lds + RING_OFF, g, S, E, tokl);
        if (BOTH(5)) GRID_BAR();
    }

    if (IN(6)) {
        REFRESH();
        if (!IN(5)) moe_meta(F);
        const LAS int* meta = (const LAS int*)(F.lds + META_OFF);
        pg8::MoeOrder S{meta[130 + 32], F.G, blk, 4, meta + 130, meta + 32, meta + 64};
        LAS int* tokl = (LAS int*)(F.lds + TOKL_OFF);
        { pg8::Unit u; LAS float* epil = (LAS float*)(F.lds + EPIL_OFF); const float* gatew = (const float*)(ws + WS_GATEW);
          for (int ui = 0; ui < 6 && S.next(ui, u); ++ui) { if (F.tid < 256) { tokl[ui * 256 + F.tid] = u.pm * 256 + F.tid; epil[ui * 512 + F.tid] = args.b_down[(size_t)u.e * 1024 + (u.pn & 3) * 256 + F.tid]; }
              else { const int r = u.rt * 256 + (F.tid - 256); epil[ui * 512 + F.tid] = (r < meta[u.e]) ? gatew[(size_t)u.e * CAP + r] * Y8_SCALE : 0.0f; } } }
        __syncthreads();
        pg8::Gemm g{ws + WS_ACT, ws + WS_WD, M, D, DFF, DFF};
        pg8::EpiDown E{ws + WS_Y, (const LAS float*)(F.lds + EPIL_OFF), 1.0f / (ACT8_SCALE * W8_SCALE)};
        pg8::gemm_phase<pg8::EpiDown, pg8::MoeOrder, MK_ALIGN6, true, true>(F.lds + RING_OFF, g, S, E, tokl);
        if (BOTH(6)) GRID_BAR();
    }

    if (IN(7)) {
        REFRESH();
        if (!IN(6)) moe_meta(F);
        final_phase(F, args, blk);
    }
#undef IN
#undef BOTH
#undef GRID_BAR
}

#ifndef MK_STAGE
#define MK_STAGE 0
#endif
#ifndef MK_SPLIT
#define MK_SPLIT 0
#endif

#if MK_STAGE != 0
#endif

extern "C" void kernel_launch(void* const* d_in, const int* in_sizes, int n_in, void* d_out, int out_size, void* d_ws, size_t ws_size, hipStream_t stream) {
    static int grid = 0;
    if (grid == 0) {
        if (n_in != 18 || in_sizes[0] != M * D || out_size != M * D || ws_size < (size_t)1024 * MiB) { fprintf(stderr, "kernel_launch: unexpected shapes / workspace (n_in %d, ws %zu); nothing launched\n", n_in, ws_size); grid = -1; return; }
        int dev = 0, cus = 0, per_cu = 0;
        if (hipGetDevice(&dev) != hipSuccess || hipDeviceGetAttribute(&cus, hipDeviceAttributeMultiprocessorCount, dev) != hipSuccess) { grid = -1; return; }
        if (hipFuncSetAttribute((const void*)mega_fwd, hipFuncAttributeMaxDynamicSharedMemorySize, LDS_BYTES) != hipSuccess) { fprintf(stderr, "kernel_launch: hipFuncSetAttribute failed\n"); grid = -1; return; }
        if (hipOccupancyMaxActiveBlocksPerMultiprocessor(&per_cu, (const void*)mega_fwd, NWAVES * 64, LDS_BYTES) != hipSuccess || per_cu < 1) { fprintf(stderr, "kernel_launch: occupancy query says %d workgroups per CU\n", per_cu); }
        (void)hipGetLastError();
        grid = cus;
        if (grid != 256) { fprintf(stderr, "kernel_launch: built for a 256-CU device, found %d CUs; nothing launched\n", cus); grid = -1; return; }
    }
    if (grid < 0) return;
    if (hipMemsetAsync((char*)d_ws + WS_CTL, 0, CTL_ZERO_BYTES, stream) != hipSuccess) return;
    Args a{};
    a.x = (const float*)d_in[0]; a.norm_mix_g = (const float*)d_in[1]; a.w_in = (const float*)d_in[2]; a.b_f = (const float*)d_in[3]; a.b_glu = (const float*)d_in[4];
    a.w_dw = (const float*)d_in[5]; a.b_dw = (const float*)d_in[6]; a.ln_g = (const float*)d_in[7]; a.ln_b = (const float*)d_in[8]; a.w_out = (const float*)d_in[9];
    a.norm_ffn_g = (const float*)d_in[10]; a.w_router = (const float*)d_in[11]; a.b_router = (const float*)d_in[12]; a.w_gu = (const float*)d_in[13]; a.b_gu = (const float*)d_in[14];
    a.w_down = (const float*)d_in[15]; a.b_down = (const float*)d_in[16]; a.norm_final_g = (const float*)d_in[17];
    a.out = (float*)d_out; a.ws = (unsigned char*)d_ws; a.pad = 0;
    const int ph_end = (MK_STAGE == 0) ? NPHASE : (MK_STAGE + 1);
#if defined(MK_PREFILL)
    (void)hipMemsetAsync((char*)d_ws + WS_MIX, 0xFF, (size_t)M * D * 2, stream);
#endif
#if MK_SPLIT
    for (int p = 0; p < ph_end; ++p) { a.ph_lo = p; a.ph_hi = p + 1; a.li = p; hipLaunchKernelGGL(mega_fwd, dim3(grid), dim3(NWAVES * 64), LDS_BYTES, stream, a); }
#else
    a.ph_lo = 0; a.ph_hi = ph_end; a.li = 0;
    hipLaunchKernelGGL(mega_fwd, dim3(grid), dim3(NWAVES * 64), LDS_BYTES, stream, a);
#endif
#if MK_STAGE != 0
    orc::finish(MK_STAGE, a, stream);
#endif
}
```

```cpp
#include <hip/hip_runtime.h>
#include <hip/hip_bf16.h>
#include <cstdio>
#include <cstdint>
#include <cmath>
#define MK_VARIANT 0
#define MK_DBGSTAT 0
#define MK_ROWA 32
#define MK_ROWB 64
#define MK_NCONV 96
#define MK_DNP5 0
#define MK_L1 0
#define PG8_BAUX 0
#define MK_CONVSPLIT 0
#define MK_ALIGN5 true
#define MK_ALIGN6 true
namespace pg8 {
#define PG8_LAS __attribute__((address_space(3)))
typedef unsigned short bf16_t;
typedef short bf16x8 __attribute__((ext_vector_type(8)));
typedef float f32x4 __attribute__((ext_vector_type(4)));
typedef unsigned u32x4 __attribute__((ext_vector_type(4)));
constexpr int BM = 256, BK = 64, HALF = 128, HTB = HALF * BK * 2  , STAGE_BYTES = 8 * HTB, NXCD = 8, WGM = 8;

__host__ __device__ __forceinline__ int lds_byte(int r, int c) { const int st = (r >> 4) * 2 + (c >> 5), rr = r & 15, cc = c & 31, ob = rr * 64 + cc * 2; return st * 1024 + (ob ^ (((ob >> 9) & 1) << 5)); }
__host__ __device__ __forceinline__ void stage_rc(int b, int& R, int& C) { const int st = b / 1024, sb = b % 1024, swz = sb ^ (((sb >> 9) & 1) << 5); R = (st >> 1) * 16 + swz / 64; C = (st & 1) * 32 + (swz % 64) / 2; }
__host__ __device__ __forceinline__ int perm32(int rho) { const int n = rho >> 4, i = rho & 15; return 8 * (i >> 2) + 4 * n + (i & 3); }

struct Unit { int pm, pn, e, rt, seq; };
struct Gemm { const void* A; const void* Bt; int M, N, K, KB; };

struct StaticOrder {
    int nM, nN, nwg, G, c;
    __host__ __device__ void init(int M, int N, int G_, int c_) { nM = M / BM; nN = N / BM; nwg = nM * nN; G = G_; c = c_; }
    __host__ __device__ bool next(int i, Unit& u) const {
        const long L = (long)i * G + c; if (L >= nwg) return false;
        int wgid = (int)L; { const int q = nwg / NXCD, r = nwg % NXCD, xcd = wgid % NXCD, off = wgid / NXCD; wgid = (xcd < r ? xcd * (q + 1) : r * (q + 1) + (xcd - r) * q) + off; }
        const int nig = WGM * nN, gid = wgid / nig, fm = gid * WGM, gsz = (nM - fm) < WGM ? (nM - fm) : WGM;
        u.pm = fm + ((wgid % nig) % gsz); u.pn = (wgid % nig) / gsz; u.e = 0; u.rt = 0; return true;
    }
    __device__ __forceinline__ void a_ready(const Unit&) const {}
    __device__ __forceinline__ void done(const Unit&) const {}
};

__device__ __forceinline__ unsigned cvt_pk_bf16(float lo, float hi) { unsigned r; asm volatile("v_cvt_pk_bf16_f32 %0, %1, %2" : "=v"(r) : "v"(lo), "v"(hi)); return r; }
__device__ __forceinline__ float sigmoid_f(float x) { return __builtin_amdgcn_rcpf(1.0f + __builtin_amdgcn_exp2f(-1.4426950408889634f * x)); }
typedef int i32x4 __attribute__((ext_vector_type(4))); typedef int i32x8 __attribute__((ext_vector_type(8))); typedef unsigned u32x2 __attribute__((ext_vector_type(2)));
__device__ __forceinline__ float clamp448(float x) { return fminf(fmaxf(x, -448.0f), 448.0f); }
__device__ __forceinline__ unsigned pk4_fp8(float a, float b, float c, float d) { int w = __builtin_amdgcn_cvt_pk_fp8_f32(clamp448(a), clamp448(b), 0, false); w = __builtin_amdgcn_cvt_pk_fp8_f32(clamp448(c), clamp448(d), w, true); return (unsigned)w; }
__device__ __forceinline__ unsigned pk4_fp8_nc(float a, float b, float c, float d) { int w = __builtin_amdgcn_cvt_pk_fp8_f32(a, b, 0, false); w = __builtin_amdgcn_cvt_pk_fp8_f32(c, d, w, true); return (unsigned)w; }
__device__ __forceinline__ u32x4 pack8(f32x4 v0, f32x4 v1) { u32x4 w; w.x = cvt_pk_bf16(v0[0], v0[1]); w.y = cvt_pk_bf16(v0[2], v0[3]); w.z = cvt_pk_bf16(v1[0], v1[1]); w.w = cvt_pk_bf16(v1[2], v1[3]); return w; }

struct EpiProj {
    static constexpr bool PERM = true, AFTER_DRAIN = false;
    bf16_t *Q, *U; size_t qkv_stride  ; const PG8_LAS float* bglu  ; float qscale; unsigned* nrm;
    __device__ __forceinline__ void operator()(const f32x4 (&acc)[2][2][4][2], const Unit& u, int wr, int wc, int fr, int fq) const {
        const int row0 = u.pm * BM + wr * 64 + fr;
        if (u.pn < 6) {
            const int t = u.pn >> 1; bf16_t* base = Q + (size_t)t * qkv_stride; const float sc = (t == 0) ? qscale : 1.0f;
            const int col0 = (u.pn & 1) * 256 + wc * 32 + 8 * fq;
#pragma unroll
            for (int ai = 0; ai < 2; ++ai)
#pragma unroll
                for (int m = 0; m < 4; ++m) { bf16_t* rowp = base + (size_t)(row0 + ai * HALF + m * 16) * 512 + col0;
#pragma unroll
                    for (int bj = 0; bj < 2; ++bj) *(u32x4*)(rowp + bj * HALF) = pack8(acc[ai][bj][m][0] * sc, acc[ai][bj][m][1] * sc); }
            if (t < 2) {
#pragma unroll
                for (int bj = 0; bj < 2; ++bj) { float mx = 0.f;
#pragma unroll
                    for (int ai = 0; ai < 2; ++ai)
#pragma unroll
                        for (int m = 0; m < 4; ++m) { const f32x4 a0 = acc[ai][bj][m][0] * sc, a1 = acc[ai][bj][m][1] * sc;
                            float s = (a0[0] * a0[0] + a0[1] * a0[1]) + (a0[2] * a0[2] + a0[3] * a0[3]) + (a1[0] * a1[0] + a1[1] * a1[1]) + (a1[2] * a1[2] + a1[3] * a1[3]);
                            s += __shfl_xor(s, 16); s += __shfl_xor(s, 32); mx = fmaxf(mx, s); }
#pragma unroll
                    for (int o = 1; o < 16; o <<= 1) mx = fmaxf(mx, __shfl_xor(mx, o));
                    if (fr == 0 && fq == 0) { const int head = (u.pn & 1) * 4 + bj * 2 + (wc >> 1), bh = (u.pm >> 5) * 8 + head;
                        __hip_atomic_fetch_max(nrm + (size_t)(((t * 16 + bh) * 2 + (wc & 1)) * 64), __builtin_bit_cast(unsigned, mx), __ATOMIC_RELAXED, __HIP_MEMORY_SCOPE_AGENT); } } }
        } else {
            const int ch0 = (u.pn - 6) * 128 + wc * 32 + 8 * fq;
            f32x4 ba[2], bg[2];
#pragma unroll
            for (int n = 0; n < 2; ++n) { ba[n] = *(const PG8_LAS f32x4*)(bglu + ch0 + 4 * n); bg[n] = *(const PG8_LAS f32x4*)(bglu + 512 + ch0 + 4 * n); }
#pragma unroll
            for (int ai = 0; ai < 2; ++ai)
#pragma unroll
                for (int m = 0; m < 4; ++m) { f32x4 o[2];
#pragma unroll
                    for (int n = 0; n < 2; ++n) { const f32x4 a = acc[ai][0][m][n] + ba[n], g = acc[ai][1][m][n] + bg[n];
#pragma unroll
                        for (int j = 0; j < 4; ++j) o[n][j] = a[j] * sigmoid_f(g[j]); }
                    *(u32x4*)(U + (size_t)(row0 + ai * HALF + m * 16) * 512 + ch0) = pack8(o[0], o[1]); }
        }
    }
};
struct EpiH1 {
    static constexpr bool PERM = true, AFTER_DRAIN = false;
    const bf16_t* xn; const float* rms; const float* g; bf16_t* h1;
    __device__ __forceinline__ void operator()(const f32x4 (&acc)[2][2][4][2], const Unit& u, int wr, int wc, int fr, int fq) const {
        const int row0 = u.pm * BM + wr * 64 + fr, col0 = u.pn * BM + wc * 32 + 8 * fq;
        f32x4 gi[2][2];
#pragma unroll
        for (int bj = 0; bj < 2; ++bj)
#pragma unroll
            for (int n = 0; n < 2; ++n) { const f32x4 gv = *(const f32x4*)(g + col0 + bj * HALF + 4 * n);
                gi[bj][n] = (f32x4){__builtin_amdgcn_rcpf(gv[0]), __builtin_amdgcn_rcpf(gv[1]), __builtin_amdgcn_rcpf(gv[2]), __builtin_amdgcn_rcpf(gv[3])}; }
#pragma unroll
        for (int ai = 0; ai < 2; ++ai) {
            u32x4 xb[4][2]; float rr[4];
#pragma unroll
            for (int m = 0; m < 4; ++m) { const int row = row0 + ai * HALF + m * 16; rr[m] = rms[row];
#pragma unroll
                for (int bj = 0; bj < 2; ++bj) xb[m][bj] = *(const u32x4*)(xn + (size_t)row * 1024 + col0 + bj * HALF); }
            __builtin_amdgcn_sched_barrier(0);
#pragma unroll
            for (int m = 0; m < 4; ++m)
#pragma unroll
                for (int bj = 0; bj < 2; ++bj) { const int row = row0 + ai * HALF + m * 16; const size_t p = (size_t)row * 1024 + col0 + bj * HALF;
                    const u32x4 b = xb[m][bj]; const float r = rr[m];
                    const f32x4 x0 = (f32x4){__builtin_bit_cast(float, b.x << 16), __builtin_bit_cast(float, b.x & 0xffff0000u), __builtin_bit_cast(float, b.y << 16), __builtin_bit_cast(float, b.y & 0xffff0000u)} * r * gi[bj][0];
                    const f32x4 x1 = (f32x4){__builtin_bit_cast(float, b.z << 16), __builtin_bit_cast(float, b.z & 0xffff0000u), __builtin_bit_cast(float, b.w << 16), __builtin_bit_cast(float, b.w & 0xffff0000u)} * r * gi[bj][1];
                    *(u32x4*)(h1 + p) = pack8(acc[ai][bj][m][0] + x0, acc[ai][bj][m][1] + x1); }
            __builtin_amdgcn_sched_barrier(0);
        }
    }
};
struct EpiGU {
    static constexpr bool PERM = true, AFTER_DRAIN = false;
    unsigned char* act; const PG8_LAS float* tab  ; float acc_scale, out_scale;
    __device__ __forceinline__ void operator()(const f32x4 (&acc)[2][2][4][2], const Unit& u, int wr, int wc, int fr, int fq) const {
        const int row0 = u.pm * BM + wr * 64 + fr, pl = u.pn & 7, ch0 = pl * 128 + wc * 32 + 8 * fq;
        const PG8_LAS float* bp = tab + u.seq * 256 + wc * 32 + 8 * fq;
        f32x4 bgt[2], bup[2];
#pragma unroll
        for (int n = 0; n < 2; ++n) { bgt[n] = *(const PG8_LAS f32x4*)(bp + 4 * n); bup[n] = *(const PG8_LAS f32x4*)(bp + 128 + 4 * n); }
#pragma unroll
        for (int ai = 0; ai < 2; ++ai)
#pragma unroll
            for (int m = 0; m < 4; ++m) { f32x4 o[2];
#pragma unroll
                for (int n = 0; n < 2; ++n) { const f32x4 g = acc[ai][0][m][n] * acc_scale + bgt[n], up = acc[ai][1][m][n] * acc_scale + bup[n];
#pragma unroll
                    for (int j = 0; j < 4; ++j) { const float hg = fminf(g[j], 7.0f), hu = fminf(fmaxf(up[j], -7.0f), 7.0f);
                        o[n][j] = fmaf(hu, out_scale, out_scale) * (hg * __builtin_amdgcn_rcpf(1.0f + __builtin_amdgcn_exp2f(hg * (-1.702f * 1.4426950408889634f)))); } }
                u32x2 w; w.x = pk4_fp8_nc(o[0][0], o[0][1], o[0][2], o[0][3]); w.y = pk4_fp8_nc(o[1][0], o[1][1], o[1][2], o[1][3]);
                *(u32x2*)(act + (size_t)(row0 + ai * HALF + m * 16) * 1024 + ch0) = w; }
    }
};
struct EpiDown {
    static constexpr bool PERM = true, AFTER_DRAIN = false;
    unsigned char* y; const PG8_LAS float* tab  ; float acc_scale;
    __device__ __forceinline__ void operator()(const f32x4 (&acc)[2][2][4][2], const Unit& u, int wr, int wc, int fr, int fq) const {
        const int r0 = wr * 64 + fr, pl = u.pn & 3, col0 = pl * 256 + wc * 32 + 8 * fq;
        const PG8_LAS float* tp = tab + u.seq * 512; const PG8_LAS float* bp = tp + wc * 32 + 8 * fq;
        f32x4 bv[2][2];
#pragma unroll
        for (int bj = 0; bj < 2; ++bj)
#pragma unroll
            for (int n = 0; n < 2; ++n) bv[bj][n] = *(const PG8_LAS f32x4*)(bp + bj * HALF + 4 * n);
#pragma unroll
        for (int ai = 0; ai < 2; ++ai)
#pragma unroll
            for (int m = 0; m < 4; ++m) { const int r = r0 + ai * HALF + m * 16; const float gt = tp[256 + r];
                unsigned char* rowp = y + (size_t)(u.pm * BM + r) * 1024 + col0;
#pragma unroll
                for (int bj = 0; bj < 2; ++bj) { const f32x4 v0 = (acc[ai][bj][m][0] * acc_scale + bv[bj][0]) * gt, v1 = (acc[ai][bj][m][1] * acc_scale + bv[bj][1]) * gt;
                    u32x2 w; w.x = pk4_fp8(v0[0], v0[1], v0[2], v0[3]); w.y = pk4_fp8(v1[0], v1[1], v1[2], v1[3]); *(u32x2*)(rowp + bj * HALF) = w; } }
    }
};

struct MoeOrder {
    int nwg, G, c, NPN; const PG8_LAS int* ustart; const PG8_LAS int* ntile; const PG8_LAS int* tileoff;
    __device__ __forceinline__ bool next(int i, Unit& u) const {
        const int L = i * G + c; if (L >= nwg) return false;
        int wgid = L; { const int q = nwg / NXCD, r = nwg % NXCD, xcd = wgid % NXCD, off = wgid / NXCD; wgid = (xcd < r ? xcd * (q + 1) : r * (q + 1) + (xcd - r) * q) + off; }
        int e = 0;
        for (int k = 1; k < 32; ++k) e += (ustart[k] <= wgid) ? 1 : 0;
        e = __builtin_amdgcn_readfirstlane(e);
        const int l = wgid - ustart[e], rt = l / NPN, pl = l - rt * NPN;
        u.pm = __builtin_amdgcn_readfirstlane(tileoff[e] + rt); u.pn = __builtin_amdgcn_readfirstlane(e * NPN + pl); u.e = e; u.rt = __builtin_amdgcn_readfirstlane(rt); return true;
    }
    __device__ __forceinline__ void a_ready(const Unit&) const {}
    __device__ __forceinline__ void done(const Unit&) const {}
};

#ifndef PG8_BAUX
#define PG8_BAUX 0
#endif
template <class Epi, class Sched, bool ALIGN_EPI, bool GATHER, bool F8>
__device__ __forceinline__ void gemm_phase(PG8_LAS unsigned char* lds, const Gemm g, const Sched& S, const Epi& E, const PG8_LAS int* tokl) {
    const int tid = threadIdx.x, wid = __builtin_amdgcn_readfirstlane(tid >> 6), lane = tid & 63, wr = wid >> 2, wc = wid & 3, fr = lane & 15, fq = lane >> 4;
    const int KB = g.KB, nt = KB / 128;
    unsigned voffB[2];
#pragma unroll
    for (int i = 0; i < 2; ++i) { int R, C; stage_rc(tid * 16 + i * 8192, R, C); const int Rb = Epi::PERM ? ((R & ~31) + perm32(R & 31)) : R;
        voffB[i] = (unsigned)(Rb * KB + C * 2); }
    const size_t kstep = (size_t)(BK * 2);
    const size_t hstep = (size_t)HALF * KB;
    const size_t tstep = 2 * hstep;
    const unsigned ldsw = (unsigned)wid * 1024u;
    const int aoff = lds_byte(wr * 64 + fr, fq * 8), boff = lds_byte(wc * 32 + fr, fq * 8);
#define PG8_SA(b, h) (((b) * 2 + (h)) * HTB)
#define PG8_SB(b, h) ((4 + (b) * 2 + (h)) * HTB)
#define PG8_STAGE(bufoff, gbase, voff) do { _Pragma("unroll") for (int _i = 0; _i < 2; ++_i) \
        __builtin_amdgcn_global_load_lds((const unsigned*)((const char*)(gbase) + (voff)[_i]), (PG8_LAS unsigned*)(lds + (bufoff) + ldsw + _i * 8192), 16, 0, 0); } while (0)
#define PG8_STAGEB(bufoff, gbase, voff) do { _Pragma("unroll") for (int _i = 0; _i < 2; ++_i) \
        __builtin_amdgcn_global_load_lds((const unsigned*)((const char*)(gbase) + (voff)[_i]), (PG8_LAS unsigned*)(lds + (bufoff) + ldsw + _i * 8192), 16, 0, PG8_BAUX); } while (0)
#define PG8_LDA(dst, b, h) do { _Pragma("unroll") for (int m = 0; m < 4; ++m) _Pragma("unroll") for (int k = 0; k < 2; ++k) dst[m][k] = *(const PG8_LAS bf16x8*)(lds + PG8_SA(b, h) + aoff + m * 2048 + k * 1024); } while (0)
#define PG8_LDB(dst, b, h) do { _Pragma("unroll") for (int n = 0; n < 2; ++n) _Pragma("unroll") for (int k = 0; k < 2; ++k) dst[n][k] = *(const PG8_LAS bf16x8*)(lds + PG8_SB(b, h) + boff + n * 2048 + k * 1024); } while (0)
#define PG8_CAT(X) __builtin_shufflevector(__builtin_bit_cast(i32x4, (X)[0]), __builtin_bit_cast(i32x4, (X)[1]), 0, 1, 2, 3, 4, 5, 6, 7)
#define PG8_MMA(ai, bj, At, Bt) do { __builtin_amdgcn_s_setprio(1); if constexpr (F8) { _Pragma("unroll") for (int m = 0; m < 4; ++m) _Pragma("unroll") for (int n = 0; n < 2; ++n) \
        acc[ai][bj][m][n] = __builtin_amdgcn_mfma_scale_f32_16x16x128_f8f6f4(PG8_CAT(Bt[n]), PG8_CAT(At[m]), acc[ai][bj][m][n], 0, 0, 0, 0x7f7f7f7f, 0, 0x7f7f7f7f); } else { \
        _Pragma("unroll") for (int m = 0; m < 4; ++m) _Pragma("unroll") for (int n = 0; n < 2; ++n) _Pragma("unroll") for (int k = 0; k < 2; ++k) \
        acc[ai][bj][m][n] = __builtin_amdgcn_mfma_f32_16x16x32_bf16(Bt[n][k], At[m][k], acc[ai][bj][m][n], 0, 0, 0); } __builtin_amdgcn_s_setprio(0); } while (0)
#define PG8_WAIT_V(n) asm volatile("s_waitcnt vmcnt(" #n ")" ::: "memory")
#define PG8_WAIT_L(n) asm volatile("s_waitcnt lgkmcnt(" #n ")" ::: "memory")
#define PG8_BAR __builtin_amdgcn_s_barrier()
#define PG8_SCHED __builtin_amdgcn_sched_barrier(0)
#define PG8_SETOFF(V, UIDX) do { _Pragma("unroll") for (int _i = 0; _i < 2; ++_i) { int _R, _C; { int _t = threadIdx.x; asm volatile("" : "+v"(_t)); stage_rc(_t * 16 + _i * 8192, _R, _C); } \
        _Pragma("unroll") for (int _h = 0; _h < 2; ++_h) { const unsigned _r = GATHER ? (unsigned)tokl[(UIDX) * 256 + _h * HALF + _R] : (unsigned)(_h * HALF + _R); V[_h][_i] = _r * (unsigned)KB + (unsigned)(_C * 2); } } } while (0)
    Unit cur, nxt; int ui = 0;
    if (!S.next(0, cur)) return;
    cur.seq = 0;
    f32x4 acc[2][2][4][2];
#pragma unroll
    for (int a = 0; a < 2; ++a)
#pragma unroll
        for (int b = 0; b < 2; ++b)
#pragma unroll
            for (int m = 0; m < 4; ++m)
#pragma unroll
                for (int n = 0; n < 2; ++n) acc[a][b][m][n] = (f32x4){0.f, 0.f, 0.f, 0.f};
    bf16x8 At[4][2], B0[2][2], B1[2][2];
    unsigned voA[2][2];
    const char* cA = GATHER ? (const char*)g.A : (const char*)g.A + (size_t)cur.pm * tstep; const char* cB = (const char*)g.Bt + (size_t)cur.pn * tstep;
    PG8_SETOFF(voA, 0);
    S.a_ready(cur);
    PG8_STAGEB(PG8_SB(0, 0), cB, voffB); PG8_STAGEB(PG8_SB(0, 1), cB + hstep, voffB); PG8_STAGE(PG8_SA(0, 0), cA, voA[0]); PG8_STAGE(PG8_SA(0, 1), cA, voA[1]);
    if (wr == 1) PG8_BAR;
    PG8_WAIT_V(2); PG8_BAR;
    PG8_STAGEB(PG8_SB(1, 0), cB + kstep, voffB); PG8_STAGE(PG8_SA(1, 0), cA + kstep, voA[0]); PG8_STAGEB(PG8_SB(1, 1), cB + hstep + kstep, voffB);
    PG8_WAIT_V(6); PG8_BAR;
    for (;;) {
        const bool has_next = S.next(ui + 1, nxt);
        const char* nA = has_next ? (GATHER ? (const char*)g.A : (const char*)g.A + (size_t)nxt.pm * tstep) : cA; const char* nB = has_next ? (const char*)g.Bt + (size_t)nxt.pn * tstep : cB;
#pragma clang loop unroll(disable)
        for (int t = 0; t < nt; t += 2) {
            const bool last = (t == nt - 2);
            const char* a1 = cA + (size_t)(t + 1) * kstep;
            const char* a2 = last ? nA : cA + (size_t)(t + 2) * kstep; const char* b2 = last ? nB : cB + (size_t)(t + 2) * kstep;
            const char* a3 = a2 + kstep; const char* b3 = b2 + kstep;
            if (last && has_next) S.a_ready(nxt);
            PG8_LDB(B0, 0, 0); PG8_LDB(B1, 0, 1); PG8_SCHED; PG8_LDA(At, 0, 0); PG8_STAGE(PG8_SA(1, 1), a1, voA[1]);
            if (GATHER && last && has_next) { PG8_SETOFF(voA, ui + 1); }
            PG8_WAIT_V(8); PG8_WAIT_L(0); PG8_BAR; PG8_MMA(0, 0, At, B0); PG8_MMA(0, 1, At, B1); PG8_BAR; PG8_SCHED;
            PG8_LDA(At, 0, 1); PG8_STAGEB(PG8_SB(0, 0), b2, voffB); PG8_STAGEB(PG8_SB(0, 1), b2 + hstep, voffB); PG8_STAGE(PG8_SA(0, 0), a2, voA[0]);
            PG8_WAIT_V(8); PG8_WAIT_L(0); PG8_BAR; PG8_MMA(1, 0, At, B0); PG8_MMA(1, 1, At, B1); PG8_BAR; PG8_SCHED;
            PG8_LDB(B0, 1, 0); PG8_LDB(B1, 1, 1); PG8_SCHED; PG8_LDA(At, 1, 0); PG8_STAGE(PG8_SA(0, 1), a2, voA[1]);
            PG8_WAIT_V(8); PG8_WAIT_L(0); PG8_BAR; PG8_MMA(0, 0, At, B0); PG8_MMA(0, 1, At, B1); PG8_BAR; PG8_SCHED;
            PG8_LDA(At, 1, 1); PG8_STAGEB(PG8_SB(1, 0), b3, voffB); PG8_STAGEB(PG8_SB(1, 1), b3 + hstep, voffB); PG8_STAGE(PG8_SA(1, 0), a3, voA[0]);
            PG8_WAIT_V(8); PG8_WAIT_L(0); PG8_BAR; PG8_MMA(1, 0, At, B0); PG8_MMA(1, 1, At, B1); PG8_BAR; PG8_SCHED;
        }
        if constexpr (ALIGN_EPI) { if (wr == 0) PG8_BAR; }
        E(acc, cur, wr, wc, fr, fq); S.done(cur);
        if (!has_next) break;
#pragma unroll
        for (int a = 0; a < 2; ++a)
#pragma unroll
            for (int b = 0; b < 2; ++b)
#pragma unroll
                for (int m = 0; m < 4; ++m)
#pragma unroll
                    for (int n = 0; n < 2; ++n) acc[a][b][m][n] = (f32x4){0.f, 0.f, 0.f, 0.f};
        cur = nxt; cA = nA; cB = nB; ++ui; cur.seq = ui;
        if constexpr (ALIGN_EPI) { if (wr == 1) PG8_BAR; }
    }
    PG8_WAIT_V(0);
    if constexpr (!ALIGN_EPI) { if (wr == 0) PG8_BAR; }
    PG8_BAR;
#undef PG8_SA
#undef PG8_SB
#undef PG8_STAGE
#undef PG8_STAGEB
#undef PG8_LDA
#undef PG8_LDB
#undef PG8_MMA
#undef PG8_CAT
#undef PG8_WAIT_V
#undef PG8_WAIT_L
#undef PG8_BAR
#undef PG8_SCHED
#undef PG8_SETOFF
}
}
namespace attn_body {
using bf16=__hip_bfloat16;
using bf16x8=__attribute__((ext_vector_type(8)))short;
using s16x4=__attribute__((ext_vector_type(4)))short;
using f32x16=__attribute__((ext_vector_type(16)))float;
using u32x4=__attribute__((ext_vector_type(4)))unsigned;
using f32x4_t=__attribute__((ext_vector_type(4)))float;
constexpr int BATCH=2,NHEAD=8,SEQ=8192,D=64,DM=NHEAD*D,OPITCH=1024;
constexpr int NW=8,QBLK=32,QB=QBLK*NW,KVBLK=64,NQB=SEQ/QB;
constexpr int ATTN_PITCH=DM, ATTN_UNIT_ROWS=QB;
__device__ __forceinline__ int crow(int r,int hi){return (r&3)+8*(r>>2)+4*hi;}
#define SBAR() __builtin_amdgcn_sched_barrier(0)
__device__ __forceinline__ void cmask(f32x16&p0,f32x16&p1,int jb,int qrel,int hi){
  const float NEG=-INFINITY; int kb=64*jb+4*hi;
  #pragma unroll
  for(int r=0;r<16;++r){int kv=kb+(r&3)+8*(r>>2); if(kv>qrel)p0[r]=NEG; if(kv+32>qrel)p1[r]=NEG;}
}

constexpr int NSLOT=3, SLOTB=8192;
constexpr int LDS_K=0, LDS_V=NSLOT*SLOTB, LDS_WS=2*NSLOT*SLOTB, LDS_OST=LDS_WS+NW*64*4, LDS_C=LDS_OST+NW*4096, LDS_BYTES=LDS_C+SEQ*4;
constexpr float C2=0.125f*1.4426950408889634f;
__device__ __forceinline__ void glds16(const void*gsrc,unsigned lds_dst){unsigned keep;
  asm volatile("s_mov_b32 %0, m0\n\ts_mov_b32 m0, %2\n\ts_nop 0\n\tglobal_load_lds_dwordx4 %1, off\n\ts_mov_b32 m0, %0":"=&s"(keep):"v"(gsrc),"s"(lds_dst):"memory");}
__device__ __forceinline__ float max3f(float a,float b,float c){float r;asm("v_max3_f32 %0, %1, %2, %3":"=v"(r):"v"(a),"v"(b),"v"(c));return r;}
__device__ __forceinline__ float max2f(float a,float b){float r;asm("v_max_f32_e32 %0, %1, %2":"=v"(r):"v"(a),"v"(b));return r;}
__device__ __forceinline__ float fadd_s(float a,float b){float r;asm("v_add_f32_e32 %0, %1, %2":"=v"(r):"v"(a),"v"(b));return r;}
__device__ __forceinline__ float fsub_s(float a,float b){float r;asm("v_sub_f32_e32 %0, %1, %2":"=v"(r):"v"(a),"v"(b));return r;}
typedef float f32x2_t __attribute__((ext_vector_type(2))); typedef __bf16 bf16x2_t __attribute__((ext_vector_type(2)));
__device__ __forceinline__ unsigned cvtpk_s(float lo,float hi){f32x2_t v={lo,hi};bf16x2_t b=__builtin_convertvector(v,bf16x2_t);return __builtin_bit_cast(unsigned,b);}
#define WAIT_BAR(N) asm volatile("s_waitcnt vmcnt(" #N ") lgkmcnt(0)\n\ts_barrier":::"memory")

__device__ __forceinline__ void qkt(f32x16&p0,f32x16&p1,const char*Kslot,const bf16x8*qr,const f32x16&c0,const f32x16&c1,int r32,int hi){
  const char*kb=Kslot+hi*1024+r32*16;
  #pragma unroll
  for(int d0=0;d0<4;++d0){
    const bf16x8 b0=*reinterpret_cast<const bf16x8*>(kb+d0*2048);
    const bf16x8 b1=*reinterpret_cast<const bf16x8*>(kb+d0*2048+512);
    if(d0==0){p0=__builtin_amdgcn_mfma_f32_32x32x16_bf16(b0,qr[0],c0,0,0,0);p1=__builtin_amdgcn_mfma_f32_32x32x16_bf16(b1,qr[0],c1,0,0,0);}
    else{p0=__builtin_amdgcn_mfma_f32_32x32x16_bf16(b0,qr[d0],p0,0,0,0);p1=__builtin_amdgcn_mfma_f32_32x32x16_bf16(b1,qr[d0],p1,0,0,0);}}
}
typedef __attribute__((address_space(3))) const char* lds_cptr;
typedef short v4i16_t __attribute__((ext_vector_type(4)));
__device__ __forceinline__ void kload8(bf16x8*kf,lds_cptr kp){
  kf[0]=*(const __attribute__((address_space(3))) bf16x8*)(kp);      kf[1]=*(const __attribute__((address_space(3))) bf16x8*)(kp+512);
  kf[2]=*(const __attribute__((address_space(3))) bf16x8*)(kp+2048); kf[3]=*(const __attribute__((address_space(3))) bf16x8*)(kp+2560);
  kf[4]=*(const __attribute__((address_space(3))) bf16x8*)(kp+4096); kf[5]=*(const __attribute__((address_space(3))) bf16x8*)(kp+4608);
  kf[6]=*(const __attribute__((address_space(3))) bf16x8*)(kp+6144); kf[7]=*(const __attribute__((address_space(3))) bf16x8*)(kp+6656);
}
__device__ __forceinline__ void kload2(bf16x8*kf,lds_cptr kp,int j){ kf[2*j]=*(const __attribute__((address_space(3))) bf16x8*)(kp+j*2048); kf[2*j+1]=*(const __attribute__((address_space(3))) bf16x8*)(kp+j*2048+512); }
__device__ __forceinline__ s16x4 vtr(lds_cptr p){ return __builtin_bit_cast(s16x4,__builtin_amdgcn_ds_read_tr16_b64_v4i16((__attribute__((address_space(3))) v4i16_t*)p)); }
__device__ __forceinline__ float rowmax(const f32x16&p0,const f32x16&p1){
  float a=max3f(p0[0],p0[1],p1[0]),b=max3f(p0[2],p0[3],p1[1]);a=max3f(a,p1[2],p1[3]);
  #pragma unroll
  for(int r=4;r<16;r+=4){a=max3f(a,p0[r],p0[r+1]);b=max3f(b,p0[r+2],p0[r+3]);a=max3f(a,p1[r],p1[r+1]);b=max3f(b,p1[r+2],p1[r+3]);}
  const float m=max2f(a,b);
  auto rr=__builtin_amdgcn_permlane32_swap(__float_as_uint(m),__float_as_uint(m),false,false);
  return max2f(__uint_as_float(rr[0]),__uint_as_float(rr[1]));
}
__device__ __forceinline__ void pv(f32x16*o,int vb,bf16x8 pa0,bf16x8 pa1,bf16x8 pa2,bf16x8 pa3){
  #pragma unroll
  for(int d0=0;d0<2;++d0){s16x4 lo[4],hi[4];
    #pragma unroll
    for(int ks=0;ks<4;++ks){
      asm volatile("ds_read_b64_tr_b16 %0,%1 offset:%c2":"=&v"(lo[ks]):"v"(vb),"i"(d0*4096+ks*1024):"memory");
      asm volatile("ds_read_b64_tr_b16 %0,%1 offset:%c2":"=&v"(hi[ks]):"v"(vb),"i"(d0*4096+ks*1024+512):"memory");}
    asm volatile("s_waitcnt lgkmcnt(0)":::"memory");SBAR();
    #define PK(k) (bf16x8){lo[k][0],lo[k][1],lo[k][2],lo[k][3],hi[k][0],hi[k][1],hi[k][2],hi[k][3]}
    o[d0]=__builtin_amdgcn_mfma_f32_32x32x16_bf16(pa0,PK(0),o[d0],0,0,0);
    o[d0]=__builtin_amdgcn_mfma_f32_32x32x16_bf16(pa1,PK(1),o[d0],0,0,0);
    o[d0]=__builtin_amdgcn_mfma_f32_32x32x16_bf16(pa2,PK(2),o[d0],0,0,0);
    o[d0]=__builtin_amdgcn_mfma_f32_32x32x16_bf16(pa3,PK(3),o[d0],0,0,0);
    #undef PK
  }
}

#ifndef ATTN_STORE16
#define ATTN_STORE16(p,v) (*(u32x4*)(p)=(v))
#endif
template<int THRL> __device__ __forceinline__ void attn_unit(int b,int h,int qb,const bf16*Q,const bf16*__restrict__ K,const bf16*__restrict__ V,bf16*O,const float*__restrict__ CP,const unsigned*__restrict__ NRM,char*shm){
  const int tid=threadIdx.x,lane=tid&63,r32=lane&31,hi=lane>>5; const int wid=__builtin_amdgcn_readfirstlane(tid>>6);
  const long rowbase=(long)b*SEQ; const int q0=qb*QB;
  const bf16*Qw=Q+(rowbase+q0+wid*QBLK)*DM+h*D;
  const bf16*Kh=K+rowbase*DM+h*D,*Vh=V+rowbase*DM+h*D;
  const unsigned lds0=(unsigned)(uintptr_t)shm;
  const lds_cptr shm3=(lds_cptr)shm;
  float*wsf=(float*)(shm+LDS_WS)+wid*64;
  const bf16*ksrc=Kh+(long)lane*DM+wid*8;
  const bf16*vsrc=Vh+(long)(16*(wid&3)+(lane>>2))*DM+(wid>>2)*32+(lane&3)*8;
  const unsigned kdst=lds0+LDS_K+wid*1024, vdst=lds0+LDS_V+wid*1024;
  #define DMA_K(t,slot) glds16(ksrc+(long)TIDX(t)*KVBLK*DM,(unsigned)__builtin_amdgcn_readfirstlane(kdst+(slot)))
  #define DMA_V(t,slot) glds16(vsrc+(long)TIDX(t)*KVBLK*DM,(unsigned)__builtin_amdgcn_readfirstlane(vdst+(slot)))
  const int vb0=(int)(lds0+LDS_V)+((lane>>4)&1)*32+(lane&3)*8+(4*hi+((lane&15)>>2))*64;
  const char*Kbase=shm+LDS_K; bf16x8 kf[8];
  const lds_cptr kp0=shm3+LDS_K+hi*1024+r32*16; const lds_cptr vp0=shm3+LDS_V+((lane>>4)&1)*32+(lane&3)*8+(4*hi+((lane&15)>>2))*64;
  const int NT=(q0+QB)/KVBLK;
#if defined(ATT_ORIGORDER)
  #define TIDX(p) (p)
  #define JBOF(t) ((t)-(NT-4))
#else
  #define TIDX(p) (((p)<4)?(NT-4+(p)):(NT-1-(p)))
  #define JBOF(t) (((t)<4)?(t):-1)
#endif
  const float*cg=CP+(long)(b*NHEAD+h)*SEQ;
  typedef __attribute__((address_space(3))) const f32x4_t* lds_c4;
#if !defined(ATT_NOSTAGE)
  { float*cl=(float*)(shm+LDS_C); const int nk=q0+QB; for(int i=tid*4;i<nk;i+=NW*64*4)*(f32x4_t*)(cl+i)=*(const f32x4_t*)(cg+i); }
#endif
  const lds_c4 cl4=(lds_c4)(shm3+LDS_C)+hi;
#if defined(ATT_NOBIAS)
  #define CBIAS(C0,C1,a) do{ _Pragma("unroll") for(int g_=0;g_<16;++g_){ C0[g_]=nm; C1[g_]=nm; } }while(0)
#else
  #define CBIAS(C0,C1,a) do{ const lds_c4 cp_=cl4+16*(a); _Pragma("unroll") for(int g_=0;g_<4;++g_){ const f32x4_t v_=cp_[2*g_], w_=cp_[8+2*g_]; \
      C0[4*g_]=nm-v_[0];C0[4*g_+1]=nm-v_[1];C0[4*g_+2]=nm-v_[2];C0[4*g_+3]=nm-v_[3]; C1[4*g_]=nm-w_[0];C1[4*g_+1]=nm-w_[1];C1[4*g_+2]=nm-w_[2];C1[4*g_+3]=nm-w_[3]; } }while(0)
#endif
  DMA_K(0,0);DMA_V(0,0);DMA_K(1,SLOTB);
  bf16x8 qr[4];
  #pragma unroll
  for(int d0=0;d0<4;++d0)qr[d0]=*reinterpret_cast<const bf16x8*>(&Qw[(long)r32*DM+d0*16+hi*8]);
  #if defined(ATT_NOBIAS)
  float l_reg=0.f,nm=0.f;
#else
  float l_reg=0.f,nm=cg[q0+wid*QBLK+r32];
#endif
  f32x16 o[2];o[0]=f32x16{};o[1]=f32x16{};
  const int qrel=wid*QBLK+r32;
  #define CMASK(P0,P1,t) do{int jb_=JBOF(t); if(jb_>=0)cmask(P0,P1,jb_,qrel,hi);}while(0)
  bool resc=false;
  #define START(P0,P1) do{ const float rm=rowmax(P0,P1); resc=false; \
    { const float dl=rm; \
      _Pragma("unroll") for(int r=0;r<16;++r){P0[r]=fsub_s(P0[r],dl);P1[r]=fsub_s(P1[r],dl);} \
      nm=fsub_s(nm,dl); } \
    _Pragma("unroll") for(int r=0;r<16;++r)P0[r]=__builtin_amdgcn_exp2f(P0[r]); }while(0)
  #define RESC() do{ if(resc){ asm volatile("s_waitcnt lgkmcnt(0)":::"memory"); \
      _Pragma("unroll") for(int d_=0;d_<2;++d_) _Pragma("unroll") for(int r=0;r<16;++r)o[d_][r]*=wsf[crow(r,hi)]; } }while(0)
  f32x16 pA0,pA1,pB0,pB1;
  int sl_prev=0,sl_cur=0,sl_next=SLOTB;
  #define ROT() do{sl_prev=sl_cur;sl_cur=sl_next;sl_next=(sl_next==(NSLOT-1)*SLOTB)?0:sl_next+SLOTB;}while(0)
  DMA_K(2,2*SLOTB);
  WAIT_BAR(3);
  int NTe=NT;
#if !defined(ATT_NOSKIP)
  { const unsigned*np=NRM+(size_t)((b*NHEAD+h)*2)*64; const float qn=__builtin_bit_cast(float,np[0])+__builtin_bit_cast(float,np[64]), kn=__builtin_bit_cast(float,np[16*2*64])+__builtin_bit_cast(float,np[16*2*64+64]);
    const float thr=40.0f+2.0f*1.02f*sqrtf(qn*kn); const __attribute__((address_space(3))) float*cls=(const __attribute__((address_space(3))) float*)(shm3+LDS_C);
    const float cq0=cls[q0]; int lo_=0,hi_=NT-4;
    while(lo_<hi_){ const int mid=(lo_+hi_)>>1; if(cq0-cls[64*mid+63]>=-thr)hi_=mid; else lo_=mid+1; }
    NTe=4+(NT-4-lo_); NTe+=NTe&1; NTe=__builtin_amdgcn_readfirstlane(NTe); }
#endif
  { f32x16 cb0,cb1; CBIAS(cb0,cb1,TIDX(0)); qkt(pA0,pA1,Kbase,qr,cb0,cb1,r32,hi); } asm volatile("s_nop 15\n\ts_nop 7":"+v"(pA0),"+v"(pA1));CMASK(pA0,pA1,0);
  START(pA0,pA1);
  _Pragma("unroll") for(int r=0;r<16;++r)pA1[r]=__builtin_amdgcn_exp2f(pA1[r]);
  WAIT_BAR(0);
  DMA_K(3,0);DMA_V(1,SLOTB);
  ROT();
  kload8(kf,kp0+sl_cur);
  WAIT_BAR(2);
  s16x4 vlo[8],vhi[8]; u32x4 pw0,pw1,pw2,pw3;
  #define PKW(P,B) cvtpk_s(P[B],P[B+1])
  #define PAF(k) __builtin_bit_cast(bf16x8,pw##k)
  #define VFR(i) (bf16x8){vlo[i][0],vlo[i][1],vlo[i][2],vlo[i][3],vhi[i][0],vhi[i][1],vhi[i][2],vhi[i][3]}
  #define PIN(x) asm volatile("":"+v"(x))
  #define MX3(a,b,c) __builtin_fmaxf(__builtin_fmaxf((a),(b)),(c))
  #define GAPA(MF,A0,A1,A2,A3,W0,W1,PW) do{ MF; sacc+=A0; sacc+=A1; sacc+=A2; sacc+=A3; PIN(sacc); W0; W1; PIN(PW); SBAR(); }while(0)
  #define EX(v) __builtin_amdgcn_exp2f(v)
  #define GAPB(MF,X,B) do{ MF; X[B]=EX(X[B]); X[B+1]=EX(X[B+1]); X[B+2]=EX(X[B+2]); X[B+3]=EX(X[B+3]); PIN(X); SBAR(); }while(0)
  #define VRD(i) do{ vlo[i]=vtr(vp_+(((i)>>2)*4096+((i)&3)*1024)); vhi[i]=vtr(vp_+(((i)>>2)*4096+((i)&3)*1024+512)); }while(0)
  #define KRD(G,j) do{ if(G){ kload2(kf,kp0+sl_next,j); SBAR(); } }while(0)
  #define STEP(C0,C1,P0,P1,t,GK,GV,GL) do{ SBAR(); \
    CBIAS(C0,C1,TIDX(t)); SBAR(); \
    const lds_cptr vp_=vp0+sl_prev; \
    VRD(0); SBAR(); float sacc=(P0[0]+P0[1]); \
    GAPA(C0=__builtin_amdgcn_mfma_f32_32x32x16_bf16(kf[0],qr[0],C0,0,0,0), P0[2],P0[3],P0[4],P0[5],     pw0[0]=PKW(P0,0), pw0[1]=PKW(P0,2), pw0); \
    VRD(4); SBAR(); GAPA(C1=__builtin_amdgcn_mfma_f32_32x32x16_bf16(kf[1],qr[0],C1,0,0,0), P0[6],P0[7],P0[8],P0[9],     pw0[2]=PKW(P0,4), pw0[3]=PKW(P0,6), pw0); \
    VRD(1); SBAR(); GAPA(C0=__builtin_amdgcn_mfma_f32_32x32x16_bf16(kf[2],qr[1],C0,0,0,0),   P0[10],P0[11],P0[12],P0[13], pw1[0]=PKW(P0,8), pw1[1]=PKW(P0,10), pw1); \
    VRD(5); SBAR(); GAPA(C1=__builtin_amdgcn_mfma_f32_32x32x16_bf16(kf[3],qr[1],C1,0,0,0),   P0[14],P0[15],P1[0],P1[1],   pw1[2]=PKW(P0,12),pw1[3]=PKW(P0,14), pw1); \
    VRD(2); SBAR(); GAPA(C0=__builtin_amdgcn_mfma_f32_32x32x16_bf16(kf[4],qr[2],C0,0,0,0),   P1[2],P1[3],P1[4],P1[5],     pw2[0]=PKW(P1,0), pw2[1]=PKW(P1,2), pw2); \
    VRD(6); SBAR(); GAPA(C1=__builtin_amdgcn_mfma_f32_32x32x16_bf16(kf[5],qr[2],C1,0,0,0),   P1[6],P1[7],P1[8],P1[9],     pw2[2]=PKW(P1,4), pw2[3]=PKW(P1,6), pw2); \
    VRD(3); SBAR(); GAPA(C0=__builtin_amdgcn_mfma_f32_32x32x16_bf16(kf[6],qr[3],C0,0,0,0),   P1[10],P1[11],P1[12],P1[13], pw3[0]=PKW(P1,8), pw3[1]=PKW(P1,10), pw3); \
    VRD(7); SBAR(); GAPA(C1=__builtin_amdgcn_mfma_f32_32x32x16_bf16(kf[7],qr[3],C1,0,0,0),   P1[14],P1[15],0.f,0.f,       pw3[2]=PKW(P1,12),pw3[3]=PKW(P1,14), pw3); \
    l_reg+=sacc; \
    if(GK){DMA_K((t)+3,sl_cur);} if(GV){DMA_V((t)+1,sl_next);} \
    CMASK(C0,C1,t); \
    { float a=MX3(C0[0],C0[1],C1[0]),b=MX3(C0[2],C0[3],C1[1]); a=MX3(a,C1[2],C1[3]); \
      _Pragma("unroll") for(int r=4;r<16;r+=4){a=MX3(a,C0[r],C0[r+1]);b=MX3(b,C0[r+2],C0[r+3]);a=MX3(a,C1[r],C1[r+1]);b=MX3(b,C1[r+2],C1[r+3]);} \
      float rm=__builtin_fmaxf(a,b); { auto rr=__builtin_amdgcn_permlane32_swap(__float_as_uint(rm),__float_as_uint(rm),false,false); rm=__builtin_fmaxf(__uint_as_float(rr[0]),__uint_as_float(rr[1])); } \
      resc=false; \
      if(__builtin_expect(__any(rm>(float)THRL),0)){ const float dl=__builtin_fmaxf(rm,0.f); \
        _Pragma("unroll") for(int r=0;r<16;++r){C0[r]-=dl;C1[r]-=dl;} \
        nm-=dl; \
        const float f=__builtin_amdgcn_exp2f(-dl); l_reg*=f; if(hi==0)wsf[r32]=f; resc=true; } } \
    SBAR(); \
    GAPB(o[0]=__builtin_amdgcn_mfma_f32_32x32x16_bf16(PAF(0),VFR(0),o[0],0,0,0), C0,0); \
    GAPB(o[1]=__builtin_amdgcn_mfma_f32_32x32x16_bf16(PAF(0),VFR(4),o[1],0,0,0), C0,4); \
    KRD(GL,0); GAPB(o[0]=__builtin_amdgcn_mfma_f32_32x32x16_bf16(PAF(1),VFR(1),o[0],0,0,0), C0,8); \
    KRD(GL,1); GAPB(o[1]=__builtin_amdgcn_mfma_f32_32x32x16_bf16(PAF(1),VFR(5),o[1],0,0,0), C0,12); \
    KRD(GL,2); GAPB(o[0]=__builtin_amdgcn_mfma_f32_32x32x16_bf16(PAF(2),VFR(2),o[0],0,0,0), C1,0); \
    KRD(GL,3); GAPB(o[1]=__builtin_amdgcn_mfma_f32_32x32x16_bf16(PAF(2),VFR(6),o[1],0,0,0), C1,4); \
    GAPB(o[0]=__builtin_amdgcn_mfma_f32_32x32x16_bf16(PAF(3),VFR(3),o[0],0,0,0), C1,8); \
    GAPB(o[1]=__builtin_amdgcn_mfma_f32_32x32x16_bf16(PAF(3),VFR(7),o[1],0,0,0), C1,12); \
    }while(0)
  int t=1;
  #define ENDW(tt) do{ if((tt)+3<NTe){WAIT_BAR(2);} else if((tt)+2<NTe){WAIT_BAR(1);} else {WAIT_BAR(0);} }while(0)
  for(;t<5&&t+1<NTe;t+=2){
    STEP(pB0,pB1,pA0,pA1,t,(t+3<NTe),(t+1<NTe),(t+1<NTe));       ENDW(t);   RESC(); ROT();
    STEP(pA0,pA1,pB0,pB1,t+1,(t+4<NTe),(t+2<NTe),(t+2<NTe));     ENDW(t+1); RESC(); ROT();
  }
  #undef CMASK
  #define CMASK(P0,P1,t) do{}while(0)
  for(;t+5<NTe;t+=2){
    STEP(pB0,pB1,pA0,pA1,t,true,true,true);     WAIT_BAR(2); RESC(); ROT();
    STEP(pA0,pA1,pB0,pB1,t+1,true,true,true);   WAIT_BAR(2); RESC(); ROT();
  }
  #undef CMASK
  #define CMASK(P0,P1,t) do{int jb_=JBOF(t); if(jb_>=0)cmask(P0,P1,jb_,qrel,hi);}while(0)
  for(;t+1<NTe;t+=2){
    STEP(pB0,pB1,pA0,pA1,t,(t+3<NTe),(t+1<NTe),(t+1<NTe));       ENDW(t);   RESC(); ROT();
    STEP(pA0,pA1,pB0,pB1,t+1,(t+4<NTe),(t+2<NTe),(t+2<NTe));     ENDW(t+1); RESC(); ROT();
  }
  STEP(pB0,pB1,pA0,pA1,NTe-1,false,false,false); RESC();
  { float sacc=pB0[0]+pB0[1]; _Pragma("unroll") for(int r=2;r<16;++r)sacc+=pB0[r]; _Pragma("unroll") for(int r=0;r<16;++r)sacc+=pB1[r]; l_reg+=sacc;
    pw0=(u32x4){PKW(pB0,0),PKW(pB0,2),PKW(pB0,4),PKW(pB0,6)};pw1=(u32x4){PKW(pB0,8),PKW(pB0,10),PKW(pB0,12),PKW(pB0,14)};pw2=(u32x4){PKW(pB1,0),PKW(pB1,2),PKW(pB1,4),PKW(pB1,6)};pw3=(u32x4){PKW(pB1,8),PKW(pB1,10),PKW(pB1,12),PKW(pB1,14)};
    SBAR(); pv(o,vb0+sl_cur,PAF(0),PAF(1),PAF(2),PAF(3)); }
  #undef PKW
  #undef PAF
  #undef VFR
  #undef PIN
  #undef MX3
  #undef GAPA
  #undef GAPB
  #undef EX
  #undef VRD
  #undef KRD
  #undef STEP
  #undef ENDW
  {auto rr=__builtin_amdgcn_permlane32_swap(__float_as_uint(l_reg),__float_as_uint(l_reg),false,false);l_reg=__uint_as_float(rr[0])+__uint_as_float(rr[1]);}
  if(hi==0)wsf[32+r32]=l_reg;asm volatile("s_waitcnt lgkmcnt(0)":::"memory");
  float rli[16];
  #pragma unroll
  for(int r=0;r<16;++r)rli[r]=__builtin_amdgcn_rcpf(wsf[32+crow(r,hi)]);
  bf16*Ow=O+(rowbase+q0+wid*QBLK)*OPITCH+h*D;
  { bf16*stg=(bf16*)(shm+LDS_OST)+wid*2048;
    #pragma unroll
    for(int r=0;r<16;++r){const int orow=crow(r,hi);
      #pragma unroll
      for(int d0=0;d0<2;++d0)stg[orow*64+d0*32+r32]=__float2bfloat16(o[d0][r]*rli[r]);}
    asm volatile("s_waitcnt lgkmcnt(0)":::"memory");
    #pragma unroll
    for(int i=0;i<4;++i){const int row=i*8+(lane>>3),ch=lane&7; const u32x4 v=*(const u32x4*)(stg+row*64+ch*8); ATTN_STORE16(Ow+(long)row*OPITCH+ch*8,v);} }
  asm volatile("s_waitcnt lgkmcnt(0)\n\ts_barrier":::"memory");
  #undef DMA_K
  #undef DMA_V
  #undef TIDX
  #undef JBOF
  #undef CBIAS
  #undef CMASK
  #undef START
  #undef RESC
  #undef ROT
}
constexpr int ATTN_LDS_BYTES=LDS_BYTES;
struct AttnTensors { const bf16* Q; const bf16* K; const bf16* V; bf16* O; const float* CP; const unsigned* NRM; };
struct AttnUnit { int bh; int qb; };
struct StaticOrder {
  int vcu;
  __device__ __forceinline__ explicit StaticOrder(int grid,int block):vcu((grid%8==0)?((block%8)*(grid/8)+block/8):block){}
  __device__ __forceinline__ bool next(int i,AttnUnit&u)const{ const int j=vcu+256*(i>>1); if(j>=256)return false; const int s=j&15; u.bh=j>>4; u.qb=(i&1)?s:31-s; return true; }
  __device__ __forceinline__ void a_ready(const AttnUnit&)const{}
  __device__ __forceinline__ void done(const AttnUnit&)const{}
};
struct QueueOrder {
  unsigned* head; volatile unsigned* slot;
  __device__ __forceinline__ bool next(int,AttnUnit&u)const{
    if(threadIdx.x==0)*slot=__hip_atomic_fetch_add(head,1u,__ATOMIC_RELAXED,__HIP_MEMORY_SCOPE_AGENT);
    __syncthreads(); const unsigned j=*slot; __syncthreads();
    if(j>=512u)return false; u.bh=(int)(j&15u); u.qb=31-(int)(j>>4); return true; }
  __device__ __forceinline__ void a_ready(const AttnUnit&)const{}
  __device__ __forceinline__ void done(const AttnUnit&)const{}
};
template<class Sched,int THRL=8> __device__ __forceinline__ void attn_phase(char*lds,const AttnTensors&T,const Sched&S){
  AttnUnit u;
  for(int i=0;S.next(i,u);++i){ S.a_ready(u); attn_unit<THRL>(u.bh/NHEAD,u.bh%NHEAD,u.qb,T.Q,T.K,T.V,T.O,T.CP,T.NRM,lds); S.done(u); }
}
#undef SBAR
#undef WAIT_BAR
}

constexpr int NWAVES = 8;
constexpr int BATCH = 2, T = 8192, D = 1024, M = BATCH * T;
constexpr int NH = 8, DATT = 512, DCONV = 512, CWID = 31, NE = 32, TOPK = 4, DFF = 1024, DIN = 2568, NP1 = 2560;
constexpr int COL_F = 1536, COL_A = 1544, COL_G = 2056;
constexpr int CAP = 16384;
constexpr int MAXTILES = (M * TOPK) / 256 + NE;
constexpr float LOG2E = 1.4426950408889634f;
constexpr float W8_SCALE = 64.0f, HN8_SCALE = 8.0f, ACT8_SCALE = 4.0f, Y8_SCALE = 32.0f;
constexpr int MAXU = 12;

constexpr size_t MiB = 1u << 20;
constexpr size_t WS_CTL = 0, CTL_ZERO_BYTES = 1 * MiB;
constexpr size_t WS_WIN = 2 * MiB, WS_WO = 8 * MiB, WS_LF = 10 * MiB, WS_CP = 10 * MiB + 512 * 1024, WS_RMS = 11 * MiB + 512 * 1024  , WS_TOKINFO = 11 * MiB, WS_TOKIDX = 12 * MiB, WS_GATEW = 14 * MiB;
constexpr size_t WS_XN = 16 * MiB, WS_Q = 48 * MiB, WS_K = 64 * MiB, WS_V = 80 * MiB, WS_U = 96 * MiB, WS_MIX = 112 * MiB, WS_H1 = 144 * MiB, WS_HN = 208 * MiB;
constexpr size_t WS_WGU = 240 * MiB, WS_WD = 368 * MiB, WS_ACT = 432 * MiB, WS_Y = 576 * MiB, WS_END = 720 * MiB;
static_assert(WS_V - WS_K == WS_K - WS_Q && WS_ACT + (size_t)MAXTILES * 256 * 1024 * 2 <= WS_Y && WS_Y + (size_t)MAXTILES * 256 * 1024 * 2 <= WS_END, "d_ws map");
constexpr int CW_TMO = 0, CW_CODE = 1, CW_CNT = 64  , CW_BAR = 4096;
static_assert(CW_CNT + 64 * NE <= CW_BAR, "CTL words");
constexpr int CW_NRM = 16384  , CW_QHEAD = 24576  ;
constexpr int CW_CQ = CW_QHEAD + 64  ;
static_assert((CW_CQ + 256) * 4 <= (int)CTL_ZERO_BYTES, "CTL words inside the memset region");

constexpr int RING_OFF = 0, RING_BYTES = 131072;
constexpr int LDSCTL_OFF = RING_BYTES, MISC_OFF = LDSCTL_OFF;
constexpr int META_OFF = LDSCTL_OFF + 512;
constexpr int TOKL_OFF = LDSCTL_OFF + 2048;
constexpr int EPIL_OFF = TOKL_OFF + MAXU * 1024, EPIL_BYTES = 12288;
constexpr int LDS_BYTES = 163840;
static_assert(EPIL_OFF + EPIL_BYTES <= LDS_BYTES && 9 * 256 * 4 <= EPIL_BYTES && 6 * 512 * 4 <= EPIL_BYTES, "LDS map");

#define GAS __attribute__((address_space(1)))
#define LAS __attribute__((address_space(3)))
typedef unsigned short bf16;
typedef unsigned v4u __attribute__((ext_vector_type(4)));
typedef unsigned v2u __attribute__((ext_vector_type(2)));
typedef float f32x4 __attribute__((ext_vector_type(4)));
typedef GAS unsigned gu32;
#define RLX_AGENT __ATOMIC_RELAXED, __HIP_MEMORY_SCOPE_AGENT
#define LDS_WAIT() asm volatile("s_waitcnt lgkmcnt(0)" ::: "memory")
#define VM_WAIT() asm volatile("s_waitcnt vmcnt(0)" ::: "memory")
__device__ __forceinline__ unsigned f2bf(float f) { unsigned u = __builtin_bit_cast(unsigned, f); return (u + 0x7fffu + ((u >> 16) & 1u)) >> 16; }
__device__ __forceinline__ unsigned pk2(float lo, float hi) { return f2bf(lo) | (f2bf(hi) << 16); }
__device__ __forceinline__ float bf2f(unsigned short h) { return __builtin_bit_cast(float, (unsigned)h << 16); }
#define XB_TMO      128
#define XB_XCNT(j)  (256  + 64 * (j))
#define XB_XSUB(j)  (1280 + 64 * (j))
#define XB_XGEN(j)  (2304 + 64 * (j))
#define XB_TOP      3328
#define XB_TOPGEN   3392
#define XCD_BAR_WORDS 3456
#define XB_SPIN_CAP (1u << 18)

__device__ __forceinline__ unsigned xb_ld(unsigned* p)              { return __hip_atomic_load(p, __ATOMIC_RELAXED, __HIP_MEMORY_SCOPE_AGENT); }
__device__ __forceinline__ unsigned xb_add(unsigned* p, unsigned v) { return __hip_atomic_fetch_add(p, v, __ATOMIC_RELAXED, __HIP_MEMORY_SCOPE_AGENT); }
__device__ __forceinline__ unsigned xb_xcc_id() { return (unsigned)__builtin_amdgcn_s_getreg((3 << 11) | 20) & 0xFu; }
#define XB_SPIN(cond, bar) do { unsigned _sp = 0; while (cond) { __builtin_amdgcn_s_sleep(1); \
    if ((++_sp & 255u) == 0u) { if (xb_ld(&(bar)[XB_TMO])) break; if (_sp > XB_SPIN_CAP) { atomicAdd(&(bar)[XB_TMO], 1u); break; } } } } while (0)

struct XcdBarrier {
    unsigned* bar; unsigned x;
    volatile LAS unsigned* st;
};

__device__ __forceinline__ XcdBarrier xcd_barrier_post(unsigned* bar, volatile LAS unsigned* st) {
    XcdBarrier b; b.bar = bar; b.x = xb_xcc_id(); b.st = st;
    if (threadIdx.x == 0) (void)xb_add(&bar[XB_XCNT(b.x)], 1u);
    return b;
}
__device__ __forceinline__ void xcd_barrier_complete(unsigned* bar, unsigned x, unsigned& nloc, unsigned& nx) {
    const unsigned G = gridDim.x * gridDim.y * gridDim.z;
    unsigned sum, cnt, mine, sp = 0u;
    for (;;) {
        sum = 0u; cnt = 0u; mine = 0u;
#pragma unroll
        for (unsigned j = 0; j < 16; ++j) { const unsigned c = xb_ld(&bar[XB_XCNT(j)]); sum += c; cnt += (c > 0u) ? 1u : 0u; mine = (j == x) ? c : mine; }
        if (sum == G) break;
        __builtin_amdgcn_s_sleep(1);
        if ((++sp & 255u) == 0u) { if (xb_ld(&bar[XB_TMO])) break; if (sp > XB_SPIN_CAP) { atomicAdd(&bar[XB_TMO], 1u); break; } }
    }
    nloc = mine > 0u ? mine : 1u; nx = cnt > 0u ? cnt : 1u;
}

__device__ __forceinline__ void xcd_barrier(const XcdBarrier& b) {
    asm volatile("s_waitcnt vmcnt(0)" ::: "memory");
    __syncthreads();
    if (threadIdx.x == 0) {
        unsigned* bar = b.bar;
        __builtin_amdgcn_s_waitcnt(0);
        unsigned nloc = b.st[0], nx = b.st[1];
        if (nloc == 0u) { xcd_barrier_complete(bar, b.x, nloc, nx); b.st[0] = nloc; b.st[1] = nx; }
        const unsigned old = xb_add(&bar[XB_XSUB(b.x)], 1u);
        const unsigned gen = old / nloc;
        if (old + 1u == (gen + 1u) * nloc) {
            __builtin_amdgcn_fence(__ATOMIC_RELEASE, "agent");
            asm volatile("s_waitcnt vmcnt(0)" ::: "memory");
            const unsigned og = xb_add(&bar[XB_TOP], 1u);
            const unsigned tg = og / nx;
            if (og + 1u == (tg + 1u) * nx) xb_add(&bar[XB_TOPGEN], 1u);
            else XB_SPIN(xb_ld(&bar[XB_TOPGEN]) == tg, bar);
            __builtin_amdgcn_fence(__ATOMIC_ACQUIRE, "agent");
            xb_add(&bar[XB_XGEN(b.x)], 1u);
            asm volatile("s_waitcnt vmcnt(0)" ::: "memory");
        } else {
            XB_SPIN(xb_ld(&bar[XB_XGEN(b.x)]) == gen, bar);
            __builtin_amdgcn_fence(__ATOMIC_ACQUIRE, "agent");
            asm volatile("s_waitcnt vmcnt(0)" ::: "memory");
        }
    }
    __syncthreads();
}

struct Args {
    const float *x, *norm_mix_g, *w_in, *b_f, *b_glu, *w_dw, *b_dw, *ln_g, *ln_b, *w_out, *norm_ffn_g, *w_router, *b_router, *w_gu, *b_gu, *w_down, *b_down, *norm_final_g;
    float* out; unsigned char* ws; int ph_lo, ph_hi, li, pad;
};
struct Frame {
    LAS unsigned char* lds;
    volatile LAS unsigned* MISC;
    gu32* ctl;
    int tid, lane, wave, vcu, G;
};
__device__ __forceinline__ float wave_sum(float v) {
#pragma unroll
    for (int o = 1; o < 64; o <<= 1) v += __shfl_xor(v, o);
    return v;
}

__device__ __forceinline__ void p0_transpose_item(const float* W, int K, int N, int k0, int sc0, bf16* WTrow0, LAS float* scr, int lane) {
#pragma unroll 8
    for (int i = 0; i < 32; ++i) { const int kk = 2 * i + (lane >> 5); scr[kk * 33 + (lane & 31)] = __builtin_nontemporal_load(W + (size_t)(k0 + kk) * N + sc0 + (lane & 31)); }
    LDS_WAIT(); asm volatile("" ::: "memory");
    const int c = lane & 7;
#pragma unroll
    for (int j = 0; j < 4; ++j) { const int n = (lane >> 3) + 8 * j; const LAS float* s = scr + (8 * c) * 33 + n;
        v4u o; o.x = pk2(s[0 * 33], s[1 * 33]); o.y = pk2(s[2 * 33], s[3 * 33]); o.z = pk2(s[4 * 33], s[5 * 33]); o.w = pk2(s[6 * 33], s[7 * 33]);
        *(GAS v4u*)(WTrow0 + (size_t)n * K + k0 + 8 * c) = o; }
    LDS_WAIT(); asm volatile("" ::: "memory");
}
__device__ __forceinline__ void p0_transpose_item_f8(const float* W, int K, int N, int k0, int sc0, unsigned char* WTrow0, int lane, float sc) {
    const int kr = lane >> 3, c4 = lane & 7;
    const GAS f32x4* src = (const GAS f32x4*)(W + (size_t)(k0 + 16 * kr) * N + sc0 + 4 * c4);
    f32x4 v[16];
#pragma unroll
    for (int i = 0; i < 16; ++i) v[i] = __builtin_nontemporal_load(src + (size_t)i * (N / 4));
    __builtin_amdgcn_sched_barrier(0);
#pragma unroll
    for (int c = 0; c < 4; ++c) { v4u o;
        o.x = pg8::pk4_fp8(v[0][c] * sc, v[1][c] * sc, v[2][c] * sc, v[3][c] * sc); o.y = pg8::pk4_fp8(v[4][c] * sc, v[5][c] * sc, v[6][c] * sc, v[7][c] * sc);
        o.z = pg8::pk4_fp8(v[8][c] * sc, v[9][c] * sc, v[10][c] * sc, v[11][c] * sc); o.w = pg8::pk4_fp8(v[12][c] * sc, v[13][c] * sc, v[14][c] * sc, v[15][c] * sc);
        *(GAS v4u*)(WTrow0 + (size_t)(4 * c4 + c) * K + k0 + 16 * kr) = o; }
}
constexpr int P0_KB = D / 64, P0_KB8 = D / 128;
constexpr int P0_I_IN = P0_KB * (NP1 / 32), P0_I_O = P0_KB * (D / 32), P0_I_GU = NE * P0_KB8 * (2 * DFF / 32), P0_I_DN = NE * P0_KB8 * (D / 32);
constexpr int P0_NITEMS = P0_I_IN + P0_I_O + P0_I_GU + P0_I_DN;
__device__ __forceinline__ void p0_items(Frame& F, const Args& a, int first, int last, int gw, int NGW) {
    unsigned char* ws = a.ws;
    LAS float* scr = (LAS float*)(F.lds + RING_OFF + F.wave * 16384);
    bf16* Win_t = (bf16*)(ws + WS_WIN); bf16* Wo_t = (bf16*)(ws + WS_WO);
    constexpr int I_IN = P0_I_IN;
    for (int it = first + gw; it < last; it += NGW) {
        int r = it;
        if (r < I_IN) { const int nb = r % (NP1 / 32), kb = r / (NP1 / 32), n0 = nb * 32; int sc;
            if (n0 < 1536) sc = n0; else { const int j = (n0 - 1536) >> 8, i = (n0 - 1536) & 255; sc = (i < 128) ? (COL_A + 128 * j + i) : (COL_G + 128 * j + (i - 128)); }
            p0_transpose_item(a.w_in, D, DIN, kb * 64, sc, Win_t + (size_t)n0 * D, scr, F.lane); continue; }
        r -= I_IN;
        { const int nb = r % (D / 32), kb = r / (D / 32); p0_transpose_item(a.w_out, D, D, kb * 64, nb * 32, Wo_t + (size_t)nb * 32 * D, scr, F.lane); }
    }
}
__device__ __forceinline__ void p0_item_f8(const Args& a, int r, int lane) {
    if (r < P0_I_GU) { const int per = P0_KB8 * (2 * DFF / 32), e = r / per, q = r % per, nb = q % (2 * DFF / 32), kb = q / (2 * DFF / 32), n0 = nb * 32;
        const int pl = n0 >> 8, i = n0 & 255, sc = (i < 128) ? (128 * pl + i) : (DFF + 128 * pl + (i - 128));
        p0_transpose_item_f8(a.w_gu + (size_t)e * D * 2 * DFF, D, 2 * DFF, kb * 128, sc, a.ws + WS_WGU + ((size_t)e * 2 * DFF + n0) * D, lane, W8_SCALE); }
    else { r -= P0_I_GU; const int per = P0_KB8 * (D / 32), e = r / per, q = r % per, nb = q % (D / 32), kb = q / (D / 32);
        p0_transpose_item_f8(a.w_down + (size_t)e * DFF * D, DFF, D, kb * 128, nb * 32, a.ws + WS_WD + ((size_t)e * D + nb * 32) * DFF, lane, W8_SCALE); }
}
__device__ __forceinline__ void conv_pull(Frame& F, const Args& a, int cw, int first, int last) {
    for (;;) {
        unsigned it = 0;
        if (F.lane == 0) it = __hip_atomic_fetch_add((unsigned*)(F.ctl + cw), 2u, __ATOMIC_RELAXED, __HIP_MEMORY_SCOPE_AGENT);
        const int r = first + (int)__builtin_amdgcn_readfirstlane(it);
        if (r >= last) break;
        p0_item_f8(a, r, F.lane); if (r + 1 < last) p0_item_f8(a, r + 1, F.lane);
    }
}
__device__ __forceinline__ void conv_static(Frame& F, const Args& a, int first, int last, int gw, int NGW) {
    for (int it = first + gw; it < last; it += NGW) p0_item_f8(a, it, F.lane);
}
__device__ __forceinline__ void p0_prologue(Frame& F, const Args& a) {
    unsigned char* ws = a.ws;
    const int gw = F.vcu * NWAVES + F.wave, NGW = F.G * NWAVES;
    p0_items(F, a, 0, P0_I_IN + P0_I_O, gw, NGW);
    __syncthreads();
    LAS float* wf = (LAS float*)(F.lds + RING_OFF);
    for (int i = F.tid; i < D * NH; i += NWAVES * 64) { const int k = i >> 3, h = i & 7; wf[h * D + k] = a.w_in[(size_t)k * DIN + COL_F + h]; }
    __syncthreads();
    bf16* XN = (bf16*)(ws + WS_XN); float* LF = (float*)(ws + WS_LF);
    f32x4 gv[4];
#pragma unroll
    for (int j = 0; j < 4; ++j) gv[j] = ((const GAS f32x4*)a.norm_mix_g)[F.lane + 64 * j];
    for (int m = gw; m < M; m += NGW) {
        const GAS f32x4* xr = (const GAS f32x4*)(a.x + (size_t)m * D) + F.lane;
        f32x4 v[4]; float s = 0.f;
#pragma unroll
        for (int j = 0; j < 4; ++j) { v[j] = xr[64 * j]; s += (v[j].x * v[j].x + v[j].y * v[j].y) + (v[j].z * v[j].z + v[j].w * v[j].w); }
        const float ms = wave_sum(s) * (1.f / D) + 1e-6f, rs = 1.0f / sqrtf(ms);
        if (F.lane == 0) ((float*)(ws + WS_RMS))[m] = sqrtf(ms);
#pragma unroll
        for (int j = 0; j < 4; ++j) v[j] = v[j] * rs * gv[j];
        GAS unsigned long long* o8 = (GAS unsigned long long*)(XN + (size_t)m * D) + F.lane;
#pragma unroll
        for (int j = 0; j < 4; ++j) o8[64 * j] = (unsigned long long)pk2(v[j].x, v[j].y) | ((unsigned long long)pk2(v[j].z, v[j].w) << 32);
        float fl[NH];
#pragma unroll
        for (int h = 0; h < NH; ++h) { float acc = 0.f;
#pragma unroll
            for (int j = 0; j < 4; ++j) { const f32x4 w = *(const LAS f32x4*)(wf + h * D + 4 * F.lane + 256 * j); acc += (v[j].x * w.x + v[j].y * w.y) + (v[j].z * w.z + v[j].w * w.w); }
            fl[h] = wave_sum(acc); }
        if (F.lane < NH) { float z = fl[0];
#pragma unroll
            for (int h = 1; h < NH; ++h) z = (F.lane == h) ? fl[h] : z;
            z += a.b_f[F.lane];
            const float ls = fminf(z, 0.f) - log1pf(expf(-fabsf(z)));
            const int b = m / T, t = m % T;
            LF[(size_t)(b * NH + F.lane) * T + t] = ls; }
    }
}
__device__ __forceinline__ void scan_bh(Frame& F, const float* LF, float* CP, int bh) {
    LAS double* wtot = (LAS double*)(F.lds + RING_OFF);
    const GAS f32x4* src = (const GAS f32x4*)(LF + (size_t)bh * T) + F.tid * 4;
    f32x4 v[4];
#pragma unroll
    for (int j = 0; j < 4; ++j) v[j] = src[j];
    double pre[16]; double run = 0.0;
#pragma unroll
    for (int j = 0; j < 4; ++j)
#pragma unroll
        for (int c = 0; c < 4; ++c) { run += (double)v[j][c]; pre[j * 4 + c] = run; }
    double inc = run;
#pragma unroll
    for (int o = 1; o < 64; o <<= 1) { const double up = __shfl_up(inc, o); if (F.lane >= o) inc += up; }
    if (F.lane == 63) wtot[F.wave] = inc;
    __syncthreads();
    double base = inc - run;
    for (int w = 0; w < F.wave; ++w) base += wtot[w];
    GAS f32x4* dst = (GAS f32x4*)(CP + (size_t)bh * T) + F.tid * 4;
#pragma unroll
    for (int j = 0; j < 4; ++j) { f32x4 o;
#pragma unroll
        for (int c = 0; c < 4; ++c) o[c] = (float)((base + pre[j * 4 + c]) * (double)LOG2E);
        dst[j] = o; }
    __syncthreads();
}

__device__ __forceinline__ void conv_phase(Frame& F, const Args& a, int blk, int grp0, int grp1) {
    const bf16* U = (const bf16*)(a.ws + WS_U); bf16* MIX = (bf16*)(a.ws + WS_MIX);
    LAS float* yl = (LAS float*)(F.lds + RING_OFF);
    LAS float* st = (LAS float*)(F.lds + RING_OFF + 65536);
    int ch = threadIdx.x; asm volatile("" : "+v"(ch));
    const int clane = ch & 63, cwave = __builtin_amdgcn_readfirstlane(ch >> 6);
    float w[CWID];
#pragma unroll
    for (int j = 0; j < CWID; ++j) w[j] = a.w_dw[j * DCONV + ch];
    const float bdw = a.b_dw[ch], lg = a.ln_g[ch], lb = a.ln_b[ch];
    for (int grp = grp0; grp < grp1; ++grp) {
        const int n0 = blk * 64 + grp * 32, t0 = n0 % T;
        unsigned short raw[CWID - 1 + 32];
#pragma unroll
        for (int i = 0; i < CWID - 1 + 32; ++i) { const int ts = t0 - (CWID - 1) + i; const int rowc = (ts >= 0) ? (n0 - (CWID - 1) + i) : n0;
            raw[i] = U[(size_t)rowc * DCONV + ch]; }
        __builtin_amdgcn_sched_barrier(0);
        float uin[CWID - 1 + 32];
#pragma unroll
        for (int i = 0; i < CWID - 1 + 32; ++i) { const int ts = t0 - (CWID - 1) + i; uin[i] = (ts >= 0) ? bf2f(raw[i]) : 0.f; }
        float y[32];
#pragma unroll
        for (int o = 0; o < 32; ++o) { float acc = bdw;
#pragma unroll
            for (int j = 0; j < CWID; ++j) acc = fmaf(w[j], uin[o + j], acc);
            y[o] = acc; yl[o * DCONV + ch] = acc; }
        __syncthreads();
#pragma unroll
        for (int q = 0; q < 4; ++q) { const int o = cwave * 4 + q;
            const f32x4 p0 = *(const LAS f32x4*)(yl + o * DCONV + 4 * clane), p1 = *(const LAS f32x4*)(yl + o * DCONV + 256 + 4 * clane);
            const float mu = wave_sum((p0.x + p0.y) + (p0.z + p0.w) + (p1.x + p1.y) + (p1.z + p1.w)) * (1.f / DCONV);
            const f32x4 d0 = p0 - mu, d1 = p1 - mu;
            const float var = wave_sum((d0.x * d0.x + d0.y * d0.y) + (d0.z * d0.z + d0.w * d0.w) + (d1.x * d1.x + d1.y * d1.y) + (d1.z * d1.z + d1.w * d1.w)) * (1.f / DCONV);
            if (clane == 0) { st[2 * o] = mu; st[2 * o + 1] = 1.0f / sqrtf(var + 1e-5f); } }
        __syncthreads();
#pragma unroll
        for (int o = 0; o < 32; ++o) { const float z = (y[o] - st[2 * o]) * st[2 * o + 1] * lg + lb; const float sw = z * pg8::sigmoid_f(z);
            MIX[(size_t)(n0 + o) * D + DATT + ch] = (bf16)f2bf(sw); }
        __syncthreads();
    }
}

#define RT_SWZ(col) ((((col) & 7) ^ ((((col) >> 3) & 1) << 2)))
__device__ __forceinline__ void router_table(Frame& F, const Args& a) {
    LAS unsigned char* tbl = F.lds + RING_OFF;
    { f32x4 wv[16]; float gg[16];
#pragma unroll
      for (int i = 0; i < 16; ++i) { const int f = F.tid + 512 * i; wv[i] = ((const GAS f32x4*)a.w_router)[f]; gg[i] = a.norm_ffn_g[f >> 3]; }
      __builtin_amdgcn_sched_barrier(0);
#pragma unroll
      for (int i = 0; i < 16; ++i) { const int f = F.tid + 512 * i, col = f >> 3, e4 = f & 7; *(LAS f32x4*)(tbl + col * 128 + ((e4 ^ RT_SWZ(col)) << 4)) = wv[i] * gg[i]; } }
}
__device__ __forceinline__ void router_phase(Frame& F, const Args& a, int blk, size_t dry  ) {
    const bf16* H1 = (const bf16*)(a.ws + WS_H1); unsigned char* HN = a.ws + WS_HN + dry;
    int* tokinfo = (int*)(a.ws + WS_TOKINFO + dry); int* tokidx = (int*)(a.ws + WS_TOKIDX + dry); float* gatew = (float*)(a.ws + WS_GATEW + dry);
    int* gcnt = (int*)(F.ctl + CW_CNT) + (dry ? 32 : 0);
    LAS unsigned char* tbl = F.lds + RING_OFF;
    LAS int* lcnt = (LAS int*)(F.lds + META_OFF) + 32 + 32 + 33 + 33 + 33;
    LAS int* lbase = lcnt + 32;
    LAS float* part = (LAS float*)(F.lds + TOKL_OFF);
    LAS float* ssp = part + 4 * 8 * 64;
    LAS float* rsl = ssp + 64;
    if (F.tid < 32) lcnt[F.tid] = 0;
    __syncthreads();
    const int rg = F.wave & 3, kh = F.wave >> 2, r16 = F.lane & 15, kq = F.lane >> 4;
    f32x4 c0 = {0.f, 0.f, 0.f, 0.f}, c1 = {0.f, 0.f, 0.f, 0.f}; float ss = 0.f;
    {
        const bf16* hp = H1 + (size_t)(blk * 64 + rg * 16 + r16) * D + kh * 512 + kq * 8;
        const int e4a = r16 >> 2, e4b = 4 + (r16 >> 2), wi = (r16 & 3) * 4;
        v4u avv[16];
#pragma unroll
        for (int j = 0; j < 16; ++j) avv[j] = *(const v4u*)(hp + 32 * j);
        __builtin_amdgcn_sched_barrier(0);
#pragma unroll
        for (int j = 0; j < 16; ++j) {
#pragma unroll
            for (int c = 0; c < 8; ++c) { const unsigned wv = avv[j][c >> 1]; const float av = __builtin_bit_cast(float, (c & 1) ? (wv & 0xffff0000u) : (wv << 16));
                ss += av * av;
                const int k = kh * 512 + 32 * j + 8 * kq + c; const LAS unsigned char* rp = tbl + k * 128 + wi; const int sw = RT_SWZ(k);
                const float b0 = *(const LAS float*)(rp + ((e4a ^ sw) << 4)), b1 = *(const LAS float*)(rp + ((e4b ^ sw) << 4));
                c0 = __builtin_amdgcn_mfma_f32_16x16x4f32(av, b0, c0, 0, 0, 0); c1 = __builtin_amdgcn_mfma_f32_16x16x4f32(av, b1, c1, 0, 0, 0); } }
    }
    ss += __shfl_xor(ss, 16); ss += __shfl_xor(ss, 32);
    if (kh == 1) {
#pragma unroll
        for (int i = 0; i < 4; ++i) { part[(rg * 8 + i) * 64 + F.lane] = c0[i]; part[(rg * 8 + 4 + i) * 64 + F.lane] = c1[i]; }
        if (F.lane < 16) ssp[rg * 16 + F.lane] = ss;
    }
    __syncthreads();
    int pe = 0, plr = 0; float pw = 0.f;
    if (kh == 0) {
#pragma unroll
        for (int i = 0; i < 4; ++i) { c0[i] += part[(rg * 8 + i) * 64 + F.lane]; c1[i] += part[(rg * 8 + 4 + i) * 64 + F.lane]; }
        if (F.lane < 16) rsl[rg * 16 + F.lane] = 1.0f / sqrtf((ss + ssp[rg * 16 + F.lane]) * (1.f / D) + 1e-6f);
        LDS_WAIT(); asm volatile("" ::: "memory");
        const float ba = a.b_router[r16], bb = a.b_router[16 + r16];
#pragma unroll
        for (int i = 0; i < 4; ++i) {
            const float rs = rsl[rg * 16 + 4 * kq + i];
            float za = c0[i] * rs + ba, zb = c1[i] * rs + bb;
            int idx[TOPK]; float val[TOPK];
#pragma unroll
            for (int k = 0; k < TOPK; ++k) { float bv = za; int bi = r16; if (zb > za) { bv = zb; bi = 16 + r16; }
#pragma unroll
                for (int o = 8; o > 0; o >>= 1) { const float ov = __shfl_xor(bv, o); const int oi = __shfl_xor(bi, o); if (ov > bv || (ov == bv && oi < bi)) { bv = ov; bi = oi; } }
                idx[k] = bi; val[k] = bv; if (bi == r16) za = -INFINITY; if (bi == 16 + r16) zb = -INFINITY; }
            float ex[TOPK], den = 0.f;
#pragma unroll
            for (int k = 0; k < TOPK; ++k) { ex[k] = __expf(val[k] - val[0]); den += ex[k]; }
            const float inv = 1.0f / den;
#pragma unroll
            for (int k = 0; k < TOPK; ++k) if (r16 == 4 * i + k) { pe = idx[k]; pw = ex[k] * inv; }
        }
        plr = __hip_atomic_fetch_add(&lcnt[pe], 1, __ATOMIC_RELAXED, __HIP_MEMORY_SCOPE_WORKGROUP);
    }
    __syncthreads();
    if (F.tid < 32) lbase[F.tid] = (int)__hip_atomic_fetch_add(gcnt + 64 * F.tid, lcnt[F.tid], RLX_AGENT);
    __syncthreads();
    if (kh == 0) { const int rank = lbase[pe] + plr, row = blk * 64 + rg * 16 + (F.lane >> 2), k = F.lane & 3;
        tokinfo[row * TOPK + k] = pe * CAP + rank; tokidx[pe * CAP + rank] = row; gatew[pe * CAP + rank] = pw; }
    f32x4 gv[4];
#pragma unroll
    for (int j = 0; j < 4; ++j) gv[j] = ((const GAS f32x4*)a.norm_ffn_g)[F.lane + 64 * j];
    for (int rb = 0; rb < 2; ++rb) { f32x4 hv[4][4];
#pragma unroll
        for (int rr = 0; rr < 4; ++rr) { const GAS v2u* hr = (const GAS v2u*)(H1 + (size_t)(blk * 64 + F.wave * 8 + rb * 4 + rr) * D) + F.lane;
#pragma unroll
            for (int j = 0; j < 4; ++j) { const v2u p = hr[64 * j]; hv[rr][j] = (f32x4){__builtin_bit_cast(float, p.x << 16), __builtin_bit_cast(float, p.x & 0xffff0000u), __builtin_bit_cast(float, p.y << 16), __builtin_bit_cast(float, p.y & 0xffff0000u)}; } }
        __builtin_amdgcn_sched_barrier(0);
#pragma unroll
        for (int rr = 0; rr < 4; ++rr) { const int lr = F.wave * 8 + rb * 4 + rr, row = blk * 64 + lr; const float rs = rsl[lr];
            GAS unsigned* o4 = (GAS unsigned*)(HN + (size_t)row * D) + F.lane;
#pragma unroll
            for (int j = 0; j < 4; ++j) { const f32x4 v = hv[rr][j] * (rs * HN8_SCALE) * gv[j]; o4[64 * j] = pg8::pk4_fp8(v.x, v.y, v.z, v.w); } } }
    __syncthreads();
}
__device__ __forceinline__ void moe_meta(Frame& F) {
    LAS int* meta = (LAS int*)(F.lds + META_OFF);
    if (F.tid < 32) { const int c = (int)__hip_atomic_load((int*)(F.ctl + CW_CNT) + 64 * F.tid, RLX_AGENT); meta[F.tid] = c; meta[32 + F.tid] = (c + 255) >> 8; }
    __syncthreads();
    if (F.tid == 0) { int o = 0; for (int e = 0; e < 32; ++e) { meta[64 + e] = o; meta[97 + e] = o * 8; meta[130 + e] = o * 4; o += meta[32 + e]; } meta[64 + 32] = o; meta[97 + 32] = o * 8; meta[130 + 32] = o * 4; }
    __syncthreads();
}

__device__ __forceinline__ void final_phase(Frame& F, const Args& a, int blk) {
    const bf16* H1 = (const bf16*)(a.ws + WS_H1); const unsigned char* Y = a.ws + WS_Y; const int* tokinfo = (const int*)(a.ws + WS_TOKINFO);
    const LAS int* tileoff = (const LAS int*)(F.lds + META_OFF) + 64;
    f32x4 gv[4];
#pragma unroll
    for (int j = 0; j < 4; ++j) gv[j] = ((const GAS f32x4*)a.norm_final_g)[F.lane + 64 * j];
    for (int rr = 0; rr < 8; ++rr) {
        const int row = blk * 64 + F.wave * 8 + rr;
        const GAS v2u* hr = (const GAS v2u*)(H1 + (size_t)row * D) + F.lane;
        f32x4 v[4];
#pragma unroll
        for (int j = 0; j < 4; ++j) { const v2u p = __builtin_nontemporal_load(hr + 64 * j); v[j] = (f32x4){__builtin_bit_cast(float, p.x << 16), __builtin_bit_cast(float, p.x & 0xffff0000u), __builtin_bit_cast(float, p.y << 16), __builtin_bit_cast(float, p.y & 0xffff0000u)}; }
#pragma unroll
        for (int k = 0; k < TOPK; ++k) { const int info = tokinfo[row * TOPK + k], e = info >> 14, rank = info & (CAP - 1);
            const GAS unsigned* yr = (const GAS unsigned*)(Y + ((size_t)tileoff[e] * 256 + rank) * D) + F.lane;
#pragma unroll
            for (int j = 0; j < 4; ++j) { const unsigned p = __builtin_nontemporal_load(yr + 64 * j);
                const auto lo2 = __builtin_amdgcn_cvt_pk_f32_fp8((int)p, false), hi2 = __builtin_amdgcn_cvt_pk_f32_fp8((int)p, true);
                v[j].x += lo2[0] * (1.0f / Y8_SCALE); v[j].y += lo2[1] * (1.0f / Y8_SCALE); v[j].z += hi2[0] * (1.0f / Y8_SCALE); v[j].w += hi2[1] * (1.0f / Y8_SCALE); } }
        float s = 0.f;
#pragma unroll
        for (int j = 0; j < 4; ++j) s += (v[j].x * v[j].x + v[j].y * v[j].y) + (v[j].z * v[j].z + v[j].w * v[j].w);
        const float rs = 1.0f / sqrtf(wave_sum(s) * (1.f / D) + 1e-6f);
        GAS f32x4* orow = (GAS f32x4*)(a.out + (size_t)row * D) + F.lane;
#pragma unroll
        for (int j = 0; j < 4; ++j) __builtin_nontemporal_store(v[j] * rs * gv[j], orow + 64 * j);
    }
}

constexpr int NPHASE = 8;
__global__ void __launch_bounds__(NWAVES * 64, 2) mega_fwd(Args args) {
    extern __shared__ __attribute__((aligned(16))) unsigned char lds[];
    Frame F;
    F.lds = (LAS unsigned char*)lds;
    F.MISC = (volatile LAS unsigned*)(F.lds + MISC_OFF);
    F.tid = threadIdx.x; F.lane = F.tid & 63; F.wave = __builtin_amdgcn_readfirstlane(F.tid >> 6);
    F.G = gridDim.x; { const int bx = blockIdx.x; F.vcu = (F.G % 8 == 0) ? (bx % 8) * (F.G / 8) + bx / 8 : bx; }
    unsigned char* ws = args.ws;
    F.ctl = (gu32*)(ws + WS_CTL);
    for (int u = F.tid; u < 512 / 4; u += NWAVES * 64) ((LAS unsigned*)(F.lds + LDSCTL_OFF))[u] = 0u;
    __syncthreads();
    const int lo = args.ph_lo, hi = args.ph_hi;
    XcdBarrier bar; bar.bar = (unsigned*)(F.ctl + CW_BAR); bar.x = 0; bar.st = nullptr;
    if (hi - lo > 1) bar = xcd_barrier_post((unsigned*)(F.ctl + CW_BAR) + args.li * XCD_BAR_WORDS, F.MISC + 8);
#ifdef MK_ONLY
#define IN(k) ((k) == MK_ONLY && lo <= (k) && (k) < hi)
#else
#define IN(k) (lo <= (k) && (k) < hi)
#endif
#define BOTH(k) (IN(k) && IN((k) + 1))
#define GRID_BAR() xcd_barrier(bar)
#define REFRESH() do { int t_ = threadIdx.x; asm volatile("" : "+v"(t_)); F.tid = t_; F.lane = t_ & 63; F.wave = __builtin_amdgcn_readfirstlane(t_ >> 6); } while (0)
    const int blk = blockIdx.x;

    if (IN(0)) {
        REFRESH();
        p0_prologue(F, args);
        if (BOTH(0)) GRID_BAR();
    }

    if (IN(1)) {
        REFRESH();
#ifndef NO_SCAN
        if (blk >= F.G - 16) scan_bh(F, (const float*)(ws + WS_LF), (float*)(ws + WS_CP), blk - (F.G - 16));
#endif
        pg8::Gemm g{ws + WS_XN, ws + WS_WIN, M, NP1, D, 2 * D}; pg8::StaticOrder S; S.init(M, NP1, F.G, blk);
        LAS float* epil = (LAS float*)(F.lds + EPIL_OFF);
        for (int i = F.tid; i < 2 * DCONV; i += NWAVES * 64) epil[i] = args.b_glu[i];
        __syncthreads();
        pg8::EpiProj E{(bf16*)(ws + WS_Q), (bf16*)(ws + WS_U), (size_t)(WS_K - WS_Q) / 2, epil, 0.125f * LOG2E, (unsigned*)(F.ctl + CW_NRM)};
        pg8::gemm_phase<pg8::EpiProj, pg8::StaticOrder, true, false, false>(F.lds + RING_OFF, g, S, E, nullptr);
        if (blk >= 128 && F.G == 256) conv_static(F, args, 0, MK_L1, (blk - 128) * NWAVES + F.wave, 128 * NWAVES);
        else if (F.G != 256) conv_static(F, args, 0, MK_L1, F.vcu * NWAVES + F.wave, F.G * NWAVES);
        if (BOTH(1)) GRID_BAR();
#ifdef MK_XBAR
        if (BOTH(1)) { GRID_BAR(); GRID_BAR(); GRID_BAR(); GRID_BAR(); }
#endif
    }

    if (IN(2)) {
        REFRESH();
        const attn_body::AttnTensors AT{(const attn_body::bf16*)(ws + WS_Q), (const attn_body::bf16*)(ws + WS_K), (const attn_body::bf16*)(ws + WS_V), (attn_body::bf16*)(ws + WS_MIX), (const float*)(ws + WS_CP), (const unsigned*)(F.ctl + CW_NRM)};
        volatile unsigned* slot = (volatile unsigned*)(lds + MISC_OFF + 64);
        { constexpr int c = MK_NCONV / 8; const int r = blk >> 3, sel = ((r + 1) * c) / 32 - (r * c) / 32;
          if (sel) conv_static(F, args, MK_L1, MK_DNP5 ? P0_I_GU : P0_I_GU + P0_I_DN, (((r * c) / 32) * 8 + (blk & 7)) * NWAVES + F.wave, MK_NCONV * NWAVES); }
        for (;;) {
            if (threadIdx.x == 0) *slot = __hip_atomic_fetch_add((unsigned*)(F.ctl + CW_QHEAD), 1u, __ATOMIC_RELAXED, __HIP_MEMORY_SCOPE_AGENT);
            __syncthreads(); const unsigned j = __builtin_amdgcn_readfirstlane(*slot); __syncthreads();
            if (j >= 512u + (unsigned)(M / 32)) break;
            if (j < 512u) { const int bh = (int)(j & 15u), qb = 31 - (int)(j >> 4); attn_body::attn_unit<8>(bh / NH, bh % NH, qb, AT.Q, AT.K, AT.V, AT.O, AT.CP, AT.NRM, (char*)lds + RING_OFF); }
            else { const int cj = (int)(j - 512u); conv_phase(F, args, cj >> 1, cj & 1, (cj & 1) + 1); }
        }
        if (BOTH(2)) GRID_BAR();
    }

    if (IN(3)) {
        REFRESH();
        pg8::Gemm g{ws + WS_MIX, ws + WS_WO, M, D, D, 2 * D}; pg8::StaticOrder S; S.init(M, D, F.G, blk);
        pg8::EpiH1 E{(const bf16*)(ws + WS_XN), (const float*)(ws + WS_RMS), args.norm_mix_g, (bf16*)(ws + WS_H1)};
        pg8::gemm_phase<pg8::EpiH1, pg8::StaticOrder, true, false, false>(F.lds + RING_OFF, g, S, E, nullptr);
        if (IN(4)) router_table(F, args);
        if (BOTH(3)) GRID_BAR();
    }

    if (IN(4)) {
        REFRESH();
        if (!IN(3)) router_table(F, args);
        router_phase(F, args, blk, 0);
        if (BOTH(4)) GRID_BAR();
    }

    if (IN(5)) {
        REFRESH();
        moe_meta(F);
        const LAS int* meta = (const LAS int*)(F.lds + META_OFF);
        LAS int* tokl = (LAS int*)(F.lds + TOKL_OFF);
        pg8::MoeOrder S{meta[97 + 32], F.G, blk, 8, meta + 97, meta + 32, meta + 64};
        { pg8::Unit u; const int* tokidx = (const int*)(ws + WS_TOKIDX);
          LAS float* epil = (LAS float*)(F.lds + EPIL_OFF);
          for (int ui = 0; ui < MAXU && S.next(ui, u); ++ui) { if (F.tid < 256) { const int r = u.rt * 256 + F.tid; tokl[ui * 256 + F.tid] = (r < meta[u.e]) ? tokidx[u.e * CAP + r] : 0; }
              else { const int t = F.tid - 256, pl = u.pn & 7; epil[ui * 256 + t] = args.b_gu[(size_t)u.e * 2048 + ((t < 128) ? (128 * pl + t) : (DFF + 128 * pl + (t - 128)))]; } } }
        __syncthreads();
        pg8::Gemm g{ws + WS_HN, ws + WS_WGU, M, 2 * DFF, D, D};
        pg8::EpiGU E{ws + WS_ACT, (const LAS float*)(F.lds + EPIL_OFF), 1.0f / (HN8_SCALE * W8_SCALE), ACT8_SCALE};
        pg8::gemm_phase<pg8::EpiGU, pg8::MoeOrder, MK_ALIGN5, true, true>(F.lds + RING_OFF, g, S, E, tokl);
        if (MK_DNP5) conv_pull(F, args, CW_CQ + 128, P0_I_GU, P0_I_GU + P0_I_DN);
        if (BOTH(5)) GRID_BAR();
    }

    if (IN(6)) {
        REFRESH();
        if (!IN(5)) moe_meta(F);
        const LAS int* meta = (const LAS int*)(F.lds + META_OFF);
        pg8::MoeOrder S{meta[130 + 32], F.G, blk, 4, meta + 130, meta + 32, meta + 64};
        LAS int* tokl = (LAS int*)(F.lds + TOKL_OFF);
        { pg8::Unit u; LAS float* epil = (LAS float*)(F.lds + EPIL_OFF); const float* gatew = (const float*)(ws + WS_GATEW);
          for (int ui = 0; ui < 6 && S.next(ui, u); ++ui) { if (F.tid < 256) { tokl[ui * 256 + F.tid] = u.pm * 256 + F.tid; epil[ui * 512 + F.tid] = args.b_down[(size_t)u.e * 1024 + (u.pn & 3) * 256 + F.tid]; }
              else { const int r = u.rt * 256 + (F.tid - 256); epil[ui * 512 + F.tid] = (r < meta[u.e]) ? gatew[(size_t)u.e * CAP + r] * Y8_SCALE : 0.0f; } } }
        __syncthreads();
        pg8::Gemm g{ws + WS_ACT, ws + WS_WD, M, D, DFF, DFF};
        pg8::EpiDown E{ws + WS_Y, (const LAS float*)(F.lds + EPIL_OFF), 1.0f / (ACT8_SCALE * W8_SCALE)};
        pg8::gemm_phase<pg8::EpiDown, pg8::MoeOrder, MK_ALIGN6, true, true>(F.lds + RING_OFF, g, S, E, tokl);
        if (BOTH(6)) GRID_BAR();
    }

    if (IN(7)) {
        REFRESH();
        if (!IN(6)) moe_meta(F);
        final_phase(F, args, blk);
    }
#undef IN
#undef BOTH
#undef GRID_BAR
}

#ifndef MK_STAGE
#define MK_STAGE 0
#endif
#ifndef MK_SPLIT
#define MK_SPLIT 0
#endif

#if MK_STAGE != 0
#endif

extern "C" void kernel_launch(void* const* d_in, const int* in_sizes, int n_in, void* d_out, int out_size, void* d_ws, size_t ws_size, hipStream_t stream) {
    static int grid = 0;
    if (grid == 0) {
        if (n_in != 18 || in_sizes[0] != M * D || out_size != M * D || ws_size < (size_t)1024 * MiB) { fprintf(stderr, "kernel_launch: unexpected shapes / workspace (n_in %d, ws %zu); nothing launched\n", n_in, ws_size); grid = -1; return; }
        int dev = 0, cus = 0, per_cu = 0;
        if (hipGetDevice(&dev) != hipSuccess || hipDeviceGetAttribute(&cus, hipDeviceAttributeMultiprocessorCount, dev) != hipSuccess) { grid = -1; return; }
        if (hipFuncSetAttribute((const void*)mega_fwd, hipFuncAttributeMaxDynamicSharedMemorySize, LDS_BYTES) != hipSuccess) { fprintf(stderr, "kernel_launch: hipFuncSetAttribute failed\n"); grid = -1; return; }
        if (hipOccupancyMaxActiveBlocksPerMultiprocessor(&per_cu, (const void*)mega_fwd, NWAVES * 64, LDS_BYTES) != hipSuccess || per_cu < 1) { fprintf(stderr, "kernel_launch: occupancy query says %d workgroups per CU\n", per_cu); }
        (void)hipGetLastError();
        grid = cus;
        if (grid != 256) { fprintf(stderr, "kernel_launch: built for a 256-CU device, found %d CUs; nothing launched\n", cus); grid = -1; return; }
    }
    if (grid < 0) return;
    if (hipMemsetAsync((char*)d_ws + WS_CTL, 0, CTL_ZERO_BYTES, stream) != hipSuccess) return;
    Args a{};
    a.x = (const float*)d_in[0]; a.norm_mix_g = (const float*)d_in[1]; a.w_in = (const float*)d_in[2]; a.b_f = (const float*)d_in[3]; a.b_glu = (const float*)d_in[4];
    a.w_dw = (const float*)d_in[5]; a.b_dw = (const float*)d_in[6]; a.ln_g = (const float*)d_in[7]; a.ln_b = (const float*)d_in[8]; a.w_out = (const float*)d_in[9];
    a.norm_ffn_g = (const float*)d_in[10]; a.w_router = (const float*)d_in[11]; a.b_router = (const float*)d_in[12]; a.w_gu = (const float*)d_in[13]; a.b_gu = (const float*)d_in[14];
    a.w_down = (const float*)d_in[15]; a.b_down = (const float*)d_in[16]; a.norm_final_g = (const float*)d_in[17];
    a.out = (float*)d_out; a.ws = (unsigned char*)d_ws; a.pad = 0;
    const int ph_end = (MK_STAGE == 0) ? NPHASE : (MK_STAGE + 1);
#if defined(MK_PREFILL)
    (void)hipMemsetAsync((char*)d_ws + WS_MIX, 0xFF, (size_t)M * D * 2, stream);
#endif
#if MK_SPLIT
    for (int p = 0; p < ph_end; ++p) { a.ph_lo = p; a.ph_hi = p + 1; a.li = p; hipLaunchKernelGGL(mega_fwd, dim3(grid), dim3(NWAVES * 64), LDS_BYTES, stream, a); }
#else
    a.ph_lo = 0; a.ph_hi = ph_end; a.li = 0;
    hipLaunchKernelGGL(mega_fwd, dim3(grid), dim3(NWAVES * 64), LDS_BYTES, stream, a);
#endif
#if MK_STAGE != 0
    orc::finish(MK_STAGE, a, stream);
#endif
}
```

```cpp
#include <hip/hip_runtime.h>
#include <hip/hip_bf16.h>
#include <cstdio>
#include <cstdint>
#include <cmath>
#define MK_VARIANT 0
#define MK_DBGSTAT 0
#define MK_ROWA 32
#define MK_ROWB 64
#define MK_NCONV 96
#define MK_DNP5 0
#define MK_L1 0
#define PG8_BAUX 0
#define MK_CONVSPLIT 0
#define MK_ALIGN5 true
#define MK_ALIGN6 true
namespace pg8 {
#define PG8_LAS __attribute__((address_space(3)))
typedef unsigned short bf16_t;
typedef short bf16x8 __attribute__((ext_vector_type(8)));
typedef float f32x4 __attribute__((ext_vector_type(4)));
typedef unsigned u32x4 __attribute__((ext_vector_type(4)));
constexpr int BM = 256, BK = 64, HALF = 128, HTB = HALF * BK * 2  , STAGE_BYTES = 8 * HTB, NXCD = 8, WGM = 8;

__host__ __device__ __forceinline__ int lds_byte(int r, int c) { const int st = (r >> 4) * 2 + (c >> 5), rr = r & 15, cc = c & 31, ob = rr * 64 + cc * 2; return st * 1024 + (ob ^ (((ob >> 9) & 1) << 5)); }
__host__ __device__ __forceinline__ void stage_rc(int b, int& R, int& C) { const int st = b / 1024, sb = b % 1024, swz = sb ^ (((sb >> 9) & 1) << 5); R = (st >> 1) * 16 + swz / 64; C = (st & 1) * 32 + (swz % 64) / 2; }
__host__ __device__ __forceinline__ int perm32(int rho) { const int n = rho >> 4, i = rho & 15; return 8 * (i >> 2) + 4 * n + (i & 3); }

struct Unit { int pm, pn, e, rt, seq; };
struct Gemm { const void* A; const void* Bt; int M, N, K, KB; };

struct StaticOrder {
    int nM, nN, nwg, G, c;
    __host__ __device__ void init(int M, int N, int G_, int c_) { nM = M / BM; nN = N / BM; nwg = nM * nN; G = G_; c = c_; }
    __host__ __device__ bool next(int i, Unit& u) const {
        const long L = (long)i * G + c; if (L >= nwg) return false;
        int wgid = (int)L; { const int q = nwg / NXCD, r = nwg % NXCD, xcd = wgid % NXCD, off = wgid / NXCD; wgid = (xcd < r ? xcd * (q + 1) : r * (q + 1) + (xcd - r) * q) + off; }
        const int nig = WGM * nN, gid = wgid / nig, fm = gid * WGM, gsz = (nM - fm) < WGM ? (nM - fm) : WGM;
        u.pm = fm + ((wgid % nig) % gsz); u.pn = (wgid % nig) / gsz; u.e = 0; u.rt = 0; return true;
    }
    __device__ __forceinline__ void a_ready(const Unit&) const {}
    __device__ __forceinline__ void done(const Unit&) const {}
};

__device__ __forceinline__ unsigned cvt_pk_bf16(float lo, float hi) { unsigned r; asm volatile("v_cvt_pk_bf16_f32 %0, %1, %2" : "=v"(r) : "v"(lo), "v"(hi)); return r; }
__device__ __forceinline__ float sigmoid_f(float x) { return __builtin_amdgcn_rcpf(1.0f + __builtin_amdgcn_exp2f(-1.4426950408889634f * x)); }
typedef int i32x4 __attribute__((ext_vector_type(4))); typedef int i32x8 __attribute__((ext_vector_type(8))); typedef unsigned u32x2 __attribute__((ext_vector_type(2)));
__device__ __forceinline__ float clamp448(float x) { return fminf(fmaxf(x, -448.0f), 448.0f); }
__device__ __forceinline__ unsigned pk4_fp8(float a, float b, float c, float d) { int w = __builtin_amdgcn_cvt_pk_fp8_f32(clamp448(a), clamp448(b), 0, false); w = __builtin_amdgcn_cvt_pk_fp8_f32(clamp448(c), clamp448(d), w, true); return (unsigned)w; }
__device__ __forceinline__ unsigned pk4_fp8_nc(float a, float b, float c, float d) { int w = __builtin_amdgcn_cvt_pk_fp8_f32(a, b, 0, false); w = __builtin_amdgcn_cvt_pk_fp8_f32(c, d, w, true); return (unsigned)w; }
__device__ __forceinline__ u32x4 pack8(f32x4 v0, f32x4 v1) { u32x4 w; w.x = cvt_pk_bf16(v0[0], v0[1]); w.y = cvt_pk_bf16(v0[2], v0[3]); w.z = cvt_pk_bf16(v1[0], v1[1]); w.w = cvt_pk_bf16(v1[2], v1[3]); return w; }

struct EpiProj {
    static constexpr bool PERM = true, AFTER_DRAIN = false, CINIT = false;
    bf16_t *Q, *U; size_t qkv_stride  ; const PG8_LAS float* bglu  ; float qscale; unsigned* nrm;
    __device__ __forceinline__ void operator()(const f32x4 (&acc)[2][2][4][2], const Unit& u, int wr, int wc, int fr, int fq) const {
        const int row0 = u.pm * BM + wr * 64 + fr;
        if (u.pn < 6) {
            const int t = u.pn >> 1; bf16_t* base = Q + (size_t)t * qkv_stride; const float sc = (t == 0) ? qscale : 1.0f;
            const int col0 = (u.pn & 1) * 256 + wc * 32 + 8 * fq;
#pragma unroll
            for (int ai = 0; ai < 2; ++ai)
#pragma unroll
                for (int m = 0; m < 4; ++m) { bf16_t* rowp = base + (size_t)(row0 + ai * HALF + m * 16) * 512 + col0;
#pragma unroll
                    for (int bj = 0; bj < 2; ++bj) *(u32x4*)(rowp + bj * HALF) = pack8(acc[ai][bj][m][0] * sc, acc[ai][bj][m][1] * sc); }
            if (t < 2) {
#pragma unroll
                for (int bj = 0; bj < 2; ++bj) { float mx = 0.f;
#pragma unroll
                    for (int ai = 0; ai < 2; ++ai)
#pragma unroll
                        for (int m = 0; m < 4; ++m) { const f32x4 a0 = acc[ai][bj][m][0] * sc, a1 = acc[ai][bj][m][1] * sc;
                            float s = (a0[0] * a0[0] + a0[1] * a0[1]) + (a0[2] * a0[2] + a0[3] * a0[3]) + (a1[0] * a1[0] + a1[1] * a1[1]) + (a1[2] * a1[2] + a1[3] * a1[3]);
                            s += __shfl_xor(s, 16); s += __shfl_xor(s, 32); mx = fmaxf(mx, s); }
#pragma unroll
                    for (int o = 1; o < 16; o <<= 1) mx = fmaxf(mx, __shfl_xor(mx, o));
                    if (fr == 0 && fq == 0) { const int head = (u.pn & 1) * 4 + bj * 2 + (wc >> 1), bh = (u.pm >> 5) * 8 + head;
                        __hip_atomic_fetch_max(nrm + (size_t)(((t * 16 + bh) * 2 + (wc & 1)) * 64), __builtin_bit_cast(unsigned, mx), __ATOMIC_RELAXED, __HIP_MEMORY_SCOPE_AGENT); } } }
        } else {
            const int ch0 = (u.pn - 6) * 128 + wc * 32 + 8 * fq;
            f32x4 ba[2], bg[2];
#pragma unroll
            for (int n = 0; n < 2; ++n) { ba[n] = *(const PG8_LAS f32x4*)(bglu + ch0 + 4 * n); bg[n] = *(const PG8_LAS f32x4*)(bglu + 512 + ch0 + 4 * n); }
#pragma unroll
            for (int ai = 0; ai < 2; ++ai)
#pragma unroll
                for (int m = 0; m < 4; ++m) { f32x4 o[2];
#pragma unroll
                    for (int n = 0; n < 2; ++n) { const f32x4 a = acc[ai][0][m][n] + ba[n], g = acc[ai][1][m][n] + bg[n];
#pragma unroll
                        for (int j = 0; j < 4; ++j) o[n][j] = a[j] * sigmoid_f(g[j]); }
                    *(u32x4*)(U + (size_t)(row0 + ai * HALF + m * 16) * 512 + ch0) = pack8(o[0], o[1]); }
        }
    }
};
struct EpiH1 {
    static constexpr bool PERM = true, AFTER_DRAIN = false, CINIT = false;
    const bf16_t* xn; const float* rms; const float* g; bf16_t* h1;
    __device__ __forceinline__ void operator()(const f32x4 (&acc)[2][2][4][2], const Unit& u, int wr, int wc, int fr, int fq) const {
        const int row0 = u.pm * BM + wr * 64 + fr, col0 = u.pn * BM + wc * 32 + 8 * fq;
        f32x4 gi[2][2];
#pragma unroll
        for (int bj = 0; bj < 2; ++bj)
#pragma unroll
            for (int n = 0; n < 2; ++n) { const f32x4 gv = *(const f32x4*)(g + col0 + bj * HALF + 4 * n);
                gi[bj][n] = (f32x4){__builtin_amdgcn_rcpf(gv[0]), __builtin_amdgcn_rcpf(gv[1]), __builtin_amdgcn_rcpf(gv[2]), __builtin_amdgcn_rcpf(gv[3])}; }
#pragma unroll
        for (int ai = 0; ai < 2; ++ai) {
            u32x4 xb[4][2]; float rr[4];
#pragma unroll
            for (int m = 0; m < 4; ++m) { const int row = row0 + ai * HALF + m * 16; rr[m] = rms[row];
#pragma unroll
                for (int bj = 0; bj < 2; ++bj) xb[m][bj] = *(const u32x4*)(xn + (size_t)row * 1024 + col0 + bj * HALF); }
            __builtin_amdgcn_sched_barrier(0);
#pragma unroll
            for (int m = 0; m < 4; ++m)
#pragma unroll
                for (int bj = 0; bj < 2; ++bj) { const int row = row0 + ai * HALF + m * 16; const size_t p = (size_t)row * 1024 + col0 + bj * HALF;
                    const u32x4 b = xb[m][bj]; const float r = rr[m];
                    const f32x4 x0 = (f32x4){__builtin_bit_cast(float, b.x << 16), __builtin_bit_cast(float, b.x & 0xffff0000u), __builtin_bit_cast(float, b.y << 16), __builtin_bit_cast(float, b.y & 0xffff0000u)} * r * gi[bj][0];
                    const f32x4 x1 = (f32x4){__builtin_bit_cast(float, b.z << 16), __builtin_bit_cast(float, b.z & 0xffff0000u), __builtin_bit_cast(float, b.w << 16), __builtin_bit_cast(float, b.w & 0xffff0000u)} * r * gi[bj][1];
                    *(u32x4*)(h1 + p) = pack8(acc[ai][bj][m][0] + x0, acc[ai][bj][m][1] + x1); }
            __builtin_amdgcn_sched_barrier(0);
        }
    }
};
struct EpiGU {
    static constexpr bool PERM = true, AFTER_DRAIN = false, CINIT = true;
    unsigned char* act; const PG8_LAS float* tab  ; float acc_scale, out_scale;
    __device__ __forceinline__ void init(f32x4 (&acc)[2][2][4][2], const Unit& u, int wr, int wc, int fr, int fq) const {
        const PG8_LAS float* bp = tab + u.seq * 256 + wc * 32 + 8 * fq;
#pragma unroll
        for (int n = 0; n < 2; ++n) { const f32x4 bg = *(const PG8_LAS f32x4*)(bp + 4 * n), bu = *(const PG8_LAS f32x4*)(bp + 128 + 4 * n);
#pragma unroll
            for (int ai = 0; ai < 2; ++ai)
#pragma unroll
                for (int m = 0; m < 4; ++m) { acc[ai][0][m][n] = bg; acc[ai][1][m][n] = bu; } }
    }
    __device__ __forceinline__ void operator()(const f32x4 (&acc)[2][2][4][2], const Unit& u, int wr, int wc, int fr, int fq) const {
        const int row0 = u.pm * BM + wr * 64 + fr, pl = u.pn & 7, ch0 = pl * 128 + wc * 32 + 8 * fq;
        const float lim = 7.0f / acc_scale, cs = (-1.702f * 1.4426950408889634f) * acc_scale, k1 = out_scale * acc_scale * acc_scale, k2 = out_scale * acc_scale;
#pragma unroll
        for (int ai = 0; ai < 2; ++ai)
#pragma unroll
            for (int m = 0; m < 4; ++m) { f32x4 o[2];
#pragma unroll
                for (int n = 0; n < 2; ++n) { const f32x4 G = acc[ai][0][m][n], U = acc[ai][1][m][n]; f32x4 hg, hu, e, r;
#pragma unroll
                    for (int j = 0; j < 4; ++j) { hg[j] = __builtin_amdgcn_fmed3f(G[j], -3.0e38f, lim); hu[j] = __builtin_amdgcn_fmed3f(U[j], -lim, lim); }
                    const f32x4 t = hg * cs;
#pragma unroll
                    for (int j = 0; j < 4; ++j) e[j] = __builtin_amdgcn_exp2f(t[j]);
                    const f32x4 d = e + 1.0f;
#pragma unroll
                    for (int j = 0; j < 4; ++j) r[j] = __builtin_amdgcn_rcpf(d[j]);
                    o[n] = (hu * k1 + k2) * (hg * r); }
                u32x2 w; w.x = pk4_fp8_nc(o[0][0], o[0][1], o[0][2], o[0][3]); w.y = pk4_fp8_nc(o[1][0], o[1][1], o[1][2], o[1][3]);
                *(u32x2*)(act + (size_t)(row0 + ai * HALF + m * 16) * 1024 + ch0) = w; }
    }
};
struct EpiDown {
    static constexpr bool PERM = true, AFTER_DRAIN = false, CINIT = true;
    unsigned char* y; const PG8_LAS float* tab  ; float acc_scale;
    __device__ __forceinline__ void init(f32x4 (&acc)[2][2][4][2], const Unit& u, int wr, int wc, int fr, int fq) const {
        const PG8_LAS float* bp = tab + u.seq * 512 + wc * 32 + 8 * fq;
#pragma unroll
        for (int bj = 0; bj < 2; ++bj)
#pragma unroll
            for (int n = 0; n < 2; ++n) { const f32x4 b = *(const PG8_LAS f32x4*)(bp + bj * HALF + 4 * n);
#pragma unroll
                for (int ai = 0; ai < 2; ++ai)
#pragma unroll
                    for (int m = 0; m < 4; ++m) acc[ai][bj][m][n] = b; }
    }
    __device__ __forceinline__ void operator()(const f32x4 (&acc)[2][2][4][2], const Unit& u, int wr, int wc, int fr, int fq) const {
        const int r0 = wr * 64 + fr, pl = u.pn & 3, col0 = pl * 256 + wc * 32 + 8 * fq;
        const PG8_LAS float* tp = tab + u.seq * 512;
#pragma unroll
        for (int ai = 0; ai < 2; ++ai)
#pragma unroll
            for (int m = 0; m < 4; ++m) { const int r = r0 + ai * HALF + m * 16; const float gt = tp[256 + r] * acc_scale;
                unsigned char* rowp = y + (size_t)(u.pm * BM + r) * 1024 + col0;
#pragma unroll
                for (int bj = 0; bj < 2; ++bj) { const f32x4 v0 = acc[ai][bj][m][0] * gt, v1 = acc[ai][bj][m][1] * gt;
                    u32x2 w; w.x = pk4_fp8(v0[0], v0[1], v0[2], v0[3]); w.y = pk4_fp8(v1[0], v1[1], v1[2], v1[3]); *(u32x2*)(rowp + bj * HALF) = w; } }
    }
};

struct MoeOrder {
    int nwg, G, c, NPN; const PG8_LAS int* ustart; const PG8_LAS int* ntile; const PG8_LAS int* tileoff;
    __device__ __forceinline__ bool next(int i, Unit& u) const {
        const int L = i * G + c; if (L >= nwg) return false;
        int wgid = L; { const int q = nwg / NXCD, r = nwg % NXCD, xcd = wgid % NXCD, off = wgid / NXCD; wgid = (xcd < r ? xcd * (q + 1) : r * (q + 1) + (xcd - r) * q) + off; }
        int e = 0;
        for (int k = 1; k < 32; ++k) e += (ustart[k] <= wgid) ? 1 : 0;
        e = __builtin_amdgcn_readfirstlane(e);
        const int l = wgid - ustart[e], rt = l / NPN, pl = l - rt * NPN;
        u.pm = __builtin_amdgcn_readfirstlane(tileoff[e] + rt); u.pn = __builtin_amdgcn_readfirstlane(e * NPN + pl); u.e = e; u.rt = __builtin_amdgcn_readfirstlane(rt); return true;
    }
    __device__ __forceinline__ void a_ready(const Unit&) const {}
    __device__ __forceinline__ void done(const Unit&) const {}
};

#ifndef PG8_BAUX
#define PG8_BAUX 0
#endif
template <class Epi, class Sched, bool ALIGN_EPI, bool GATHER, bool F8>
__device__ __forceinline__ void gemm_phase(PG8_LAS unsigned char* lds, const Gemm g, const Sched& S, const Epi& E, const PG8_LAS int* tokl) {
    const int tid = threadIdx.x, wid = __builtin_amdgcn_readfirstlane(tid >> 6), lane = tid & 63, wr = wid >> 2, wc = wid & 3, fr = lane & 15, fq = lane >> 4;
    const int KB = g.KB, nt = KB / 128;
    unsigned voffB[2];
#pragma unroll
    for (int i = 0; i < 2; ++i) { int R, C; stage_rc(tid * 16 + i * 8192, R, C); const int Rb = Epi::PERM ? ((R & ~31) + perm32(R & 31)) : R;
        voffB[i] = (unsigned)(Rb * KB + C * 2); }
    const size_t kstep = (size_t)(BK * 2);
    const size_t hstep = (size_t)HALF * KB;
    const size_t tstep = 2 * hstep;
    const unsigned ldsw = (unsigned)wid * 1024u;
    const int aoff = lds_byte(wr * 64 + fr, fq * 8), boff = lds_byte(wc * 32 + fr, fq * 8);
#define PG8_SA(b, h) (((b) * 2 + (h)) * HTB)
#define PG8_SB(b, h) ((4 + (b) * 2 + (h)) * HTB)
#define PG8_STAGE(bufoff, gbase, voff) do { _Pragma("unroll") for (int _i = 0; _i < 2; ++_i) \
        __builtin_amdgcn_global_load_lds((const unsigned*)((const char*)(gbase) + (voff)[_i]), (PG8_LAS unsigned*)(lds + (bufoff) + ldsw + _i * 8192), 16, 0, 0); } while (0)
#define PG8_STAGEB(bufoff, gbase, voff) do { _Pragma("unroll") for (int _i = 0; _i < 2; ++_i) \
        __builtin_amdgcn_global_load_lds((const unsigned*)((const char*)(gbase) + (voff)[_i]), (PG8_LAS unsigned*)(lds + (bufoff) + ldsw + _i * 8192), 16, 0, PG8_BAUX); } while (0)
#define PG8_LDA(dst, b, h) do { _Pragma("unroll") for (int m = 0; m < 4; ++m) _Pragma("unroll") for (int k = 0; k < 2; ++k) dst[m][k] = *(const PG8_LAS bf16x8*)(lds + PG8_SA(b, h) + aoff + m * 2048 + k * 1024); } while (0)
#define PG8_LDB(dst, b, h) do { _Pragma("unroll") for (int n = 0; n < 2; ++n) _Pragma("unroll") for (int k = 0; k < 2; ++k) dst[n][k] = *(const PG8_LAS bf16x8*)(lds + PG8_SB(b, h) + boff + n * 2048 + k * 1024); } while (0)
#define PG8_CAT(X) __builtin_shufflevector(__builtin_bit_cast(i32x4, (X)[0]), __builtin_bit_cast(i32x4, (X)[1]), 0, 1, 2, 3, 4, 5, 6, 7)
#define PG8_MMA(ai, bj, At, Bt) do { __builtin_amdgcn_s_setprio(1); if constexpr (F8) { _Pragma("unroll") for (int m = 0; m < 4; ++m) _Pragma("unroll") for (int n = 0; n < 2; ++n) \
        acc[ai][bj][m][n] = __builtin_amdgcn_mfma_scale_f32_16x16x128_f8f6f4(PG8_CAT(Bt[n]), PG8_CAT(At[m]), acc[ai][bj][m][n], 0, 0, 0, 0x7f7f7f7f, 0, 0x7f7f7f7f); } else { \
        _Pragma("unroll") for (int m = 0; m < 4; ++m) _Pragma("unroll") for (int n = 0; n < 2; ++n) _Pragma("unroll") for (int k = 0; k < 2; ++k) \
        acc[ai][bj][m][n] = __builtin_amdgcn_mfma_f32_16x16x32_bf16(Bt[n][k], At[m][k], acc[ai][bj][m][n], 0, 0, 0); } __builtin_amdgcn_s_setprio(0); } while (0)
#define PG8_WAIT_V(n) asm volatile("s_waitcnt vmcnt(" #n ")" ::: "memory")
#define PG8_WAIT_L(n) asm volatile("s_waitcnt lgkmcnt(" #n ")" ::: "memory")
#define PG8_BAR __builtin_amdgcn_s_barrier()
#define PG8_SCHED __builtin_amdgcn_sched_barrier(0)
#define PG8_SETOFF(V, UIDX) do { _Pragma("unroll") for (int _i = 0; _i < 2; ++_i) { int _R, _C; { int _t = threadIdx.x; asm volatile("" : "+v"(_t)); stage_rc(_t * 16 + _i * 8192, _R, _C); } \
        _Pragma("unroll") for (int _h = 0; _h < 2; ++_h) { const unsigned _r = GATHER ? (unsigned)tokl[(UIDX) * 256 + _h * HALF + _R] : (unsigned)(_h * HALF + _R); V[_h][_i] = _r * (unsigned)KB + (unsigned)(_C * 2); } } } while (0)
    Unit cur, nxt; int ui = 0;
    if (!S.next(0, cur)) return;
    cur.seq = 0;
    f32x4 acc[2][2][4][2];
    if constexpr (Epi::CINIT) E.init(acc, cur, wr, wc, fr, fq); else {
#pragma unroll
    for (int a = 0; a < 2; ++a)
#pragma unroll
        for (int b = 0; b < 2; ++b)
#pragma unroll
            for (int m = 0; m < 4; ++m)
#pragma unroll
                for (int n = 0; n < 2; ++n) acc[a][b][m][n] = (f32x4){0.f, 0.f, 0.f, 0.f};
    }
    bf16x8 At[4][2], B0[2][2], B1[2][2];
    unsigned voA[2][2];
    const char* cA = GATHER ? (const char*)g.A : (const char*)g.A + (size_t)cur.pm * tstep; const char* cB = (const char*)g.Bt + (size_t)cur.pn * tstep;
    PG8_SETOFF(voA, 0);
    S.a_ready(cur);
    PG8_STAGEB(PG8_SB(0, 0), cB, voffB); PG8_STAGEB(PG8_SB(0, 1), cB + hstep, voffB); PG8_STAGE(PG8_SA(0, 0), cA, voA[0]); PG8_STAGE(PG8_SA(0, 1), cA, voA[1]);
    if (wr == 1) PG8_BAR;
    PG8_WAIT_V(2); PG8_BAR;
    PG8_STAGEB(PG8_SB(1, 0), cB + kstep, voffB); PG8_STAGE(PG8_SA(1, 0), cA + kstep, voA[0]); PG8_STAGEB(PG8_SB(1, 1), cB + hstep + kstep, voffB);
    PG8_WAIT_V(6); PG8_BAR;
    for (;;) {
        const bool has_next = S.next(ui + 1, nxt);
        const char* nA = has_next ? (GATHER ? (const char*)g.A : (const char*)g.A + (size_t)nxt.pm * tstep) : cA; const char* nB = has_next ? (const char*)g.Bt + (size_t)nxt.pn * tstep : cB;
#pragma clang loop unroll(disable)
        for (int t = 0; t < nt; t += 2) {
            const bool last = (t == nt - 2);
            const char* a1 = cA + (size_t)(t + 1) * kstep;
            const char* a2 = last ? nA : cA + (size_t)(t + 2) * kstep; const char* b2 = last ? nB : cB + (size_t)(t + 2) * kstep;
            const char* a3 = a2 + kstep; const char* b3 = b2 + kstep;
            if (last && has_next) S.a_ready(nxt);
            PG8_LDB(B0, 0, 0); PG8_LDB(B1, 0, 1); PG8_SCHED; PG8_LDA(At, 0, 0); PG8_STAGE(PG8_SA(1, 1), a1, voA[1]);
            if (GATHER && last && has_next) { PG8_SETOFF(voA, ui + 1); }
            PG8_WAIT_V(8); PG8_WAIT_L(0); PG8_BAR; PG8_MMA(0, 0, At, B0); PG8_MMA(0, 1, At, B1); PG8_BAR; PG8_SCHED;
            PG8_LDA(At, 0, 1); PG8_STAGEB(PG8_SB(0, 0), b2, voffB); PG8_STAGEB(PG8_SB(0, 1), b2 + hstep, voffB); PG8_STAGE(PG8_SA(0, 0), a2, voA[0]);
            PG8_WAIT_V(8); PG8_WAIT_L(0); PG8_BAR; PG8_MMA(1, 0, At, B0); PG8_MMA(1, 1, At, B1); PG8_BAR; PG8_SCHED;
            PG8_LDB(B0, 1, 0); PG8_LDB(B1, 1, 1); PG8_SCHED; PG8_LDA(At, 1, 0); PG8_STAGE(PG8_SA(0, 1), a2, voA[1]);
            PG8_WAIT_V(8); PG8_WAIT_L(0); PG8_BAR; PG8_MMA(0, 0, At, B0); PG8_MMA(0, 1, At, B1); PG8_BAR; PG8_SCHED;
            PG8_LDA(At, 1, 1); PG8_STAGEB(PG8_SB(1, 0), b3, voffB); PG8_STAGEB(PG8_SB(1, 1), b3 + hstep, voffB); PG8_STAGE(PG8_SA(1, 0), a3, voA[0]);
            PG8_WAIT_V(8); PG8_WAIT_L(0); PG8_BAR; PG8_MMA(1, 0, At, B0); PG8_MMA(1, 1, At, B1); PG8_BAR; PG8_SCHED;
        }
        if constexpr (ALIGN_EPI) { if (wr == 0) PG8_BAR; }
        E(acc, cur, wr, wc, fr, fq); S.done(cur);
        if (!has_next) break;
        cur = nxt; cA = nA; cB = nB; ++ui; cur.seq = ui;
        if constexpr (Epi::CINIT) E.init(acc, cur, wr, wc, fr, fq); else {
#pragma unroll
        for (int a = 0; a < 2; ++a)
#pragma unroll
            for (int b = 0; b < 2; ++b)
#pragma unroll
                for (int m = 0; m < 4; ++m)
#pragma unroll
                    for (int n = 0; n < 2; ++n) acc[a][b][m][n] = (f32x4){0.f, 0.f, 0.f, 0.f};
        }
        if constexpr (ALIGN_EPI) { if (wr == 1) PG8_BAR; }
    }
    PG8_WAIT_V(0);
    if constexpr (!ALIGN_EPI) { if (wr == 0) PG8_BAR; }
    PG8_BAR;
#undef PG8_SA
#undef PG8_SB
#undef PG8_STAGE
#undef PG8_STAGEB
#undef PG8_LDA
#undef PG8_LDB
#undef PG8_MMA
#undef PG8_CAT
#undef PG8_WAIT_V
#undef PG8_WAIT_L
#undef PG8_BAR
#undef PG8_SCHED
#undef PG8_SETOFF
}
}
namespace attn_body {
using bf16=__hip_bfloat16;
using bf16x8=__attribute__((ext_vector_type(8)))short;
using s16x4=__attribute__((ext_vector_type(4)))short;
using f32x16=__attribute__((ext_vector_type(16)))float;
using u32x4=__attribute__((ext_vector_type(4)))unsigned;
using f32x4_t=__attribute__((ext_vector_type(4)))float;
constexpr int BATCH=2,NHEAD=8,SEQ=8192,D=64,DM=NHEAD*D,OPITCH=1024;
constexpr int NW=8,QBLK=32,QB=QBLK*NW,KVBLK=64,NQB=SEQ/QB;
constexpr int ATTN_PITCH=DM, ATTN_UNIT_ROWS=QB;
__device__ __forceinline__ int crow(int r,int hi){return (r&3)+8*(r>>2)+4*hi;}
#define SBAR() __builtin_amdgcn_sched_barrier(0)
__device__ __forceinline__ void cmask(f32x16&p0,f32x16&p1,int jb,int qrel,int hi){
  const float NEG=-INFINITY; int kb=64*jb+4*hi;
  #pragma unroll
  for(int r=0;r<16;++r){int kv=kb+(r&3)+8*(r>>2); if(kv>qrel)p0[r]=NEG; if(kv+32>qrel)p1[r]=NEG;}
}

constexpr int NSLOT=3, SLOTB=8192;
constexpr int LDS_K=0, LDS_V=NSLOT*SLOTB, LDS_WS=2*NSLOT*SLOTB, LDS_OST=LDS_WS+NW*64*4, LDS_C=LDS_OST+NW*4096, LDS_BYTES=LDS_C+SEQ*4;
constexpr float C2=0.125f*1.4426950408889634f;
__device__ __forceinline__ void glds16(const void*gsrc,unsigned lds_dst){unsigned keep;
  asm volatile("s_mov_b32 %0, m0\n\ts_mov_b32 m0, %2\n\ts_nop 0\n\tglobal_load_lds_dwordx4 %1, off\n\ts_mov_b32 m0, %0":"=&s"(keep):"v"(gsrc),"s"(lds_dst):"memory");}
__device__ __forceinline__ float max3f(float a,float b,float c){float r;asm("v_max3_f32 %0, %1, %2, %3":"=v"(r):"v"(a),"v"(b),"v"(c));return r;}
__device__ __forceinline__ float max2f(float a,float b){float r;asm("v_max_f32_e32 %0, %1, %2":"=v"(r):"v"(a),"v"(b));return r;}
__device__ __forceinline__ float fadd_s(float a,float b){float r;asm("v_add_f32_e32 %0, %1, %2":"=v"(r):"v"(a),"v"(b));return r;}
__device__ __forceinline__ float fsub_s(float a,float b){float r;asm("v_sub_f32_e32 %0, %1, %2":"=v"(r):"v"(a),"v"(b));return r;}
typedef float f32x2_t __attribute__((ext_vector_type(2))); typedef __bf16 bf16x2_t __attribute__((ext_vector_type(2)));
__device__ __forceinline__ unsigned cvtpk_s(float lo,float hi){f32x2_t v={lo,hi};bf16x2_t b=__builtin_convertvector(v,bf16x2_t);return __builtin_bit_cast(unsigned,b);}
#define WAIT_BAR(N) asm volatile("s_waitcnt vmcnt(" #N ") lgkmcnt(0)\n\ts_barrier":::"memory")

__device__ __forceinline__ void qkt(f32x16&p0,f32x16&p1,const char*Kslot,const bf16x8*qr,const f32x16&c0,const f32x16&c1,int r32,int hi){
  const char*kb=Kslot+hi*1024+r32*16;
  #pragma unroll
  for(int d0=0;d0<4;++d0){
    const bf16x8 b0=*reinterpret_cast<const bf16x8*>(kb+d0*2048);
    const bf16x8 b1=*reinterpret_cast<const bf16x8*>(kb+d0*2048+512);
    if(d0==0){p0=__builtin_amdgcn_mfma_f32_32x32x16_bf16(b0,qr[0],c0,0,0,0);p1=__builtin_amdgcn_mfma_f32_32x32x16_bf16(b1,qr[0],c1,0,0,0);}
    else{p0=__builtin_amdgcn_mfma_f32_32x32x16_bf16(b0,qr[d0],p0,0,0,0);p1=__builtin_amdgcn_mfma_f32_32x32x16_bf16(b1,qr[d0],p1,0,0,0);}}
}
typedef __attribute__((address_space(3))) const char* lds_cptr;
typedef short v4i16_t __attribute__((ext_vector_type(4)));
__device__ __forceinline__ void kload8(bf16x8*kf,lds_cptr kp){
  kf[0]=*(const __attribute__((address_space(3))) bf16x8*)(kp);      kf[1]=*(const __attribute__((address_space(3))) bf16x8*)(kp+512);
  kf[2]=*(const __attribute__((address_space(3))) bf16x8*)(kp+2048); kf[3]=*(const __attribute__((address_space(3))) bf16x8*)(kp+2560);
  kf[4]=*(const __attribute__((address_space(3))) bf16x8*)(kp+4096); kf[5]=*(const __attribute__((address_space(3))) bf16x8*)(kp+4608);
  kf[6]=*(const __attribute__((address_space(3))) bf16x8*)(kp+6144); kf[7]=*(const __attribute__((address_space(3))) bf16x8*)(kp+6656);
}
__device__ __forceinline__ void kload2(bf16x8*kf,lds_cptr kp,int j){ kf[2*j]=*(const __attribute__((address_space(3))) bf16x8*)(kp+j*2048); kf[2*j+1]=*(const __attribute__((address_space(3))) bf16x8*)(kp+j*2048+512); }
__device__ __forceinline__ s16x4 vtr(lds_cptr p){ return __builtin_bit_cast(s16x4,__builtin_amdgcn_ds_read_tr16_b64_v4i16((__attribute__((address_space(3))) v4i16_t*)p)); }
__device__ __forceinline__ float rowmax(const f32x16&p0,const f32x16&p1){
  float a=max3f(p0[0],p0[1],p1[0]),b=max3f(p0[2],p0[3],p1[1]);a=max3f(a,p1[2],p1[3]);
  #pragma unroll
  for(int r=4;r<16;r+=4){a=max3f(a,p0[r],p0[r+1]);b=max3f(b,p0[r+2],p0[r+3]);a=max3f(a,p1[r],p1[r+1]);b=max3f(b,p1[r+2],p1[r+3]);}
  const float m=max2f(a,b);
  auto rr=__builtin_amdgcn_permlane32_swap(__float_as_uint(m),__float_as_uint(m),false,false);
  return max2f(__uint_as_float(rr[0]),__uint_as_float(rr[1]));
}
__device__ __forceinline__ void pv(f32x16*o,int vb,bf16x8 pa0,bf16x8 pa1,bf16x8 pa2,bf16x8 pa3){
  #pragma unroll
  for(int d0=0;d0<2;++d0){s16x4 lo[4],hi[4];
    #pragma unroll
    for(int ks=0;ks<4;++ks){
      asm volatile("ds_read_b64_tr_b16 %0,%1 offset:%c2":"=&v"(lo[ks]):"v"(vb),"i"(d0*4096+ks*1024):"memory");
      asm volatile("ds_read_b64_tr_b16 %0,%1 offset:%c2":"=&v"(hi[ks]):"v"(vb),"i"(d0*4096+ks*1024+512):"memory");}
    asm volatile("s_waitcnt lgkmcnt(0)":::"memory");SBAR();
    #define PK(k) (bf16x8){lo[k][0],lo[k][1],lo[k][2],lo[k][3],hi[k][0],hi[k][1],hi[k][2],hi[k][3]}
    o[d0]=__builtin_amdgcn_mfma_f32_32x32x16_bf16(pa0,PK(0),o[d0],0,0,0);
    o[d0]=__builtin_amdgcn_mfma_f32_32x32x16_bf16(pa1,PK(1),o[d0],0,0,0);
    o[d0]=__builtin_amdgcn_mfma_f32_32x32x16_bf16(pa2,PK(2),o[d0],0,0,0);
    o[d0]=__builtin_amdgcn_mfma_f32_32x32x16_bf16(pa3,PK(3),o[d0],0,0,0);
    #undef PK
  }
}

#ifndef ATTN_STORE16
#define ATTN_STORE16(p,v) (*(u32x4*)(p)=(v))
#endif
template<int THRL> __device__ __forceinline__ void attn_unit(int b,int h,int qb,const bf16*Q,const bf16*__restrict__ K,const bf16*__restrict__ V,bf16*O,const float*__restrict__ CP,const unsigned*__restrict__ NRM,char*shm){
  const int tid=threadIdx.x,lane=tid&63,r32=lane&31,hi=lane>>5; const int wid=__builtin_amdgcn_readfirstlane(tid>>6);
  const long rowbase=(long)b*SEQ; const int q0=qb*QB;
  const bf16*Qw=Q+(rowbase+q0+wid*QBLK)*DM+h*D;
  const bf16*Kh=K+rowbase*DM+h*D,*Vh=V+rowbase*DM+h*D;
  const unsigned lds0=(unsigned)(uintptr_t)shm;
  const lds_cptr shm3=(lds_cptr)shm;
  float*wsf=(float*)(shm+LDS_WS)+wid*64;
  const bf16*ksrc=Kh+(long)lane*DM+wid*8;
  const bf16*vsrc=Vh+(long)(16*(wid&3)+(lane>>2))*DM+(wid>>2)*32+(lane&3)*8;
  const unsigned kdst=lds0+LDS_K+wid*1024, vdst=lds0+LDS_V+wid*1024;
  #define DMA_K(t,slot) glds16(ksrc+(long)TIDX(t)*KVBLK*DM,(unsigned)__builtin_amdgcn_readfirstlane(kdst+(slot)))
  #define DMA_V(t,slot) glds16(vsrc+(long)TIDX(t)*KVBLK*DM,(unsigned)__builtin_amdgcn_readfirstlane(vdst+(slot)))
  const int vb0=(int)(lds0+LDS_V)+((lane>>4)&1)*32+(lane&3)*8+(4*hi+((lane&15)>>2))*64;
  const char*Kbase=shm+LDS_K; bf16x8 kf[8];
  const lds_cptr kp0=shm3+LDS_K+hi*1024+r32*16; const lds_cptr vp0=shm3+LDS_V+((lane>>4)&1)*32+(lane&3)*8+(4*hi+((lane&15)>>2))*64;
  const int NT=(q0+QB)/KVBLK;
#if defined(ATT_ORIGORDER)
  #define TIDX(p) (p)
  #define JBOF(t) ((t)-(NT-4))
#else
  #define TIDX(p) (((p)<4)?(NT-4+(p)):(NT-1-(p)))
  #define JBOF(t) (((t)<4)?(t):-1)
#endif
  const float*cg=CP+(long)(b*NHEAD+h)*SEQ;
  typedef __attribute__((address_space(3))) const f32x4_t* lds_c4;
#if !defined(ATT_NOSTAGE)
  { float*cl=(float*)(shm+LDS_C); const int nk=q0+QB; for(int i=tid*4;i<nk;i+=NW*64*4)*(f32x4_t*)(cl+i)=*(const f32x4_t*)(cg+i); }
#endif
  const lds_c4 cl4=(lds_c4)(shm3+LDS_C)+hi;
#if defined(ATT_NOBIAS)
  #define CBIAS(C0,C1,a) do{ _Pragma("unroll") for(int g_=0;g_<16;++g_){ C0[g_]=nm; C1[g_]=nm; } }while(0)
#else
  #define CBIAS(C0,C1,a) do{ const lds_c4 cp_=cl4+16*(a); _Pragma("unroll") for(int g_=0;g_<4;++g_){ const f32x4_t v_=cp_[2*g_], w_=cp_[8+2*g_]; \
      C0[4*g_]=nm-v_[0];C0[4*g_+1]=nm-v_[1];C0[4*g_+2]=nm-v_[2];C0[4*g_+3]=nm-v_[3]; C1[4*g_]=nm-w_[0];C1[4*g_+1]=nm-w_[1];C1[4*g_+2]=nm-w_[2];C1[4*g_+3]=nm-w_[3]; } }while(0)
#endif
  DMA_K(0,0);DMA_V(0,0);DMA_K(1,SLOTB);
  bf16x8 qr[4];
  #pragma unroll
  for(int d0=0;d0<4;++d0)qr[d0]=*reinterpret_cast<const bf16x8*>(&Qw[(long)r32*DM+d0*16+hi*8]);
  #if defined(ATT_NOBIAS)
  float l_reg=0.f,nm=0.f;
#else
  float l_reg=0.f,nm=cg[q0+wid*QBLK+r32];
#endif
  f32x16 o[2];o[0]=f32x16{};o[1]=f32x16{};
  const int qrel=wid*QBLK+r32;
  #define CMASK(P0,P1,t) do{int jb_=JBOF(t); if(jb_>=0)cmask(P0,P1,jb_,qrel,hi);}while(0)
  bool resc=false;
  #define START(P0,P1) do{ const float rm=rowmax(P0,P1); resc=false; \
    { const float dl=rm; \
      _Pragma("unroll") for(int r=0;r<16;++r){P0[r]=fsub_s(P0[r],dl);P1[r]=fsub_s(P1[r],dl);} \
      nm=fsub_s(nm,dl); } \
    _Pragma("unroll") for(int r=0;r<16;++r)P0[r]=__builtin_amdgcn_exp2f(P0[r]); }while(0)
  #define RESC() do{ if(resc){ asm volatile("s_waitcnt lgkmcnt(0)":::"memory"); \
      _Pragma("unroll") for(int d_=0;d_<2;++d_) _Pragma("unroll") for(int r=0;r<16;++r)o[d_][r]*=wsf[crow(r,hi)]; } }while(0)
  f32x16 pA0,pA1,pB0,pB1;
  int sl_prev=0,sl_cur=0,sl_next=SLOTB;
  #define ROT() do{sl_prev=sl_cur;sl_cur=sl_next;sl_next=(sl_next==(NSLOT-1)*SLOTB)?0:sl_next+SLOTB;}while(0)
  DMA_K(2,2*SLOTB);
  WAIT_BAR(3);
  int NTe=NT;
#if !defined(ATT_NOSKIP)
  { const unsigned*np=NRM+(size_t)((b*NHEAD+h)*2)*64; const float qn=__builtin_bit_cast(float,np[0])+__builtin_bit_cast(float,np[64]), kn=__builtin_bit_cast(float,np[16*2*64])+__builtin_bit_cast(float,np[16*2*64+64]);
    const float thr=40.0f+2.0f*1.02f*sqrtf(qn*kn); const __attribute__((address_space(3))) float*cls=(const __attribute__((address_space(3))) float*)(shm3+LDS_C);
    const float cq0=cls[q0]; int lo_=0,hi_=NT-4;
    while(lo_<hi_){ const int mid=(lo_+hi_)>>1; if(cq0-cls[64*mid+63]>=-thr)hi_=mid; else lo_=mid+1; }
    NTe=4+(NT-4-lo_); NTe+=NTe&1; NTe=__builtin_amdgcn_readfirstlane(NTe); }
#endif
  { f32x16 cb0,cb1; CBIAS(cb0,cb1,TIDX(0)); qkt(pA0,pA1,Kbase,qr,cb0,cb1,r32,hi); } asm volatile("s_nop 15\n\ts_nop 7":"+v"(pA0),"+v"(pA1));CMASK(pA0,pA1,0);
  START(pA0,pA1);
  _Pragma("unroll") for(int r=0;r<16;++r)pA1[r]=__builtin_amdgcn_exp2f(pA1[r]);
  WAIT_BAR(0);
  DMA_K(3,0);DMA_V(1,SLOTB);
  ROT();
  kload8(kf,kp0+sl_cur);
  WAIT_BAR(2);
  s16x4 vlo[8],vhi[8]; u32x4 pw0,pw1,pw2,pw3;
  #define PKW(P,B) cvtpk_s(P[B],P[B+1])
  #define PAF(k) __builtin_bit_cast(bf16x8,pw##k)
  #define VFR(i) (bf16x8){vlo[i][0],vlo[i][1],vlo[i][2],vlo[i][3],vhi[i][0],vhi[i][1],vhi[i][2],vhi[i][3]}
  #define PIN(x) asm volatile("":"+v"(x))
  #define MX3(a,b,c) __builtin_fmaxf(__builtin_fmaxf((a),(b)),(c))
  #define GAPA(MF,A0,A1,A2,A3,W0,W1,PW) do{ MF; sacc+=A0; sacc+=A1; sacc+=A2; sacc+=A3; PIN(sacc); W0; W1; PIN(PW); SBAR(); }while(0)
  #define EX(v) __builtin_amdgcn_exp2f(v)
  #define GAPB(MF,X,B) do{ MF; X[B]=EX(X[B]); X[B+1]=EX(X[B+1]); X[B+2]=EX(X[B+2]); X[B+3]=EX(X[B+3]); PIN(X); SBAR(); }while(0)
  #define VRD(i) do{ vlo[i]=vtr(vp_+(((i)>>2)*4096+((i)&3)*1024)); vhi[i]=vtr(vp_+(((i)>>2)*4096+((i)&3)*1024+512)); }while(0)
  #define KRD(G,j) do{ if(G){ kload2(kf,kp0+sl_next,j); SBAR(); } }while(0)
  #define STEP(C0,C1,P0,P1,t,GK,GV,GL) do{ SBAR(); \
    CBIAS(C0,C1,TIDX(t)); SBAR(); \
    const lds_cptr vp_=vp0+sl_prev; \
    VRD(0); SBAR(); float sacc=(P0[0]+P0[1]); \
    GAPA(C0=__builtin_amdgcn_mfma_f32_32x32x16_bf16(kf[0],qr[0],C0,0,0,0), P0[2],P0[3],P0[4],P0[5],     pw0[0]=PKW(P0,0), pw0[1]=PKW(P0,2), pw0); \
    VRD(4); SBAR(); GAPA(C1=__builtin_amdgcn_mfma_f32_32x32x16_bf16(kf[1],qr[0],C1,0,0,0), P0[6],P0[7],P0[8],P0[9],     pw0[2]=PKW(P0,4), pw0[3]=PKW(P0,6), pw0); \
    VRD(1); SBAR(); GAPA(C0=__builtin_amdgcn_mfma_f32_32x32x16_bf16(kf[2],qr[1],C0,0,0,0),   P0[10],P0[11],P0[12],P0[13], pw1[0]=PKW(P0,8), pw1[1]=PKW(P0,10), pw1); \
    VRD(5); SBAR(); GAPA(C1=__builtin_amdgcn_mfma_f32_32x32x16_bf16(kf[3],qr[1],C1,0,0,0),   P0[14],P0[15],P1[0],P1[1],   pw1[2]=PKW(P0,12),pw1[3]=PKW(P0,14), pw1); \
    VRD(2); SBAR(); GAPA(C0=__builtin_amdgcn_mfma_f32_32x32x16_bf16(kf[4],qr[2],C0,0,0,0),   P1[2],P1[3],P1[4],P1[5],     pw2[0]=PKW(P1,0), pw2[1]=PKW(P1,2), pw2); \
    VRD(6); SBAR(); GAPA(C1=__builtin_amdgcn_mfma_f32_32x32x16_bf16(kf[5],qr[2],C1,0,0,0),   P1[6],P1[7],P1[8],P1[9],     pw2[2]=PKW(P1,4), pw2[3]=PKW(P1,6), pw2); \
    VRD(3); SBAR(); GAPA(C0=__builtin_amdgcn_mfma_f32_32x32x16_bf16(kf[6],qr[3],C0,0,0,0),   P1[10],P1[11],P1[12],P1[13], pw3[0]=PKW(P1,8), pw3[1]=PKW(P1,10), pw3); \
    VRD(7); SBAR(); GAPA(C1=__builtin_amdgcn_mfma_f32_32x32x16_bf16(kf[7],qr[3],C1,0,0,0),   P1[14],P1[15],0.f,0.f,       pw3[2]=PKW(P1,12),pw3[3]=PKW(P1,14), pw3); \
    l_reg+=sacc; \
    if(GK){DMA_K((t)+3,sl_cur);} if(GV){DMA_V((t)+1,sl_next);} \
    CMASK(C0,C1,t); \
    { float a=MX3(C0[0],C0[1],C1[0]),b=MX3(C0[2],C0[3],C1[1]); a=MX3(a,C1[2],C1[3]); \
      _Pragma("unroll") for(int r=4;r<16;r+=4){a=MX3(a,C0[r],C0[r+1]);b=MX3(b,C0[r+2],C0[r+3]);a=MX3(a,C1[r],C1[r+1]);b=MX3(b,C1[r+2],C1[r+3]);} \
      float rm=__builtin_fmaxf(a,b); { auto rr=__builtin_amdgcn_permlane32_swap(__float_as_uint(rm),__float_as_uint(rm),false,false); rm=__builtin_fmaxf(__uint_as_float(rr[0]),__uint_as_float(rr[1])); } \
      resc=false; \
      if(__builtin_expect(__any(rm>(float)THRL),0)){ const float dl=__builtin_fmaxf(rm,0.f); \
        _Pragma("unroll") for(int r=0;r<16;++r){C0[r]-=dl;C1[r]-=dl;} \
        nm-=dl; \
        const float f=__builtin_amdgcn_exp2f(-dl); l_reg*=f; if(hi==0)wsf[r32]=f; resc=true; } } \
    SBAR(); \
    GAPB(o[0]=__builtin_amdgcn_mfma_f32_32x32x16_bf16(PAF(0),VFR(0),o[0],0,0,0), C0,0); \
    GAPB(o[1]=__builtin_amdgcn_mfma_f32_32x32x16_bf16(PAF(0),VFR(4),o[1],0,0,0), C0,4); \
    KRD(GL,0); GAPB(o[0]=__builtin_amdgcn_mfma_f32_32x32x16_bf16(PAF(1),VFR(1),o[0],0,0,0), C0,8); \
    KRD(GL,1); GAPB(o[1]=__builtin_amdgcn_mfma_f32_32x32x16_bf16(PAF(1),VFR(5),o[1],0,0,0), C0,12); \
    KRD(GL,2); GAPB(o[0]=__builtin_amdgcn_mfma_f32_32x32x16_bf16(PAF(2),VFR(2),o[0],0,0,0), C1,0); \
    KRD(GL,3); GAPB(o[1]=__builtin_amdgcn_mfma_f32_32x32x16_bf16(PAF(2),VFR(6),o[1],0,0,0), C1,4); \
    GAPB(o[0]=__builtin_amdgcn_mfma_f32_32x32x16_bf16(PAF(3),VFR(3),o[0],0,0,0), C1,8); \
    GAPB(o[1]=__builtin_amdgcn_mfma_f32_32x32x16_bf16(PAF(3),VFR(7),o[1],0,0,0), C1,12); \
    }while(0)
  int t=1;
  #define ENDW(tt) do{ if((tt)+3<NTe){WAIT_BAR(2);} else if((tt)+2<NTe){WAIT_BAR(1);} else {WAIT_BAR(0);} }while(0)
  for(;t<5&&t+1<NTe;t+=2){
    STEP(pB0,pB1,pA0,pA1,t,(t+3<NTe),(t+1<NTe),(t+1<NTe));       ENDW(t);   RESC(); ROT();
    STEP(pA0,pA1,pB0,pB1,t+1,(t+4<NTe),(t+2<NTe),(t+2<NTe));     ENDW(t+1); RESC(); ROT();
  }
  #undef CMASK
  #define CMASK(P0,P1,t) do{}while(0)
  for(;t+5<NTe;t+=2){
    STEP(pB0,pB1,pA0,pA1,t,true,true,true);     WAIT_BAR(2); RESC(); ROT();
    STEP(pA0,pA1,pB0,pB1,t+1,true,true,true);   WAIT_BAR(2); RESC(); ROT();
  }
  #undef CMASK
  #define CMASK(P0,P1,t) do{int jb_=JBOF(t); if(jb_>=0)cmask(P0,P1,jb_,qrel,hi);}while(0)
  for(;t+1<NTe;t+=2){
    STEP(pB0,pB1,pA0,pA1,t,(t+3<NTe),(t+1<NTe),(t+1<NTe));       ENDW(t);   RESC(); ROT();
    STEP(pA0,pA1,pB0,pB1,t+1,(t+4<NTe),(t+2<NTe),(t+2<NTe));     ENDW(t+1); RESC(); ROT();
  }
  STEP(pB0,pB1,pA0,pA1,NTe-1,false,false,false); RESC();
  { float sacc=pB0[0]+pB0[1]; _Pragma("unroll") for(int r=2;r<16;++r)sacc+=pB0[r]; _Pragma("unroll") for(int r=0;r<16;++r)sacc+=pB1[r]; l_reg+=sacc;
    pw0=(u32x4){PKW(pB0,0),PKW(pB0,2),PKW(pB0,4),PKW(pB0,6)};pw1=(u32x4){PKW(pB0,8),PKW(pB0,10),PKW(pB0,12),PKW(pB0,14)};pw2=(u32x4){PKW(pB1,0),PKW(pB1,2),PKW(pB1,4),PKW(pB1,6)};pw3=(u32x4){PKW(pB1,8),PKW(pB1,10),PKW(pB1,12),PKW(pB1,14)};
    SBAR(); pv(o,vb0+sl_cur,PAF(0),PAF(1),PAF(2),PAF(3)); }
  #undef PKW
  #undef PAF
  #undef VFR
  #undef PIN
  #undef MX3
  #undef GAPA
  #undef GAPB
  #undef EX
  #undef VRD
  #undef KRD
  #undef STEP
  #undef ENDW
  {auto rr=__builtin_amdgcn_permlane32_swap(__float_as_uint(l_reg),__float_as_uint(l_reg),false,false);l_reg=__uint_as_float(rr[0])+__uint_as_float(rr[1]);}
  if(hi==0)wsf[32+r32]=l_reg;asm volatile("s_waitcnt lgkmcnt(0)":::"memory");
  float rli[16];
  #pragma unroll
  for(int r=0;r<16;++r)rli[r]=__builtin_amdgcn_rcpf(wsf[32+crow(r,hi)]);
  bf16*Ow=O+(rowbase+q0+wid*QBLK)*OPITCH+h*D;
  { bf16*stg=(bf16*)(shm+LDS_OST)+wid*2048;
    #pragma unroll
    for(int r=0;r<16;++r){const int orow=crow(r,hi);
      #pragma unroll
      for(int d0=0;d0<2;++d0)stg[orow*64+d0*32+r32]=__float2bfloat16(o[d0][r]*rli[r]);}
    asm volatile("s_waitcnt lgkmcnt(0)":::"memory");
    #pragma unroll
    for(int i=0;i<4;++i){const int row=i*8+(lane>>3),ch=lane&7; const u32x4 v=*(const u32x4*)(stg+row*64+ch*8); ATTN_STORE16(Ow+(long)row*OPITCH+ch*8,v);} }
  asm volatile("s_waitcnt lgkmcnt(0)\n\ts_barrier":::"memory");
  #undef DMA_K
  #undef DMA_V
  #undef TIDX
  #undef JBOF
  #undef CBIAS
  #undef CMASK
  #undef START
  #undef RESC
  #undef ROT
}
constexpr int ATTN_LDS_BYTES=LDS_BYTES;
struct AttnTensors { const bf16* Q; const bf16* K; const bf16* V; bf16* O; const float* CP; const unsigned* NRM; };
struct AttnUnit { int bh; int qb; };
struct StaticOrder {
  int vcu;
  __device__ __forceinline__ explicit StaticOrder(int grid,int block):vcu((grid%8==0)?((block%8)*(grid/8)+block/8):block){}
  __device__ __forceinline__ bool next(int i,AttnUnit&u)const{ const int j=vcu+256*(i>>1); if(j>=256)return false; const int s=j&15; u.bh=j>>4; u.qb=(i&1)?s:31-s; return true; }
  __device__ __forceinline__ void a_ready(const AttnUnit&)const{}
  __device__ __forceinline__ void done(const AttnUnit&)const{}
};
struct QueueOrder {
  unsigned* head; volatile unsigned* slot;
  __device__ __forceinline__ bool next(int,AttnUnit&u)const{
    if(threadIdx.x==0)*slot=__hip_atomic_fetch_add(head,1u,__ATOMIC_RELAXED,__HIP_MEMORY_SCOPE_AGENT);
    __syncthreads(); const unsigned j=*slot; __syncthreads();
    if(j>=512u)return false; u.bh=(int)(j&15u); u.qb=31-(int)(j>>4); return true; }
  __device__ __forceinline__ void a_ready(const AttnUnit&)const{}
  __device__ __forceinline__ void done(const AttnUnit&)const{}
};
template<class Sched,int THRL=8> __device__ __forceinline__ void attn_phase(char*lds,const AttnTensors&T,const Sched&S){
  AttnUnit u;
  for(int i=0;S.next(i,u);++i){ S.a_ready(u); attn_unit<THRL>(u.bh/NHEAD,u.bh%NHEAD,u.qb,T.Q,T.K,T.V,T.O,T.CP,T.NRM,lds); S.done(u); }
}
#undef SBAR
#undef WAIT_BAR
}

constexpr int NWAVES = 8;
constexpr int BATCH = 2, T = 8192, D = 1024, M = BATCH * T;
constexpr int NH = 8, DATT = 512, DCONV = 512, CWID = 31, NE = 32, TOPK = 4, DFF = 1024, DIN = 2568, NP1 = 2560;
constexpr int COL_F = 1536, COL_A = 1544, COL_G = 2056;
constexpr int CAP = 16384;
constexpr int MAXTILES = (M * TOPK) / 256 + NE;
constexpr float LOG2E = 1.4426950408889634f;
constexpr float W8_SCALE = 64.0f, HN8_SCALE = 8.0f, ACT8_SCALE = 4.0f, Y8_SCALE = 32.0f;
constexpr int MAXU = 12;

constexpr size_t MiB = 1u << 20;
constexpr size_t WS_CTL = 0, CTL_ZERO_BYTES = 1 * MiB;
constexpr size_t WS_WIN = 2 * MiB, WS_WO = 8 * MiB, WS_LF = 10 * MiB, WS_CP = 10 * MiB + 512 * 1024, WS_RMS = 11 * MiB + 512 * 1024  , WS_TOKINFO = 11 * MiB, WS_TOKIDX = 12 * MiB, WS_GATEW = 14 * MiB;
constexpr size_t WS_XN = 16 * MiB, WS_Q = 48 * MiB, WS_K = 64 * MiB, WS_V = 80 * MiB, WS_U = 96 * MiB, WS_MIX = 112 * MiB, WS_H1 = 144 * MiB, WS_HN = 208 * MiB;
constexpr size_t WS_WGU = 240 * MiB, WS_WD = 368 * MiB, WS_ACT = 432 * MiB, WS_Y = 576 * MiB, WS_END = 720 * MiB;
static_assert(WS_V - WS_K == WS_K - WS_Q && WS_ACT + (size_t)MAXTILES * 256 * 1024 * 2 <= WS_Y && WS_Y + (size_t)MAXTILES * 256 * 1024 * 2 <= WS_END, "d_ws map");
constexpr int CW_TMO = 0, CW_CODE = 1, CW_CNT = 64  , CW_BAR = 4096;
static_assert(CW_CNT + 64 * NE <= CW_BAR, "CTL words");
constexpr int CW_NRM = 16384  , CW_QHEAD = 24576  ;
constexpr int CW_CQ = CW_QHEAD + 64  ;
static_assert((CW_CQ + 256) * 4 <= (int)CTL_ZERO_BYTES, "CTL words inside the memset region");

constexpr int RING_OFF = 0, RING_BYTES = 131072;
constexpr int LDSCTL_OFF = RING_BYTES, MISC_OFF = LDSCTL_OFF;
constexpr int META_OFF = LDSCTL_OFF + 512;
constexpr int TOKL_OFF = LDSCTL_OFF + 2048;
constexpr int EPIL_OFF = TOKL_OFF + MAXU * 1024, EPIL_BYTES = 12288;
constexpr int LDS_BYTES = 163840;
static_assert(EPIL_OFF + EPIL_BYTES <= LDS_BYTES && 9 * 256 * 4 <= EPIL_BYTES && 6 * 512 * 4 <= EPIL_BYTES, "LDS map");

#define GAS __attribute__((address_space(1)))
#define LAS __attribute__((address_space(3)))
typedef unsigned short bf16;
typedef unsigned v4u __attribute__((ext_vector_type(4)));
typedef unsigned v2u __attribute__((ext_vector_type(2)));
typedef float f32x4 __attribute__((ext_vector_type(4)));
typedef GAS unsigned gu32;
#define RLX_AGENT __ATOMIC_RELAXED, __HIP_MEMORY_SCOPE_AGENT
#define LDS_WAIT() asm volatile("s_waitcnt lgkmcnt(0)" ::: "memory")
#define VM_WAIT() asm volatile("s_waitcnt vmcnt(0)" ::: "memory")
__device__ __forceinline__ unsigned f2bf(float f) { unsigned u = __builtin_bit_cast(unsigned, f); return (u + 0x7fffu + ((u >> 16) & 1u)) >> 16; }
__device__ __forceinline__ unsigned pk2(float lo, float hi) { return f2bf(lo) | (f2bf(hi) << 16); }
__device__ __forceinline__ float bf2f(unsigned short h) { return __builtin_bit_cast(float, (unsigned)h << 16); }
#define XB_TMO      128
#define XB_XCNT(j)  (256  + 64 * (j))
#define XB_XSUB(j)  (1280 + 64 * (j))
#define XB_XGEN(j)  (2304 + 64 * (j))
#define XB_TOP      3328
#define XB_TOPGEN   3392
#define XCD_BAR_WORDS 3456
#define XB_SPIN_CAP (1u << 18)

__device__ __forceinline__ unsigned xb_ld(unsigned* p)              { return __hip_atomic_load(p, __ATOMIC_RELAXED, __HIP_MEMORY_SCOPE_AGENT); }
__device__ __forceinline__ unsigned xb_add(unsigned* p, unsigned v) { return __hip_atomic_fetch_add(p, v, __ATOMIC_RELAXED, __HIP_MEMORY_SCOPE_AGENT); }
__device__ __forceinline__ unsigned xb_xcc_id() { return (unsigned)__builtin_amdgcn_s_getreg((3 << 11) | 20) & 0xFu; }
#define XB_SPIN(cond, bar) do { unsigned _sp = 0; while (cond) { __builtin_amdgcn_s_sleep(1); \
    if ((++_sp & 255u) == 0u) { if (xb_ld(&(bar)[XB_TMO])) break; if (_sp > XB_SPIN_CAP) { atomicAdd(&(bar)[XB_TMO], 1u); break; } } } } while (0)

struct XcdBarrier {
    unsigned* bar; unsigned x;
    volatile LAS unsigned* st;
};

__device__ __forceinline__ XcdBarrier xcd_barrier_post(unsigned* bar, volatile LAS unsigned* st) {
    XcdBarrier b; b.bar = bar; b.x = xb_xcc_id(); b.st = st;
    if (threadIdx.x == 0) (void)xb_add(&bar[XB_XCNT(b.x)], 1u);
    return b;
}
__device__ __forceinline__ void xcd_barrier_complete(unsigned* bar, unsigned x, unsigned& nloc, unsigned& nx) {
    const unsigned G = gridDim.x * gridDim.y * gridDim.z;
    unsigned sum, cnt, mine, sp = 0u;
    for (;;) {
        sum = 0u; cnt = 0u; mine = 0u;
#pragma unroll
        for (unsigned j = 0; j < 16; ++j) { const unsigned c = xb_ld(&bar[XB_XCNT(j)]); sum += c; cnt += (c > 0u) ? 1u : 0u; mine = (j == x) ? c : mine; }
        if (sum == G) break;
        __builtin_amdgcn_s_sleep(1);
        if ((++sp & 255u) == 0u) { if (xb_ld(&bar[XB_TMO])) break; if (sp > XB_SPIN_CAP) { atomicAdd(&bar[XB_TMO], 1u); break; } }
    }
    nloc = mine > 0u ? mine : 1u; nx = cnt > 0u ? cnt : 1u;
}

__device__ __forceinline__ void xcd_barrier(const XcdBarrier& b) {
    asm volatile("s_waitcnt vmcnt(0)" ::: "memory");
    __syncthreads();
    if (threadIdx.x == 0) {
        unsigned* bar = b.bar;
        __builtin_amdgcn_s_waitcnt(0);
        unsigned nloc = b.st[0], nx = b.st[1];
        if (nloc == 0u) { xcd_barrier_complete(bar, b.x, nloc, nx); b.st[0] = nloc; b.st[1] = nx; }
        const unsigned old = xb_add(&bar[XB_XSUB(b.x)], 1u);
        const unsigned gen = old / nloc;
        if (old + 1u == (gen + 1u) * nloc) {
            __builtin_amdgcn_fence(__ATOMIC_RELEASE, "agent");
            asm volatile("s_waitcnt vmcnt(0)" ::: "memory");
            const unsigned og = xb_add(&bar[XB_TOP], 1u);
            const unsigned tg = og / nx;
            if (og + 1u == (tg + 1u) * nx) xb_add(&bar[XB_TOPGEN], 1u);
            else XB_SPIN(xb_ld(&bar[XB_TOPGEN]) == tg, bar);
            __builtin_amdgcn_fence(__ATOMIC_ACQUIRE, "agent");
            xb_add(&bar[XB_XGEN(b.x)], 1u);
            asm volatile("s_waitcnt vmcnt(0)" ::: "memory");
        } else {
            XB_SPIN(xb_ld(&bar[XB_XGEN(b.x)]) == gen, bar);
            __builtin_amdgcn_fence(__ATOMIC_ACQUIRE, "agent");
            asm volatile("s_waitcnt vmcnt(0)" ::: "memory");
        }
    }
    __syncthreads();
}

struct Args {
    const float *x, *norm_mix_g, *w_in, *b_f, *b_glu, *w_dw, *b_dw, *ln_g, *ln_b, *w_out, *norm_ffn_g, *w_router, *b_router, *w_gu, *b_gu, *w_down, *b_down, *norm_final_g;
    float* out; unsigned char* ws; int ph_lo, ph_hi, li, pad;
};
struct Frame {
    LAS unsigned char* lds;
    volatile LAS unsigned* MISC;
    gu32* ctl;
    int tid, lane, wave, vcu, G;
};
__device__ __forceinline__ float wave_sum(float v) {
#pragma unroll
    for (int o = 1; o < 64; o <<= 1) v += __shfl_xor(v, o);
    return v;
}

__device__ __forceinline__ void p0_transpose_item(const float* W, int K, int N, int k0, int sc0, bf16* WTrow0, LAS float* scr, int lane) {
#pragma unroll 8
    for (int i = 0; i < 32; ++i) { const int kk = 2 * i + (lane >> 5); scr[kk * 33 + (lane & 31)] = __builtin_nontemporal_load(W + (size_t)(k0 + kk) * N + sc0 + (lane & 31)); }
    LDS_WAIT(); asm volatile("" ::: "memory");
    const int c = lane & 7;
#pragma unroll
    for (int j = 0; j < 4; ++j) { const int n = (lane >> 3) + 8 * j; const LAS float* s = scr + (8 * c) * 33 + n;
        v4u o; o.x = pk2(s[0 * 33], s[1 * 33]); o.y = pk2(s[2 * 33], s[3 * 33]); o.z = pk2(s[4 * 33], s[5 * 33]); o.w = pk2(s[6 * 33], s[7 * 33]);
        *(GAS v4u*)(WTrow0 + (size_t)n * K + k0 + 8 * c) = o; }
    LDS_WAIT(); asm volatile("" ::: "memory");
}
__device__ __forceinline__ void p0_transpose_item_f8(const float* W, int K, int N, int k0, int sc0, unsigned char* WTrow0, int lane, float sc) {
    const int kr = lane >> 3, c4 = lane & 7;
    const GAS f32x4* src = (const GAS f32x4*)(W + (size_t)(k0 + 16 * kr) * N + sc0 + 4 * c4);
    f32x4 v[16];
#pragma unroll
    for (int i = 0; i < 16; ++i) v[i] = __builtin_nontemporal_load(src + (size_t)i * (N / 4));
    __builtin_amdgcn_sched_barrier(0);
#pragma unroll
    for (int c = 0; c < 4; ++c) { v4u o;
        o.x = pg8::pk4_fp8(v[0][c] * sc, v[1][c] * sc, v[2][c] * sc, v[3][c] * sc); o.y = pg8::pk4_fp8(v[4][c] * sc, v[5][c] * sc, v[6][c] * sc, v[7][c] * sc);
        o.z = pg8::pk4_fp8(v[8][c] * sc, v[9][c] * sc, v[10][c] * sc, v[11][c] * sc); o.w = pg8::pk4_fp8(v[12][c] * sc, v[13][c] * sc, v[14][c] * sc, v[15][c] * sc);
        *(GAS v4u*)(WTrow0 + (size_t)(4 * c4 + c) * K + k0 + 16 * kr) = o; }
}
constexpr int P0_KB = D / 64, P0_KB8 = D / 128;
constexpr int P0_I_IN = P0_KB * (NP1 / 32), P0_I_O = P0_KB * (D / 32), P0_I_GU = NE * P0_KB8 * (2 * DFF / 32), P0_I_DN = NE * P0_KB8 * (D / 32);
constexpr int P0_NITEMS = P0_I_IN + P0_I_O + P0_I_GU + P0_I_DN;
__device__ __forceinline__ void p0_items(Frame& F, const Args& a, int first, int last, int gw, int NGW) {
    unsigned char* ws = a.ws;
    LAS float* scr = (LAS float*)(F.lds + RING_OFF + F.wave * 16384);
    bf16* Win_t = (bf16*)(ws + WS_WIN); bf16* Wo_t = (bf16*)(ws + WS_WO);
    constexpr int I_IN = P0_I_IN;
    for (int it = first + gw; it < last; it += NGW) {
        int r = it;
        if (r < I_IN) { const int nb = r % (NP1 / 32), kb = r / (NP1 / 32), n0 = nb * 32; int sc;
            if (n0 < 1536) sc = n0; else { const int j = (n0 - 1536) >> 8, i = (n0 - 1536) & 255; sc = (i < 128) ? (COL_A + 128 * j + i) : (COL_G + 128 * j + (i - 128)); }
            p0_transpose_item(a.w_in, D, DIN, kb * 64, sc, Win_t + (size_t)n0 * D, scr, F.lane); continue; }
        r -= I_IN;
        { const int nb = r % (D / 32), kb = r / (D / 32); p0_transpose_item(a.w_out, D, D, kb * 64, nb * 32, Wo_t + (size_t)nb * 32 * D, scr, F.lane); }
    }
}
__device__ __forceinline__ void p0_item_f8(const Args& a, int r, int lane) {
    if (r < P0_I_GU) { const int per = P0_KB8 * (2 * DFF / 32), e = r / per, q = r % per, nb = q % (2 * DFF / 32), kb = q / (2 * DFF / 32), n0 = nb * 32;
        const int pl = n0 >> 8, i = n0 & 255, sc = (i < 128) ? (128 * pl + i) : (DFF + 128 * pl + (i - 128));
        p0_transpose_item_f8(a.w_gu + (size_t)e * D * 2 * DFF, D, 2 * DFF, kb * 128, sc, a.ws + WS_WGU + ((size_t)e * 2 * DFF + n0) * D, lane, W8_SCALE); }
    else { r -= P0_I_GU; const int per = P0_KB8 * (D / 32), e = r / per, q = r % per, nb = q % (D / 32), kb = q / (D / 32);
        p0_transpose_item_f8(a.w_down + (size_t)e * DFF * D, DFF, D, kb * 128, nb * 32, a.ws + WS_WD + ((size_t)e * D + nb * 32) * DFF, lane, W8_SCALE); }
}
__device__ __forceinline__ void conv_pull(Frame& F, const Args& a, int cw, int first, int last) {
    for (;;) {
        unsigned it = 0;
        if (F.lane == 0) it = __hip_atomic_fetch_add((unsigned*)(F.ctl + cw), 2u, __ATOMIC_RELAXED, __HIP_MEMORY_SCOPE_AGENT);
        const int r = first + (int)__builtin_amdgcn_readfirstlane(it);
        if (r >= last) break;
        p0_item_f8(a, r, F.lane); if (r + 1 < last) p0_item_f8(a, r + 1, F.lane);
    }
}
__device__ __forceinline__ void conv_static(Frame& F, const Args& a, int first, int last, int gw, int NGW) {
    for (int it = first + gw; it < last; it += NGW) p0_item_f8(a, it, F.lane);
}
__device__ __forceinline__ void p0_prologue(Frame& F, const Args& a) {
    unsigned char* ws = a.ws;
    const int gw = F.vcu * NWAVES + F.wave, NGW = F.G * NWAVES;
    p0_items(F, a, 0, P0_I_IN + P0_I_O, gw, NGW);
    __syncthreads();
    LAS float* wf = (LAS float*)(F.lds + RING_OFF);
    for (int i = F.tid; i < D * NH; i += NWAVES * 64) { const int k = i >> 3, h = i & 7; wf[h * D + k] = a.w_in[(size_t)k * DIN + COL_F + h]; }
    __syncthreads();
    bf16* XN = (bf16*)(ws + WS_XN); float* LF = (float*)(ws + WS_LF);
    f32x4 gv[4];
#pragma unroll
    for (int j = 0; j < 4; ++j) gv[j] = ((const GAS f32x4*)a.norm_mix_g)[F.lane + 64 * j];
    for (int m = gw; m < M; m += NGW) {
        const GAS f32x4* xr = (const GAS f32x4*)(a.x + (size_t)m * D) + F.lane;
        f32x4 v[4]; float s = 0.f;
#pragma unroll
        for (int j = 0; j < 4; ++j) { v[j] = xr[64 * j]; s += (v[j].x * v[j].x + v[j].y * v[j].y) + (v[j].z * v[j].z + v[j].w * v[j].w); }
        const float ms = wave_sum(s) * (1.f / D) + 1e-6f, rs = 1.0f / sqrtf(ms);
        if (F.lane == 0) ((float*)(ws + WS_RMS))[m] = sqrtf(ms);
#pragma unroll
        for (int j = 0; j < 4; ++j) v[j] = v[j] * rs * gv[j];
        GAS unsigned long long* o8 = (GAS unsigned long long*)(XN + (size_t)m * D) + F.lane;
#pragma unroll
        for (int j = 0; j < 4; ++j) o8[64 * j] = (unsigned long long)pk2(v[j].x, v[j].y) | ((unsigned long long)pk2(v[j].z, v[j].w) << 32);
        float fl[NH];
#pragma unroll
        for (int h = 0; h < NH; ++h) { float acc = 0.f;
#pragma unroll
            for (int j = 0; j < 4; ++j) { const f32x4 w = *(const LAS f32x4*)(wf + h * D + 4 * F.lane + 256 * j); acc += (v[j].x * w.x + v[j].y * w.y) + (v[j].z * w.z + v[j].w * w.w); }
            fl[h] = wave_sum(acc); }
        if (F.lane < NH) { float z = fl[0];
#pragma unroll
            for (int h = 1; h < NH; ++h) z = (F.lane == h) ? fl[h] : z;
            z += a.b_f[F.lane];
            const float ls = fminf(z, 0.f) - log1pf(expf(-fabsf(z)));
            const int b = m / T, t = m % T;
            LF[(size_t)(b * NH + F.lane) * T + t] = ls; }
    }
}
__device__ __forceinline__ void scan_bh(Frame& F, const float* LF, float* CP, int bh) {
    LAS double* wtot = (LAS double*)(F.lds + RING_OFF);
    const GAS f32x4* src = (const GAS f32x4*)(LF + (size_t)bh * T) + F.tid * 4;
    f32x4 v[4];
#pragma unroll
    for (int j = 0; j < 4; ++j) v[j] = src[j];
    double pre[16]; double run = 0.0;
#pragma unroll
    for (int j = 0; j < 4; ++j)
#pragma unroll
        for (int c = 0; c < 4; ++c) { run += (double)v[j][c]; pre[j * 4 + c] = run; }
    double inc = run;
#pragma unroll
    for (int o = 1; o < 64; o <<= 1) { const double up = __shfl_up(inc, o); if (F.lane >= o) inc += up; }
    if (F.lane == 63) wtot[F.wave] = inc;
    __syncthreads();
    double base = inc - run;
    for (int w = 0; w < F.wave; ++w) base += wtot[w];
    GAS f32x4* dst = (GAS f32x4*)(CP + (size_t)bh * T) + F.tid * 4;
#pragma unroll
    for (int j = 0; j < 4; ++j) { f32x4 o;
#pragma unroll
        for (int c = 0; c < 4; ++c) o[c] = (float)((base + pre[j * 4 + c]) * (double)LOG2E);
        dst[j] = o; }
    __syncthreads();
}

__device__ __forceinline__ void conv_phase(Frame& F, const Args& a, int blk, int grp0, int grp1) {
    const bf16* U = (const bf16*)(a.ws + WS_U); bf16* MIX = (bf16*)(a.ws + WS_MIX);
    LAS float* yl = (LAS float*)(F.lds + RING_OFF);
    LAS float* st = (LAS float*)(F.lds + RING_OFF + 65536);
    int ch = threadIdx.x; asm volatile("" : "+v"(ch));
    const int clane = ch & 63, cwave = __builtin_amdgcn_readfirstlane(ch >> 6);
    float w[CWID];
#pragma unroll
    for (int j = 0; j < CWID; ++j) w[j] = a.w_dw[j * DCONV + ch];
    const float bdw = a.b_dw[ch], lg = a.ln_g[ch], lb = a.ln_b[ch];
    for (int grp = grp0; grp < grp1; ++grp) {
        const int n0 = blk * 64 + grp * 32, t0 = n0 % T;
        unsigned short raw[CWID - 1 + 32];
#pragma unroll
        for (int i = 0; i < CWID - 1 + 32; ++i) { const int ts = t0 - (CWID - 1) + i; const int rowc = (ts >= 0) ? (n0 - (CWID - 1) + i) : n0;
            raw[i] = U[(size_t)rowc * DCONV + ch]; }
        __builtin_amdgcn_sched_barrier(0);
        float uin[CWID - 1 + 32];
#pragma unroll
        for (int i = 0; i < CWID - 1 + 32; ++i) { const int ts = t0 - (CWID - 1) + i; uin[i] = (ts >= 0) ? bf2f(raw[i]) : 0.f; }
        float y[32];
#pragma unroll
        for (int o = 0; o < 32; ++o) { float acc = bdw;
#pragma unroll
            for (int j = 0; j < CWID; ++j) acc = fmaf(w[j], uin[o + j], acc);
            y[o] = acc; yl[o * DCONV + ch] = acc; }
        __syncthreads();
#pragma unroll
        for (int q = 0; q < 4; ++q) { const int o = cwave * 4 + q;
            const f32x4 p0 = *(const LAS f32x4*)(yl + o * DCONV + 4 * clane), p1 = *(const LAS f32x4*)(yl + o * DCONV + 256 + 4 * clane);
            const float mu = wave_sum((p0.x + p0.y) + (p0.z + p0.w) + (p1.x + p1.y) + (p1.z + p1.w)) * (1.f / DCONV);
            const f32x4 d0 = p0 - mu, d1 = p1 - mu;
            const float var = wave_sum((d0.x * d0.x + d0.y * d0.y) + (d0.z * d0.z + d0.w * d0.w) + (d1.x * d1.x + d1.y * d1.y) + (d1.z * d1.z + d1.w * d1.w)) * (1.f / DCONV);
            if (clane == 0) { st[2 * o] = mu; st[2 * o + 1] = 1.0f / sqrtf(var + 1e-5f); } }
        __syncthreads();
#pragma unroll
        for (int o = 0; o < 32; ++o) { const float z = (y[o] - st[2 * o]) * st[2 * o + 1] * lg + lb; const float sw = z * pg8::sigmoid_f(z);
            MIX[(size_t)(n0 + o) * D + DATT + ch] = (bf16)f2bf(sw); }
        __syncthreads();
    }
}

#define RT_SWZ(col) ((((col) & 7) ^ ((((col) >> 3) & 1) << 2)))
__device__ __forceinline__ void router_table(Frame& F, const Args& a) {
    LAS unsigned char* tbl = F.lds + RING_OFF;
    { f32x4 wv[16]; float gg[16];
#pragma unroll
      for (int i = 0; i < 16; ++i) { const int f = F.tid + 512 * i; wv[i] = ((const GAS f32x4*)a.w_router)[f]; gg[i] = a.norm_ffn_g[f >> 3]; }
      __builtin_amdgcn_sched_barrier(0);
#pragma unroll
      for (int i = 0; i < 16; ++i) { const int f = F.tid + 512 * i, col = f >> 3, e4 = f & 7; *(LAS f32x4*)(tbl + col * 128 + ((e4 ^ RT_SWZ(col)) << 4)) = wv[i] * gg[i]; } }
}
__device__ __forceinline__ void router_phase(Frame& F, const Args& a, int blk, size_t dry  ) {
    const bf16* H1 = (const bf16*)(a.ws + WS_H1); unsigned char* HN = a.ws + WS_HN + dry;
    int* tokinfo = (int*)(a.ws + WS_TOKINFO + dry); int* tokidx = (int*)(a.ws + WS_TOKIDX + dry); float* gatew = (float*)(a.ws + WS_GATEW + dry);
    int* gcnt = (int*)(F.ctl + CW_CNT) + (dry ? 32 : 0);
    LAS unsigned char* tbl = F.lds + RING_OFF;
    LAS int* lcnt = (LAS int*)(F.lds + META_OFF) + 32 + 32 + 33 + 33 + 33;
    LAS int* lbase = lcnt + 32;
    LAS float* part = (LAS float*)(F.lds + TOKL_OFF);
    LAS float* ssp = part + 4 * 8 * 64;
    LAS float* rsl = ssp + 64;
    if (F.tid < 32) lcnt[F.tid] = 0;
    __syncthreads();
    const int rg = F.wave & 3, kh = F.wave >> 2, r16 = F.lane & 15, kq = F.lane >> 4;
    f32x4 c0 = {0.f, 0.f, 0.f, 0.f}, c1 = {0.f, 0.f, 0.f, 0.f}; float ss = 0.f;
    {
        const bf16* hp = H1 + (size_t)(blk * 64 + rg * 16 + r16) * D + kh * 512 + kq * 8;
        const int e4a = r16 >> 2, e4b = 4 + (r16 >> 2), wi = (r16 & 3) * 4;
        v4u avv[16];
#pragma unroll
        for (int j = 0; j < 16; ++j) avv[j] = *(const v4u*)(hp + 32 * j);
        __builtin_amdgcn_sched_barrier(0);
#pragma unroll
        for (int j = 0; j < 16; ++j) {
#pragma unroll
            for (int c = 0; c < 8; ++c) { const unsigned wv = avv[j][c >> 1]; const float av = __builtin_bit_cast(float, (c & 1) ? (wv & 0xffff0000u) : (wv << 16));
                ss += av * av;
                const int k = kh * 512 + 32 * j + 8 * kq + c; const LAS unsigned char* rp = tbl + k * 128 + wi; const int sw = RT_SWZ(k);
                const float b0 = *(const LAS float*)(rp + ((e4a ^ sw) << 4)), b1 = *(const LAS float*)(rp + ((e4b ^ sw) << 4));
                c0 = __builtin_amdgcn_mfma_f32_16x16x4f32(av, b0, c0, 0, 0, 0); c1 = __builtin_amdgcn_mfma_f32_16x16x4f32(av, b1, c1, 0, 0, 0); } }
    }
    ss += __shfl_xor(ss, 16); ss += __shfl_xor(ss, 32);
    if (kh == 1) {
#pragma unroll
        for (int i = 0; i < 4; ++i) { part[(rg * 8 + i) * 64 + F.lane] = c0[i]; part[(rg * 8 + 4 + i) * 64 + F.lane] = c1[i]; }
        if (F.lane < 16) ssp[rg * 16 + F.lane] = ss;
    }
    __syncthreads();
    int pe = 0, plr = 0; float pw = 0.f;
    if (kh == 0) {
#pragma unroll
        for (int i = 0; i < 4; ++i) { c0[i] += part[(rg * 8 + i) * 64 + F.lane]; c1[i] += part[(rg * 8 + 4 + i) * 64 + F.lane]; }
        if (F.lane < 16) rsl[rg * 16 + F.lane] = 1.0f / sqrtf((ss + ssp[rg * 16 + F.lane]) * (1.f / D) + 1e-6f);
        LDS_WAIT(); asm volatile("" ::: "memory");
        const float ba = a.b_router[r16], bb = a.b_router[16 + r16];
#pragma unroll
        for (int i = 0; i < 4; ++i) {
            const float rs = rsl[rg * 16 + 4 * kq + i];
            float za = c0[i] * rs + ba, zb = c1[i] * rs + bb;
            int idx[TOPK]; float val[TOPK];
#pragma unroll
            for (int k = 0; k < TOPK; ++k) { float bv = za; int bi = r16; if (zb > za) { bv = zb; bi = 16 + r16; }
#pragma unroll
                for (int o = 8; o > 0; o >>= 1) { const float ov = __shfl_xor(bv, o); const int oi = __shfl_xor(bi, o); if (ov > bv || (ov == bv && oi < bi)) { bv = ov; bi = oi; } }
                idx[k] = bi; val[k] = bv; if (bi == r16) za = -INFINITY; if (bi == 16 + r16) zb = -INFINITY; }
            float ex[TOPK], den = 0.f;
#pragma unroll
            for (int k = 0; k < TOPK; ++k) { ex[k] = __expf(val[k] - val[0]); den += ex[k]; }
            const float inv = 1.0f / den;
#pragma unroll
            for (int k = 0; k < TOPK; ++k) if (r16 == 4 * i + k) { pe = idx[k]; pw = ex[k] * inv; }
        }
        plr = __hip_atomic_fetch_add(&lcnt[pe], 1, __ATOMIC_RELAXED, __HIP_MEMORY_SCOPE_WORKGROUP);
    }
    __syncthreads();
    if (F.tid < 32) lbase[F.tid] = (int)__hip_atomic_fetch_add(gcnt + 64 * F.tid, lcnt[F.tid], RLX_AGENT);
    __syncthreads();
    if (kh == 0) { const int rank = lbase[pe] + plr, row = blk * 64 + rg * 16 + (F.lane >> 2), k = F.lane & 3;
        tokinfo[row * TOPK + k] = pe * CAP + rank; tokidx[pe * CAP + rank] = row; gatew[pe * CAP + rank] = pw; }
    f32x4 gv[4];
#pragma unroll
    for (int j = 0; j < 4; ++j) gv[j] = ((const GAS f32x4*)a.norm_ffn_g)[F.lane + 64 * j];
    for (int rb = 0; rb < 2; ++rb) { f32x4 hv[4][4];
#pragma unroll
        for (int rr = 0; rr < 4; ++rr) { const GAS v2u* hr = (const GAS v2u*)(H1 + (size_t)(blk * 64 + F.wave * 8 + rb * 4 + rr) * D) + F.lane;
#pragma unroll
            for (int j = 0; j < 4; ++j) { const v2u p = hr[64 * j]; hv[rr][j] = (f32x4){__builtin_bit_cast(float, p.x << 16), __builtin_bit_cast(float, p.x & 0xffff0000u), __builtin_bit_cast(float, p.y << 16), __builtin_bit_cast(float, p.y & 0xffff0000u)}; } }
        __builtin_amdgcn_sched_barrier(0);
#pragma unroll
        for (int rr = 0; rr < 4; ++rr) { const int lr = F.wave * 8 + rb * 4 + rr, row = blk * 64 + lr; const float rs = rsl[lr];
            GAS unsigned* o4 = (GAS unsigned*)(HN + (size_t)row * D) + F.lane;
#pragma unroll
            for (int j = 0; j < 4; ++j) { const f32x4 v = hv[rr][j] * (rs * HN8_SCALE) * gv[j]; o4[64 * j] = pg8::pk4_fp8(v.x, v.y, v.z, v.w); } } }
    __syncthreads();
}
__device__ __forceinline__ void moe_meta(Frame& F) {
    LAS int* meta = (LAS int*)(F.lds + META_OFF);
    if (F.tid < 32) { const int c = (int)__hip_atomic_load((int*)(F.ctl + CW_CNT) + 64 * F.tid, RLX_AGENT); meta[F.tid] = c; meta[32 + F.tid] = (c + 255) >> 8; }
    __syncthreads();
    if (F.tid == 0) { int o = 0; for (int e = 0; e < 32; ++e) { meta[64 + e] = o; meta[97 + e] = o * 8; meta[130 + e] = o * 4; o += meta[32 + e]; } meta[64 + 32] = o; meta[97 + 32] = o * 8; meta[130 + 32] = o * 4; }
    __syncthreads();
}

__device__ __forceinline__ void final_phase(Frame& F, const Args& a, int blk) {
    const bf16* H1 = (const bf16*)(a.ws + WS_H1); const unsigned char* Y = a.ws + WS_Y; const int* tokinfo = (const int*)(a.ws + WS_TOKINFO);
    const LAS int* tileoff = (const LAS int*)(F.lds + META_OFF) + 64;
    f32x4 gv[4];
#pragma unroll
    for (int j = 0; j < 4; ++j) gv[j] = ((const GAS f32x4*)a.norm_final_g)[F.lane + 64 * j];
    for (int rr = 0; rr < 8; ++rr) {
        const int row = blk * 64 + F.wave * 8 + rr;
        const GAS v2u* hr = (const GAS v2u*)(H1 + (size_t)row * D) + F.lane;
        f32x4 v[4];
#pragma unroll
        for (int j = 0; j < 4; ++j) { const v2u p = __builtin_nontemporal_load(hr + 64 * j); v[j] = (f32x4){__builtin_bit_cast(float, p.x << 16), __builtin_bit_cast(float, p.x & 0xffff0000u), __builtin_bit_cast(float, p.y << 16), __builtin_bit_cast(float, p.y & 0xffff0000u)}; }
#pragma unroll
        for (int k = 0; k < TOPK; ++k) { const int info = tokinfo[row * TOPK + k], e = info >> 14, rank = info & (CAP - 1);
            const GAS unsigned* yr = (const GAS unsigned*)(Y + ((size_t)tileoff[e] * 256 + rank) * D) + F.lane;
#pragma unroll
            for (int j = 0; j < 4; ++j) { const unsigned p = __builtin_nontemporal_load(yr + 64 * j);
                const auto lo2 = __builtin_amdgcn_cvt_pk_f32_fp8((int)p, false), hi2 = __builtin_amdgcn_cvt_pk_f32_fp8((int)p, true);
                v[j].x += lo2[0] * (1.0f / Y8_SCALE); v[j].y += lo2[1] * (1.0f / Y8_SCALE); v[j].z += hi2[0] * (1.0f / Y8_SCALE); v[j].w += hi2[1] * (1.0f / Y8_SCALE); } }
        float s = 0.f;
#pragma unroll
        for (int j = 0; j < 4; ++j) s += (v[j].x * v[j].x + v[j].y * v[j].y) + (v[j].z * v[j].z + v[j].w * v[j].w);
        const float rs = 1.0f / sqrtf(wave_sum(s) * (1.f / D) + 1e-6f);
        GAS f32x4* orow = (GAS f32x4*)(a.out + (size_t)row * D) + F.lane;
#pragma unroll
        for (int j = 0; j < 4; ++j) __builtin_nontemporal_store(v[j] * rs * gv[j], orow + 64 * j);
    }
}

constexpr int NPHASE = 8;
__global__ void __launch_bounds__(NWAVES * 64, 2) mega_fwd(Args args) {
    extern __shared__ __attribute__((aligned(16))) unsigned char lds[];
    Frame F;
    F.lds = (LAS unsigned char*)lds;
    F.MISC = (volatile LAS unsigned*)(F.lds + MISC_OFF);
    F.tid = threadIdx.x; F.lane = F.tid & 63; F.wave = __builtin_amdgcn_readfirstlane(F.tid >> 6);
    F.G = gridDim.x; { const int bx = blockIdx.x; F.vcu = (F.G % 8 == 0) ? (bx % 8) * (F.G / 8) + bx / 8 : bx; }
    unsigned char* ws = args.ws;
    F.ctl = (gu32*)(ws + WS_CTL);
    for (int u = F.tid; u < 512 / 4; u += NWAVES * 64) ((LAS unsigned*)(F.lds + LDSCTL_OFF))[u] = 0u;
    __syncthreads();
    const int lo = args.ph_lo, hi = args.ph_hi;
    XcdBarrier bar; bar.bar = (unsigned*)(F.ctl + CW_BAR); bar.x = 0; bar.st = nullptr;
    if (hi - lo > 1) bar = xcd_barrier_post((unsigned*)(F.ctl + CW_BAR) + args.li * XCD_BAR_WORDS, F.MISC + 8);
#ifdef MK_ONLY
#define IN(k) ((k) == MK_ONLY && lo <= (k) && (k) < hi)
#else
#define IN(k) (lo <= (k) && (k) < hi)
#endif
#define BOTH(k) (IN(k) && IN((k) + 1))
#define GRID_BAR() xcd_barrier(bar)
#define REFRESH() do { int t_ = threadIdx.x; asm volatile("" : "+v"(t_)); F.tid = t_; F.lane = t_ & 63; F.wave = __builtin_amdgcn_readfirstlane(t_ >> 6); } while (0)
    const int blk = blockIdx.x;

    if (IN(0)) {
        REFRESH();
        p0_prologue(F, args);
        if (BOTH(0)) GRID_BAR();
    }

    if (IN(1)) {
        REFRESH();
#ifndef NO_SCAN
        if (blk >= F.G - 16) scan_bh(F, (const float*)(ws + WS_LF), (float*)(ws + WS_CP), blk - (F.G - 16));
#endif
        pg8::Gemm g{ws + WS_XN, ws + WS_WIN, M, NP1, D, 2 * D}; pg8::StaticOrder S; S.init(M, NP1, F.G, blk);
        LAS float* epil = (LAS float*)(F.lds + EPIL_OFF);
        for (int i = F.tid; i < 2 * DCONV; i += NWAVES * 64) epil[i] = args.b_glu[i];
        __syncthreads();
        pg8::EpiProj E{(bf16*)(ws + WS_Q), (bf16*)(ws + WS_U), (size_t)(WS_K - WS_Q) / 2, epil, 0.125f * LOG2E, (unsigned*)(F.ctl + CW_NRM)};
        pg8::gemm_phase<pg8::EpiProj, pg8::StaticOrder, true, false, false>(F.lds + RING_OFF, g, S, E, nullptr);
        if (blk >= 128 && F.G == 256) conv_static(F, args, 0, MK_L1, (blk - 128) * NWAVES + F.wave, 128 * NWAVES);
        else if (F.G != 256) conv_static(F, args, 0, MK_L1, F.vcu * NWAVES + F.wave, F.G * NWAVES);
        if (BOTH(1)) GRID_BAR();
#ifdef MK_XBAR
        if (BOTH(1)) { GRID_BAR(); GRID_BAR(); GRID_BAR(); GRID_BAR(); }
#endif
    }

    if (IN(2)) {
        REFRESH();
        const attn_body::AttnTensors AT{(const attn_body::bf16*)(ws + WS_Q), (const attn_body::bf16*)(ws + WS_K), (const attn_body::bf16*)(ws + WS_V), (attn_body::bf16*)(ws + WS_MIX), (const float*)(ws + WS_CP), (const unsigned*)(F.ctl + CW_NRM)};
        volatile unsigned* slot = (volatile unsigned*)(lds + MISC_OFF + 64);
        { constexpr int c = MK_NCONV / 8; const int r = blk >> 3, sel = ((r + 1) * c) / 32 - (r * c) / 32;
          if (sel) conv_static(F, args, MK_L1, MK_DNP5 ? P0_I_GU : P0_I_GU + P0_I_DN, (((r * c) / 32) * 8 + (blk & 7)) * NWAVES + F.wave, MK_NCONV * NWAVES); }
        for (;;) {
            if (threadIdx.x == 0) *slot = __hip_atomic_fetch_add((unsigned*)(F.ctl + CW_QHEAD), 1u, __ATOMIC_RELAXED, __HIP_MEMORY_SCOPE_AGENT);
            __syncthreads(); const unsigned j = __builtin_amdgcn_readfirstlane(*slot); __syncthreads();
            if (j >= 512u + (unsigned)(M / 32)) break;
            if (j < 512u) { const int bh = (int)(j & 15u), qb = 31 - (int)(j >> 4); attn_body::attn_unit<8>(bh / NH, bh % NH, qb, AT.Q, AT.K, AT.V, AT.O, AT.CP, AT.NRM, (char*)lds + RING_OFF); }
            else { const int cj = (int)(j - 512u); conv_phase(F, args, cj >> 1, cj & 1, (cj & 1) + 1); }
        }
        if (BOTH(2)) GRID_BAR();
    }

    if (IN(3)) {
        REFRESH();
        pg8::Gemm g{ws + WS_MIX, ws + WS_WO, M, D, D, 2 * D}; pg8::StaticOrder S; S.init(M, D, F.G, blk);
        pg8::EpiH1 E{(const bf16*)(ws + WS_XN), (const float*)(ws + WS_RMS), args.norm_mix_g, (bf16*)(ws + WS_H1)};
        pg8::gemm_phase<pg8::EpiH1, pg8::StaticOrder, true, false, false>(F.lds + RING_OFF, g, S, E, nullptr);
        if (IN(4)) router_table(F, args);
        if (BOTH(3)) GRID_BAR();
    }

    if (IN(4)) {
        REFRESH();
        if (!IN(3)) router_table(F, args);
        router_phase(F, args, blk, 0);
        if (BOTH(4)) GRID_BAR();
    }

    if (IN(5)) {
        REFRESH();
        moe_meta(F);
        const LAS int* meta = (const LAS int*)(F.lds + META_OFF);
        LAS int* tokl = (LAS int*)(F.lds + TOKL_OFF);
        pg8::MoeOrder S{meta[97 + 32], F.G, blk, 8, meta + 97, meta + 32, meta + 64};
        { pg8::Unit u; const int* tokidx = (const int*)(ws + WS_TOKIDX);
          LAS float* epil = (LAS float*)(F.lds + EPIL_OFF);
          for (int ui = 0; ui < MAXU && S.next(ui, u); ++ui) { if (F.tid < 256) { const int r = u.rt * 256 + F.tid; tokl[ui * 256 + F.tid] = (r < meta[u.e]) ? tokidx[u.e * CAP + r] : 0; }
              else { const int t = F.tid - 256, pl = u.pn & 7; epil[ui * 256 + t] = args.b_gu[(size_t)u.e * 2048 + ((t < 128) ? (128 * pl + t) : (DFF + 128 * pl + (t - 128)))] * (HN8_SCALE * W8_SCALE); } } }
        __syncthreads();
        pg8::Gemm g{ws + WS_HN, ws + WS_WGU, M, 2 * DFF, D, D};
        pg8::EpiGU E{ws + WS_ACT, (const LAS float*)(F.lds + EPIL_OFF), 1.0f / (HN8_SCALE * W8_SCALE), ACT8_SCALE};
        pg8::gemm_phase<pg8::EpiGU, pg8::MoeOrder, MK_ALIGN5, true, true>(F.lds + RING_OFF, g, S, E, tokl);
        if (MK_DNP5) conv_pull(F, args, CW_CQ + 128, P0_I_GU, P0_I_GU + P0_I_DN);
        if (BOTH(5)) GRID_BAR();
    }

    if (IN(6)) {
        REFRESH();
        if (!IN(5)) moe_meta(F);
        const LAS int* meta = (const LAS int*)(F.lds + META_OFF);
        pg8::MoeOrder S{meta[130 + 32], F.G, blk, 4, meta + 130, meta + 32, meta + 64};
        LAS int* tokl = (LAS int*)(F.lds + TOKL_OFF);
        { pg8::Unit u; LAS float* epil = (LAS float*)(F.lds + EPIL_OFF); const float* gatew = (const float*)(ws + WS_GATEW);
          for (int ui = 0; ui < 6 && S.next(ui, u); ++ui) { if (F.tid < 256) { tokl[ui * 256 + F.tid] = u.pm * 256 + F.tid; epil[ui * 512 + F.tid] = args.b_down[(size_t)u.e * 1024 + (u.pn & 3) * 256 + F.tid] * (ACT8_SCALE * W8_SCALE); }
              else { const int r = u.rt * 256 + (F.tid - 256); epil[ui * 512 + F.tid] = (r < meta[u.e]) ? gatew[(size_t)u.e * CAP + r] * Y8_SCALE : 0.0f; } } }
        __syncthreads();
        pg8::Gemm g{ws + WS_ACT, ws + WS_WD, M, D, DFF, DFF};
        pg8::EpiDown E{ws + WS_Y, (const LAS float*)(F.lds + EPIL_OFF), 1.0f / (ACT8_SCALE * W8_SCALE)};
        pg8::gemm_phase<pg8::EpiDown, pg8::MoeOrder, MK_ALIGN6, true, true>(F.lds + RING_OFF, g, S, E, tokl);
        if (BOTH(6)) GRID_BAR();
    }

    if (IN(7)) {
        REFRESH();
        if (!IN(6)) moe_meta(F);
        final_phase(F, args, blk);
    }
#undef IN
#undef BOTH
#undef GRID_BAR
}

#ifndef MK_STAGE
#define MK_STAGE 0
#endif
#ifndef MK_SPLIT
#define MK_SPLIT 0
#endif

#if MK_STAGE != 0
#endif

extern "C" void kernel_launch(void* const* d_in, const int* in_sizes, int n_in, void* d_out, int out_size, void* d_ws, size_t ws_size, hipStream_t stream) {
    static int grid = 0;
    if (grid == 0) {
        if (n_in != 18 || in_sizes[0] != M * D || out_size != M * D || ws_size < (size_t)1024 * MiB) { fprintf(stderr, "kernel_launch: unexpected shapes / workspace (n_in %d, ws %zu); nothing launched\n", n_in, ws_size); grid = -1; return; }
        int dev = 0, cus = 0, per_cu = 0;
        if (hipGetDevice(&dev) != hipSuccess || hipDeviceGetAttribute(&cus, hipDeviceAttributeMultiprocessorCount, dev) != hipSuccess) { grid = -1; return; }
        if (hipFuncSetAttribute((const void*)mega_fwd, hipFuncAttributeMaxDynamicSharedMemorySize, LDS_BYTES) != hipSuccess) { fprintf(stderr, "kernel_launch: hipFuncSetAttribute failed\n"); grid = -1; return; }
        if (hipOccupancyMaxActiveBlocksPerMultiprocessor(&per_cu, (const void*)mega_fwd, NWAVES * 64, LDS_BYTES) != hipSuccess || per_cu < 1) { fprintf(stderr, "kernel_launch: occupancy query says %d workgroups per CU\n", per_cu); }
        (void)hipGetLastError();
        grid = cus;
        if (grid != 256) { fprintf(stderr, "kernel_launch: built for a 256-CU device, found %d CUs; nothing launched\n", cus); grid = -1; return; }
    }
    if (grid < 0) return;
    if (hipMemsetAsync((char*)d_ws + WS_CTL, 0, CTL_ZERO_BYTES, stream) != hipSuccess) return;
    Args a{};
    a.x = (const float*)d_in[0]; a.norm_mix_g = (const float*)d_in[1]; a.w_in = (const float*)d_in[2]; a.b_f = (const float*)d_in[3]; a.b_glu = (const float*)d_in[4];
    a.w_dw = (const float*)d_in[5]; a.b_dw = (const float*)d_in[6]; a.ln_g = (const float*)d_in[7]; a.ln_b = (const float*)d_in[8]; a.w_out = (const float*)d_in[9];
    a.norm_ffn_g = (const float*)d_in[10]; a.w_router = (const float*)d_in[11]; a.b_router = (const float*)d_in[12]; a.w_gu = (const float*)d_in[13]; a.b_gu = (const float*)d_in[14];
    a.w_down = (const float*)d_in[15]; a.b_down = (const float*)d_in[16]; a.norm_final_g = (const float*)d_in[17];
    a.out = (float*)d_out; a.ws = (unsigned char*)d_ws; a.pad = 0;
    const int ph_end = (MK_STAGE == 0) ? NPHASE : (MK_STAGE + 1);
#if defined(MK_PREFILL)
    (void)hipMemsetAsync((char*)d_ws + WS_MIX, 0xFF, (size_t)M * D * 2, stream);
#endif
#if MK_SPLIT
    for (int p = 0; p < ph_end; ++p) { a.ph_lo = p; a.ph_hi = p + 1; a.li = p; hipLaunchKernelGGL(mega_fwd, dim3(grid), dim3(NWAVES * 64), LDS_BYTES, stream, a); }
#else
    a.ph_lo = 0; a.ph_hi = ph_end; a.li = 0;
    hipLaunchKernelGGL(mega_fwd, dim3(grid), dim3(NWAVES * 64), LDS_BYTES, stream, a);
#endif
#if MK_STAGE != 0
    orc::finish(MK_STAGE, a, stream);
#endif
}
```
